# Optimizing an MI355X kernel written in HIP

```python
import math
import jax, jax.numpy as jnp
from jax import lax
import numpy as np

D_MODEL = 1024
BATCH = 8
SEQ = 2048
DEPTH = 4

A_GROUPS = ((128, 1), (512, 4), (2048, 16))
A_HEADS_PER_GROUP = 2
A_HEADS = 6
A_HEAD_DIM = 64
A_WIDTH = A_HEADS * A_HEAD_DIM
B_HEADS = 4
B_HEAD_DIM = 64
B_WIDTH = B_HEADS * 2 * B_HEAD_DIM
C_HEADS = 4
C_KEY_DIM = 64
C_VAL_DIM = 128
C_QK_WIDTH = C_HEADS * C_KEY_DIM
C_WIDTH = C_HEADS * C_VAL_DIM
RET_CHUNK = 128
RET_THETA = 10000.0
ROPE_THETA = 500000.0
ROPE_FRACTION = 4
Q_BLOCK = 128
D_FF = 4 * D_MODEL
N_BRANCHES = 3
NORM_EPS = 1e-6
NEG_INF = -1e30
IN_SPLITS = (A_WIDTH, A_WIDTH, A_WIDTH,
             B_WIDTH, B_WIDTH, B_WIDTH,
             C_QK_WIDTH, C_QK_WIDTH, C_WIDTH, C_WIDTH,
             N_BRANCHES * D_MODEL)
N_IN = sum(IN_SPLITS)

kernel_name = "hybrid_dilated_diff_retention_encoder"


def rms_norm(t, g):
    tf = t.astype(jnp.float32)
    y = tf * lax.rsqrt(jnp.mean(tf * tf, axis=-1, keepdims=True) + NORM_EPS)
    return y.astype(t.dtype) * g


def rope_tables(seq, rot_dims, theta):
    inv = 1.0 / (theta ** (jnp.arange(0, rot_dims, 2, dtype=jnp.float32) / rot_dims))
    ang = jnp.arange(seq, dtype=jnp.float32)[:, None] * inv[None, :]
    return jnp.cos(ang), jnp.sin(ang)


def apply_rope(t, cos, sin):
    r2 = cos.shape[-1]
    shape = (t.shape[1],) + (1,) * (t.ndim - 3) + (r2,)
    c = cos.reshape(shape).astype(t.dtype)
    s = sin.reshape(shape).astype(t.dtype)
    t1, t2, tp = t[..., :r2], t[..., r2:2 * r2], t[..., 2 * r2:]
    return jnp.concatenate([t1 * c - t2 * s, t2 * c + t1 * s, tp], axis=-1)


def dilated_window_attention(q, k, v, dilation, half):
    B, S, H, d = q.shape
    L = S // dilation
    blk = half
    nb = -(-L // blk)
    Lp = nb * blk

    def to_sub(t):
        return t.reshape(B, L, dilation, H, d).transpose(0, 2, 3, 1, 4)

    qs, ks, vs = to_sub(q), to_sub(k), to_sub(v)
    qb = jnp.pad(qs, ((0, 0),) * 3 + ((0, Lp - L), (0, 0))).reshape(B, dilation, H, nb, blk, d)

    def windows(t):
        tb = jnp.pad(t, ((0, 0),) * 3 + ((blk, Lp - L + blk), (0, 0))).reshape(B, dilation, H, nb + 2, blk, d)
        return jnp.concatenate([tb[:, :, :, :-2], tb[:, :, :, 1:-1], tb[:, :, :, 2:]], axis=-2)

    kw, vw = windows(ks), windows(vs)
    qi = jnp.arange(nb)[:, None, None] * blk + jnp.arange(blk)[None, :, None]
    kj = jnp.arange(nb)[:, None, None] * blk - blk + jnp.arange(3 * blk)[None, None, :]
    valid = (jnp.abs(qi - kj) <= half) & (kj >= 0) & (kj < L)

    s = jnp.einsum('brhnqd,brhnkd->brhnqk', qb, kw).astype(jnp.float32) * (d ** -0.5)
    s = jnp.where(valid, s, NEG_INF)
    m = jnp.max(s, axis=-1, keepdims=True)
    e = jnp.exp(s - m)
    den = jnp.sum(e, axis=-1, keepdims=True)
    p = e / den
    lse = (m + jnp.log(den))[..., 0]
    o = jnp.einsum('brhnqk,brhnkd->brhnqd', p.astype(v.dtype), vw)
    o = o.reshape(B, dilation, H, Lp, d)[:, :, :, :L].transpose(0, 3, 1, 2, 4).reshape(B, S, H, d)
    lse = lse.reshape(B, dilation, H, Lp)[..., :L].transpose(0, 3, 1, 2).reshape(B, S, H)
    return o, lse


def dilated_mixer(q, k, v):
    B, S = q.shape[:2]
    outs, lses = [], []
    for g, (window, dilation) in enumerate(A_GROUPS):
        hs = slice(g * A_HEADS_PER_GROUP, (g + 1) * A_HEADS_PER_GROUP)
        o, lse = dilated_window_attention(q[:, :, hs], k[:, :, hs], v[:, :, hs], dilation, window // (2 * dilation))
        outs.append(o)
        lses.append(lse)
    alpha = jax.nn.softmax(jnp.stack(lses, axis=2), axis=2)
    o = jnp.stack(outs, axis=2) * alpha[..., None].astype(v.dtype)
    return o.reshape(B, S, A_WIDTH)


def diff_attention(q, k, v, lam):
    B, S, H, _, d = q.shape
    nb = S // Q_BLOCK
    qb = q.reshape(B, nb, Q_BLOCK, H, 2, d).transpose(1, 0, 2, 3, 4, 5)
    scale = d ** -0.5

    def block(qblk):
        s = jnp.einsum('bqhmd,bkhmd->bhmqk', qblk, k).astype(jnp.float32) * scale
        p = jax.nn.softmax(s, axis=-1)
        w = p[:, :, 0] - lam * p[:, :, 1]
        return jnp.einsum('bhqk,bkhe->bqhe', w.astype(v.dtype), v)

    out = lax.map(block, qb)
    return out.transpose(1, 0, 2, 3, 4).reshape(B, S, H, 2 * d)


def retention_direction(q, k, v, log_gamma):
    B, S, H, dk = q.shape
    dv = v.shape[-1]
    C = RET_CHUNK
    n = S // C
    pos = jnp.arange(C, dtype=jnp.float32)
    lg = log_gamma.astype(jnp.float32)
    rel = pos[:, None] - pos[None, :]
    decay_in = jnp.where(rel >= 0, jnp.exp(lg[:, None, None] * jnp.maximum(rel, 0.0)), 0.0)
    decay_q = jnp.exp(lg[:, None] * (pos + 1.0))[..., None]
    decay_k = jnp.exp(lg[:, None] * (C - 1.0 - pos))[..., None]
    decay_chunk = jnp.exp(lg * C)[:, None, None]

    def chunks(t):
        return t.reshape(B, n, C, H, t.shape[-1]).transpose(1, 0, 3, 2, 4)

    def step(state, inp):
        qc, kc, vc = inp
        scores = jnp.einsum('bhqd,bhkd->bhqk', qc, kc) * decay_in
        out = (jnp.einsum('bhqk,bhkv->bhqv', scores, vc)
               + jnp.einsum('bhqd,bhdv->bhqv', qc, state) * decay_q)
        state = decay_chunk * state + jnp.einsum('bhkd,bhkv->bhdv', kc * decay_k, vc)
        return state, out

    state0 = jnp.zeros((B, H, dk, dv), jnp.float32)
    _, ys = lax.scan(step, state0, (chunks(q), chunks(k), chunks(v)))
    return ys.transpose(1, 0, 3, 2, 4).reshape(B, S, H, dv)


def bidirectional_retention(q, k, v, decay_f, decay_b):
    qf, kf, vf = q.astype(jnp.float32), k.astype(jnp.float32), v.astype(jnp.float32)
    fwd = retention_direction(qf, kf, vf, -jnp.exp(decay_f.astype(jnp.float32)))
    flip = lambda t: jnp.flip(t, axis=1)
    bwd = flip(retention_direction(flip(qf), flip(kf), flip(vf), -jnp.exp(decay_b.astype(jnp.float32))))
    return (fwd + bwd).astype(v.dtype)


def setup_inputs(seed: int = 0) -> dict:
    key = jax.random.key(seed)
    ks = jax.random.split(key, 24)
    f32 = jnp.float32

    def nrm(k, shape, scale):
        return jax.random.normal(k, shape, f32) * scale

    def gain(k, shape):
        return 1.0 + 0.02 * jax.random.normal(k, shape, f32)

    base = jnp.log(-jnp.log1p(-(2.0 ** (-5.0 - jnp.arange(C_HEADS, dtype=f32)))))
    return {
        "x": jax.random.normal(ks[0], (BATCH, SEQ, D_MODEL), f32),
        "norm1_g": gain(ks[1], (DEPTH, D_MODEL)),
        "w_in": nrm(ks[2], (DEPTH, D_MODEL, N_IN), D_MODEL ** -0.5),
        "a_q_norm_g": gain(ks[3], (DEPTH, A_HEAD_DIM)),
        "a_k_norm_g": gain(ks[4], (DEPTH, A_HEAD_DIM)),
        "b_q_norm_g": gain(ks[5], (DEPTH, B_HEAD_DIM)),
        "b_k_norm_g": gain(ks[6], (DEPTH, B_HEAD_DIM)),
        "b_lambda_q1": nrm(ks[7], (DEPTH, B_HEAD_DIM), 0.1),
        "b_lambda_k1": nrm(ks[8], (DEPTH, B_HEAD_DIM), 0.1),
        "b_lambda_q2": nrm(ks[9], (DEPTH, B_HEAD_DIM), 0.1),
        "b_lambda_k2": nrm(ks[10], (DEPTH, B_HEAD_DIM), 0.1),
        "b_out_norm_g": gain(ks[11], (DEPTH, 2 * B_HEAD_DIM)),
        "c_decay_f": base[None, :] + nrm(ks[12], (DEPTH, C_HEADS), 0.05),
        "c_decay_b": base[None, :] + nrm(ks[13], (DEPTH, C_HEADS), 0.05),
        "c_out_norm_g": gain(ks[14], (DEPTH, C_VAL_DIM)),
        "w_br_a": nrm(ks[15], (DEPTH, A_WIDTH, D_MODEL), A_WIDTH ** -0.5),
        "w_br_b": nrm(ks[16], (DEPTH, B_WIDTH, D_MODEL), B_WIDTH ** -0.5),
        "w_br_c": nrm(ks[17], (DEPTH, C_WIDTH, D_MODEL), C_WIDTH ** -0.5),
        "w_o": nrm(ks[18], (DEPTH, D_MODEL, D_MODEL), D_MODEL ** -0.5),
        "norm2_g": gain(ks[19], (DEPTH, D_MODEL)),
        "w_mlp1": nrm(ks[20], (DEPTH, D_MODEL, D_FF), D_MODEL ** -0.5),
        "w_mlp2": nrm(ks[21], (DEPTH, D_FF, D_MODEL), D_FF ** -0.5),
    }


def reference(x, norm1_g, w_in, a_q_norm_g, a_k_norm_g, b_q_norm_g, b_k_norm_g,
              b_lambda_q1, b_lambda_k1, b_lambda_q2, b_lambda_k2, b_out_norm_g,
              c_decay_f, c_decay_b, c_out_norm_g, w_br_a, w_br_b, w_br_c, w_o,
              norm2_g, w_mlp1, w_mlp2):
    B, S, D = x.shape
    cos_p, sin_p = rope_tables(S, A_HEAD_DIM // ROPE_FRACTION, ROPE_THETA)
    cos_r, sin_r = rope_tables(S, C_KEY_DIM, RET_THETA)
    split_pts = [int(p) for p in np.cumsum(IN_SPLITS)[:-1]]

    for l in range(DEPTH):
        xn = rms_norm(x, norm1_g[l])
        proj = xn @ w_in[l]
        aq, ak, av, bq, bk, bv, cq, ck, cv, cg, gates = jnp.split(proj, split_pts, axis=-1)

        aq = apply_rope(rms_norm(aq.reshape(B, S, A_HEADS, A_HEAD_DIM), a_q_norm_g[l]), cos_p, sin_p)
        ak = apply_rope(rms_norm(ak.reshape(B, S, A_HEADS, A_HEAD_DIM), a_k_norm_g[l]), cos_p, sin_p)
        av = av.reshape(B, S, A_HEADS, A_HEAD_DIM)
        ya = dilated_mixer(aq, ak, av)

        lam_init = 0.8 - 0.6 * math.exp(-0.3 * l)
        lam = (jnp.exp(jnp.sum(b_lambda_q1[l] * b_lambda_k1[l]))
               - jnp.exp(jnp.sum(b_lambda_q2[l] * b_lambda_k2[l])) + lam_init)
        bq = apply_rope(rms_norm(bq.reshape(B, S, B_HEADS, 2, B_HEAD_DIM), b_q_norm_g[l]), cos_p, sin_p)
        bk = apply_rope(rms_norm(bk.reshape(B, S, B_HEADS, 2, B_HEAD_DIM), b_k_norm_g[l]), cos_p, sin_p)
        bv = bv.reshape(B, S, B_HEADS, 2 * B_HEAD_DIM)
        yb = diff_attention(bq, bk, bv, lam)
        yb = (rms_norm(yb, b_out_norm_g[l]) * (1.0 - lam_init)).reshape(B, S, B_WIDTH)

        cq = apply_rope(cq.reshape(B, S, C_HEADS, C_KEY_DIM), cos_r, sin_r)
        ck = apply_rope(ck.reshape(B, S, C_HEADS, C_KEY_DIM), cos_r, sin_r) * (C_KEY_DIM ** -0.5)
        cv = cv.reshape(B, S, C_HEADS, C_VAL_DIM)
        yc = bidirectional_retention(cq, ck, cv, c_decay_f[l], c_decay_b[l])
        yc = jax.nn.silu(cg) * rms_norm(yc, c_out_norm_g[l]).reshape(B, S, C_WIDTH)

        g = jax.nn.sigmoid(gates.reshape(B, S, N_BRANCHES, D))
        merged = (g[:, :, 0] * (ya @ w_br_a[l])
                  + g[:, :, 1] * (yb @ w_br_b[l])
                  + g[:, :, 2] * (yc @ w_br_c[l]))
        x = x + merged @ w_o[l]

        h = jnp.square(jax.nn.relu(rms_norm(x, norm2_g[l]) @ w_mlp1[l]))
        x = x + h @ w_mlp2[l]
    return x
```

```cpp
#include <hip/hip_runtime.h>
#include <hip/hip_cooperative_groups.h>
#include <cstdio>
#include <cstdint>
namespace cg = cooperative_groups;
namespace pg8 {
#define PG8_LAS __attribute__((address_space(3)))
typedef unsigned short bf16_t;
typedef short bf16x8 __attribute__((ext_vector_type(8)));
typedef float f32x4 __attribute__((ext_vector_type(4)));
typedef unsigned u32x4 __attribute__((ext_vector_type(4)));
constexpr int BM = 256, BK = 64, HALF = 128, HTB = HALF * BK * 2  , STAGE_BYTES = 8 * HTB, NXCD = 8, WGM = 8;

__host__ __device__ __forceinline__ int lds_byte(int r, int c) { const int st = (r >> 4) * 2 + (c >> 5), rr = r & 15, cc = c & 31, ob = rr * 64 + cc * 2; return st * 1024 + (ob ^ (((ob >> 9) & 1) << 5)); }
__host__ __device__ __forceinline__ void stage_rc(int b, int& R, int& C) { const int st = b / 1024, sb = b % 1024, swz = sb ^ (((sb >> 9) & 1) << 5); R = (st >> 1) * 16 + swz / 64; C = (st & 1) * 32 + (swz % 64) / 2; }
__host__ __device__ __forceinline__ int perm32(int rho) { const int n = rho >> 4, i = rho & 15; return 8 * (i >> 2) + 4 * n + (i & 3); }

struct Unit { int pm, pn; };
struct Gemm { const bf16_t* A; const bf16_t* Bt; int M, N, K; };

struct StaticOrder {
    int nM, nN, nwg, G, c;
    __host__ __device__ void init(int M, int N, int G_, int c_) { nM = M / BM; nN = N / BM; nwg = nM * nN; G = G_; c = c_; }
    __host__ __device__ bool next(int i, Unit& u) const {
        const long L = (long)i * G + c; if (L >= nwg) return false;
        int wgid = (int)L; { const int q = nwg / NXCD, r = nwg % NXCD, xcd = wgid % NXCD, off = wgid / NXCD; wgid = (xcd < r ? xcd * (q + 1) : r * (q + 1) + (xcd - r) * q) + off; }
        const int nig = WGM * nN, gid = wgid / nig, fm = gid * WGM, gsz = (nM - fm) < WGM ? (nM - fm) : WGM;
        u.pm = fm + ((wgid % nig) % gsz); u.pn = (wgid % nig) / gsz; return true;
    }
    __device__ __forceinline__ void a_ready(const Unit&) const {}
    __device__ __forceinline__ void done(const Unit&) const {}
};

__device__ __forceinline__ unsigned cvt_pk_bf16(float lo, float hi) { unsigned r; asm volatile("v_cvt_pk_bf16_f32 %0, %1, %2" : "=v"(r) : "v"(lo), "v"(hi)); return r; }
typedef float f32x2 __attribute__((ext_vector_type(2)));
typedef unsigned u32x2 __attribute__((ext_vector_type(2)));
__device__ __forceinline__ float bflo(unsigned w) { return __uint_as_float(w << 16); }
__device__ __forceinline__ float bfhi(unsigned w) { return __uint_as_float(w & 0xffff0000u); }
template <int ACT> struct EpiStore {
    static constexpr bool PERM = true, AFTER_DRAIN = false;
    bf16_t* O; int ldc;
    __device__ __forceinline__ void operator()(const f32x4 (&acc)[2][2][4][2], const Unit& u, int wr, int wc, int fr, int fq) const {
        const int row0 = u.pm * BM + wr * 64 + fr, col0 = u.pn * BM + wc * 32 + 8 * fq;
#pragma unroll
        for (int ai = 0; ai < 2; ++ai)
#pragma unroll
            for (int m = 0; m < 4; ++m) { const unsigned off = ((unsigned)(row0 + ai * HALF + m * 16) * (unsigned)ldc + (unsigned)col0) * 2u;
#pragma unroll
                for (int bj = 0; bj < 2; ++bj) { f32x4 v0 = acc[ai][bj][m][0], v1 = acc[ai][bj][m][1];
                    if (ACT == 1) {
#pragma unroll
                        for (int e = 0; e < 4; ++e) { float a = fmaxf(v0[e], 0.f), b = fmaxf(v1[e], 0.f); v0[e] = a * a; v1[e] = b * b; } }
                    u32x4 w; w.x = cvt_pk_bf16(v0[0], v0[1]); w.y = cvt_pk_bf16(v0[2], v0[3]); w.z = cvt_pk_bf16(v1[0], v1[1]); w.w = cvt_pk_bf16(v1[2], v1[3]);
                    *(u32x4*)((char*)O + off + (unsigned)(bj * HALF) * 2u) = w; } }
    }
};
template <int HAS_IN> struct EpiGate {
    static constexpr bool PERM = true, AFTER_DRAIN = false;
    const bf16_t* gate; int ldg; const bf16_t* Tin; bf16_t* Tout;
    __device__ __forceinline__ void operator()(const f32x4 (&acc)[2][2][4][2], const Unit& u, int wr, int wc, int fr, int fq) const {
        const int row0 = u.pm * BM + wr * 64 + fr, col0 = u.pn * BM + wc * 32 + 8 * fq;
#pragma unroll
        for (int ai = 0; ai < 2; ++ai)
#pragma unroll
            for (int mp = 0; mp < 2; ++mp) {
                u32x4 gw[2][2], tw[2][2];
#pragma unroll
                for (int mm = 0; mm < 2; ++mm)
#pragma unroll
                    for (int bj = 0; bj < 2; ++bj) { const unsigned row = (unsigned)(row0 + ai * HALF + (2 * mp + mm) * 16);
                        gw[mm][bj] = *(const u32x4*)((const char*)gate + (row * (unsigned)ldg + (unsigned)(col0 + bj * HALF)) * 2u);
                        if (HAS_IN) tw[mm][bj] = *(const u32x4*)((const char*)Tin + (row * 1024u + (unsigned)(col0 + bj * HALF)) * 2u); else tw[mm][bj] = (u32x4){0u, 0u, 0u, 0u}; }
                asm volatile("" ::: "memory");
#pragma unroll
                for (int mm = 0; mm < 2; ++mm)
#pragma unroll
                    for (int bj = 0; bj < 2; ++bj) { const int m = 2 * mp + mm; const unsigned row = (unsigned)(row0 + ai * HALF + m * 16);
                        const f32x4 v0 = acc[ai][bj][m][0], v1 = acc[ai][bj][m][1]; const u32x4 g4 = gw[mm][bj], t4 = tw[mm][bj];
                        const float gg[8] = {bflo(g4.x), bfhi(g4.x), bflo(g4.y), bfhi(g4.y), bflo(g4.z), bfhi(g4.z), bflo(g4.w), bfhi(g4.w)};
                        const float ti[8] = {bflo(t4.x), bfhi(t4.x), bflo(t4.y), bfhi(t4.y), bflo(t4.z), bfhi(t4.z), bflo(t4.w), bfhi(t4.w)};
                        float o[8];
#pragma unroll
                        for (int e = 0; e < 8; ++e) { const float s = __builtin_amdgcn_rcpf(1.0f + __builtin_amdgcn_exp2f(-1.4426950408889634f * gg[e])); o[e] = ti[e] + s * (e < 4 ? v0[e & 3] : v1[e & 3]); }
                        u32x4 w; w.x = cvt_pk_bf16(o[0], o[1]); w.y = cvt_pk_bf16(o[2], o[3]); w.z = cvt_pk_bf16(o[4], o[5]); w.w = cvt_pk_bf16(o[6], o[7]);
                        *(u32x4*)((char*)Tout + (row * 1024u + (unsigned)(col0 + bj * HALF)) * 2u) = w; }
                asm volatile("" ::: "memory"); }
    }
};
struct EpiResid {
    static constexpr bool PERM = false, AFTER_DRAIN = false;
    const float* base; float* out;
    __device__ __forceinline__ void operator()(const f32x4 (&acc)[2][2][4][2], const Unit& u, int wr, int wc, int fr, int fq) const {
        const int row0 = u.pm * BM + wr * 64 + fr, col0 = u.pn * BM + wc * 32 + 4 * fq;
#pragma unroll
        for (int ai = 0; ai < 2; ++ai)
#pragma unroll
            for (int mp = 0; mp < 2; ++mp) {
                f32x4 bs[2][2][2];
#pragma unroll
                for (int mm = 0; mm < 2; ++mm)
#pragma unroll
                    for (int bj = 0; bj < 2; ++bj)
#pragma unroll
                        for (int n = 0; n < 2; ++n) bs[mm][bj][n] = *(const f32x4*)((const char*)base + ((unsigned)(row0 + ai * HALF + (2 * mp + mm) * 16) * 1024u + (unsigned)(col0 + bj * HALF + n * 16)) * 4u);
                asm volatile("" ::: "memory");
#pragma unroll
                for (int mm = 0; mm < 2; ++mm)
#pragma unroll
                    for (int bj = 0; bj < 2; ++bj)
#pragma unroll
                        for (int n = 0; n < 2; ++n) *(f32x4*)((char*)out + ((unsigned)(row0 + ai * HALF + (2 * mp + mm) * 16) * 1024u + (unsigned)(col0 + bj * HALF + n * 16)) * 4u) = bs[mm][bj][n] + acc[ai][bj][2 * mp + mm][n];
                asm volatile("" ::: "memory"); }
    }
};

template <class Epi, class Sched, bool ALIGN_EPI = false, bool SP2 = false>
__device__ __forceinline__ void gemm_phase(PG8_LAS unsigned char* lds, const Gemm g, const Sched& S, const Epi& E) {
    int tid_ = threadIdx.x; asm volatile("" : "+v"(tid_));
    const int tid = tid_, wid = __builtin_amdgcn_readfirstlane(tid >> 6), lane = tid & 63, wr = wid >> 2, wc = wid & 3, fr = lane & 15, fq = lane >> 4;
    const int K = g.K, nt = K / BK;
    unsigned voffA[2], voffB[2];
#pragma unroll
    for (int i = 0; i < 2; ++i) { int R, C; stage_rc(tid * 16 + i * 8192, R, C); const int Rb = Epi::PERM ? ((R & ~31) + perm32(R & 31)) : R;
        voffA[i] = (unsigned)(R * K + C) * 2u; voffB[i] = (unsigned)(Rb * K + C) * 2u; }
    const size_t kstep = (size_t)(BK * 2);
    const size_t hstep = (size_t)HALF * K * 2;
    const size_t tstep = 2 * hstep;
    const unsigned ldsw = (unsigned)wid * 1024u;
    const int aoff = lds_byte(wr * 64 + fr, fq * 8), boff = lds_byte(wc * 32 + fr, fq * 8);
#define PG8_SA(b, h) (((b) * 2 + (h)) * HTB)
#define PG8_SB(b, h) ((4 + (b) * 2 + (h)) * HTB)
#define PG8_STAGE(bufoff, gbase, voff) do { _Pragma("unroll") for (int _i = 0; _i < 2; ++_i) \
        __builtin_amdgcn_global_load_lds((const unsigned*)((const char*)(gbase) + (voff)[_i]), (PG8_LAS unsigned*)(lds + (bufoff) + ldsw + _i * 8192), 16, 0, 0); } while (0)
#define PG8_LDA(dst, b, h) do { _Pragma("unroll") for (int m = 0; m < 4; ++m) _Pragma("unroll") for (int k = 0; k < 2; ++k) dst[m][k] = *(const PG8_LAS bf16x8*)(lds + PG8_SA(b, h) + aoff + m * 2048 + k * 1024); } while (0)
#define PG8_LDB(dst, b, h) do { _Pragma("unroll") for (int n = 0; n < 2; ++n) _Pragma("unroll") for (int k = 0; k < 2; ++k) dst[n][k] = *(const PG8_LAS bf16x8*)(lds + PG8_SB(b, h) + boff + n * 2048 + k * 1024); } while (0)
#define PG8_MMA(ai, bj, At, Bt) do { __builtin_amdgcn_s_setprio(1); _Pragma("unroll") for (int m = 0; m < 4; ++m) _Pragma("unroll") for (int n = 0; n < 2; ++n) _Pragma("unroll") for (int k = 0; k < 2; ++k) \
        acc[ai][bj][m][n] = __builtin_amdgcn_mfma_f32_16x16x32_bf16(Bt[n][k], At[m][k], acc[ai][bj][m][n], 0, 0, 0); __builtin_amdgcn_s_setprio(0); } while (0)
#define PG8_WAIT_V(n) asm volatile("s_waitcnt vmcnt(" #n ")" ::: "memory")
#define PG8_WAIT_L(n) asm volatile("s_waitcnt lgkmcnt(" #n ")" ::: "memory")
#define PG8_BAR __builtin_amdgcn_s_barrier()
#define PG8_SCHED __builtin_amdgcn_sched_barrier(0)
    Unit cur, nxt; int ui = 0;
    if (!S.next(0, cur)) return;
    f32x4 acc[2][2][4][2];
#pragma unroll
    for (int a = 0; a < 2; ++a)
#pragma unroll
        for (int b = 0; b < 2; ++b)
#pragma unroll
            for (int m = 0; m < 4; ++m)
#pragma unroll
                for (int n = 0; n < 2; ++n) acc[a][b][m][n] = (f32x4){0.f, 0.f, 0.f, 0.f};
    bf16x8 At[4][2], B0[2][2], B1[2][2];
    const char* cA = (const char*)g.A + (size_t)cur.pm * tstep; const char* cB = (const char*)g.Bt + (size_t)cur.pn * tstep;
    S.a_ready(cur);
    if constexpr (SP2) {
        PG8_STAGE(PG8_SB(0, 0), cB, voffB); PG8_STAGE(PG8_SB(0, 1), cB + hstep, voffB); PG8_STAGE(PG8_SA(0, 0), cA, voffA); PG8_STAGE(PG8_SA(0, 1), cA + hstep, voffA);
        if (wr == 1) PG8_BAR;
        PG8_WAIT_V(2); PG8_BAR;
        PG8_STAGE(PG8_SB(1, 0), cB + kstep, voffB); PG8_STAGE(PG8_SA(1, 0), cA + kstep, voffA); PG8_STAGE(PG8_SB(1, 1), cB + hstep + kstep, voffB);
        PG8_WAIT_V(6); PG8_BAR;
    } else {
        PG8_STAGE(PG8_SB(0, 0), cB, voffB); PG8_STAGE(PG8_SA(0, 0), cA, voffA); PG8_STAGE(PG8_SB(0, 1), cB + hstep, voffB); PG8_STAGE(PG8_SA(0, 1), cA + hstep, voffA);
        if (wr == 1) PG8_BAR;
        PG8_WAIT_V(4); PG8_BAR;
        PG8_STAGE(PG8_SB(1, 0), cB + kstep, voffB); PG8_STAGE(PG8_SA(1, 0), cA + kstep, voffA); PG8_STAGE(PG8_SB(1, 1), cB + hstep + kstep, voffB);
        PG8_WAIT_V(6); PG8_BAR;
    }
    for (;;) {
        const bool has_next = S.next(ui + 1, nxt);
        const char* nA = has_next ? (const char*)g.A + (size_t)nxt.pm * tstep : cA; const char* nB = has_next ? (const char*)g.Bt + (size_t)nxt.pn * tstep : cB;
        for (int t = 0; t < nt; t += 2) {
            const bool last = (t == nt - 2);
            const char* a1 = cA + (size_t)(t + 1) * kstep;
            const char* a2 = last ? nA : cA + (size_t)(t + 2) * kstep; const char* b2 = last ? nB : cB + (size_t)(t + 2) * kstep;
            const char* a3 = a2 + kstep; const char* b3 = b2 + kstep;
            if (last && has_next) S.a_ready(nxt);
            if constexpr (SP2) {
            PG8_LDB(B0, 0, 0); PG8_LDB(B1, 0, 1); PG8_SCHED; PG8_LDA(At, 0, 0); PG8_STAGE(PG8_SA(1, 1), a1 + hstep, voffA);
            PG8_WAIT_V(8); PG8_WAIT_L(0); PG8_BAR; PG8_MMA(0, 0, At, B0); PG8_MMA(0, 1, At, B1); PG8_BAR; PG8_SCHED;
            PG8_LDA(At, 0, 1); PG8_STAGE(PG8_SB(0, 0), b2, voffB); PG8_STAGE(PG8_SB(0, 1), b2 + hstep, voffB); PG8_STAGE(PG8_SA(0, 0), a2, voffA);
            PG8_WAIT_V(8); PG8_WAIT_L(0); PG8_BAR; PG8_MMA(1, 0, At, B0); PG8_MMA(1, 1, At, B1); PG8_BAR; PG8_SCHED;
            PG8_LDB(B0, 1, 0); PG8_LDB(B1, 1, 1); PG8_SCHED; PG8_LDA(At, 1, 0); PG8_STAGE(PG8_SA(0, 1), a2 + hstep, voffA);
            PG8_WAIT_V(8); PG8_WAIT_L(0); PG8_BAR; PG8_MMA(0, 0, At, B0); PG8_MMA(0, 1, At, B1); PG8_BAR; PG8_SCHED;
            PG8_LDA(At, 1, 1); PG8_STAGE(PG8_SB(1, 0), b3, voffB); PG8_STAGE(PG8_SB(1, 1), b3 + hstep, voffB); PG8_STAGE(PG8_SA(1, 0), a3, voffA);
            PG8_WAIT_V(8); PG8_WAIT_L(0); PG8_BAR; PG8_MMA(1, 0, At, B0); PG8_MMA(1, 1, At, B1); PG8_BAR; PG8_SCHED;
            } else {
            PG8_LDB(B0, 0, 0); PG8_SCHED; PG8_LDA(At, 0, 0); PG8_STAGE(PG8_SA(1, 1), a1 + hstep, voffA);
            PG8_WAIT_L(8); PG8_BAR; PG8_WAIT_L(0); PG8_MMA(0, 0, At, B0); PG8_BAR; PG8_SCHED;
            PG8_LDB(B1, 0, 1); PG8_STAGE(PG8_SB(0, 0), b2, voffB);
            PG8_BAR; PG8_WAIT_L(0); PG8_MMA(0, 1, At, B1); PG8_BAR;
            PG8_LDA(At, 0, 1); PG8_STAGE(PG8_SA(0, 0), a2, voffA);
            PG8_BAR; PG8_WAIT_L(0); PG8_MMA(1, 0, At, B0); PG8_BAR; PG8_SCHED;
            PG8_STAGE(PG8_SB(0, 1), b2 + hstep, voffB);
            PG8_WAIT_V(6); PG8_BAR; PG8_MMA(1, 1, At, B1); PG8_BAR;
            PG8_LDB(B0, 1, 0); PG8_SCHED; PG8_LDA(At, 1, 0); PG8_STAGE(PG8_SA(0, 1), a2 + hstep, voffA);
            PG8_WAIT_L(8); PG8_BAR; PG8_WAIT_L(0); PG8_MMA(0, 0, At, B0); PG8_BAR; PG8_SCHED;
            PG8_LDB(B1, 1, 1); PG8_STAGE(PG8_SB(1, 0), b3, voffB);
            PG8_BAR; PG8_WAIT_L(0); PG8_MMA(0, 1, At, B1); PG8_BAR;
            PG8_LDA(At, 1, 1); PG8_STAGE(PG8_SA(1, 0), a3, voffA);
            PG8_BAR; PG8_WAIT_L(0); PG8_MMA(1, 0, At, B0); PG8_BAR; PG8_SCHED;
            PG8_STAGE(PG8_SB(1, 1), b3 + hstep, voffB);
            PG8_WAIT_V(6); PG8_BAR; PG8_MMA(1, 1, At, B1); PG8_BAR;
            }
        }
        if constexpr (ALIGN_EPI) { if (wr == 0) PG8_BAR; }
        if constexpr (!Epi::AFTER_DRAIN) { E(acc, cur, wr, wc, fr, fq); S.done(cur); }
        if (!has_next) break;
#pragma unroll
        for (int a = 0; a < 2; ++a)
#pragma unroll
            for (int b = 0; b < 2; ++b)
#pragma unroll
                for (int m = 0; m < 4; ++m)
#pragma unroll
                    for (int n = 0; n < 2; ++n) acc[a][b][m][n] = (f32x4){0.f, 0.f, 0.f, 0.f};
        cur = nxt; cA = nA; cB = nB; ++ui;
        if constexpr (ALIGN_EPI) { if (wr == 1) PG8_BAR; }
    }
    PG8_WAIT_V(0);
    if constexpr (!ALIGN_EPI) { if (wr == 0) PG8_BAR; }
    PG8_BAR;
    if constexpr (Epi::AFTER_DRAIN) { E.fused(acc, cur, wr, wc, fr, fq, lds, wid, lane); S.done(cur); }
#undef PG8_SA
#undef PG8_SB
#undef PG8_STAGE
#undef PG8_LDA
#undef PG8_LDB
#undef PG8_MMA
#undef PG8_WAIT_V
#undef PG8_WAIT_L
#undef PG8_BAR
#undef PG8_SCHED
}
}

#define LAS __attribute__((address_space(3)))
typedef unsigned short bf16;
typedef short bf16x8 __attribute__((ext_vector_type(8)));
typedef float f32x4 __attribute__((ext_vector_type(4)));
typedef float f32x16 __attribute__((ext_vector_type(16)));
typedef unsigned u32x4 __attribute__((ext_vector_type(4)));
typedef unsigned u32x2 __attribute__((ext_vector_type(2)));
constexpr int NWAVES = 8, NTHR = 512;
constexpr int SEQ = 2048, NBATCH = 8, M = NBATCH * SEQ, DM = 1024, NIN = 7296, NINP = 7424, DFF = 4096, DEPTH = 4;
constexpr int C_AQ = 0, C_AK = 384, C_AV = 768, C_BQ = 1152, C_BK = 1664, C_BV = 2176, C_CQ = 2688, C_CK = 2944, C_CV = 3200, C_CG = 3712, C_GATE = 4224;
constexpr float NORM_EPS = 1e-6f, LOG2E = 1.4426950408889634f;
constexpr size_t MiB = 1u << 20;
constexpr size_t WS_WIN = 0, WS_WBRA = 16 * MiB, WS_WBRB = 17 * MiB, WS_WBRC = 18 * MiB, WS_WO = 19 * MiB, WS_W1 = 21 * MiB, WS_W2 = 29 * MiB;
constexpr size_t WS_ROPE = 37 * MiB, WS_LA = 38 * MiB, WS_ACT = 40 * MiB, WS_YA = 72 * MiB, WS_YB = 84 * MiB, WS_YC = 100 * MiB, WS_PROJ = 116 * MiB;
constexpr size_t WS_H = WS_PROJ, WS_VTB = 348 * MiB, WS_VTC = 364 * MiB  , WS_T1 = 348 * MiB, WS_T2 = 380 * MiB, WS_END = 412 * MiB;
static_assert(WS_PROJ + (size_t)M * NINP * 2 <= WS_T1, "ws map");
constexpr int LDS_BYTES = 147456, MISC_OFF = 147456 - 256;
constexpr size_t WS_CTL = WS_END, CTL_BYTES = 16384;

__device__ __forceinline__ unsigned pk2(float lo, float hi) { return pg8::cvt_pk_bf16(lo, hi); }
__device__ __forceinline__ float bflo(unsigned w) { return __uint_as_float(w << 16); }
__device__ __forceinline__ float bfhi(unsigned w) { return __uint_as_float(w & 0xffff0000u); }
__device__ __forceinline__ float shx(float v, int mask, int lane) { return __int_as_float(__builtin_amdgcn_ds_bpermute((lane ^ mask) << 2, __float_as_int(v))); }
__device__ __forceinline__ float wave_sum(float v, int lane) {
#pragma unroll
    for (int o = 1; o < 64; o <<= 1) v += shx(v, o, lane);
    return v;
}
__device__ __forceinline__ float wave_max(float v, int lane) {
#pragma unroll
    for (int o = 1; o < 64; o <<= 1) v = fmaxf(v, shx(v, o, lane));
    return v;
}
#define MFMA32(a, b, c) __builtin_amdgcn_mfma_f32_32x32x16_bf16((a), (b), (c), 0, 0, 0)
__device__ __forceinline__ bf16x8 pack8(float a0, float a1, float a2, float a3, float a4, float a5, float a6, float a7) {
    u32x4 p;
    asm volatile("v_cvt_pk_bf16_f32 %0, %4, %5\n\tv_cvt_pk_bf16_f32 %1, %6, %7\n\tv_cvt_pk_bf16_f32 %2, %8, %9\n\tv_cvt_pk_bf16_f32 %3, %10, %11\n\ts_nop 1"
                 : "=&v"(p[0]), "=&v"(p[1]), "=&v"(p[2]), "=&v"(p[3])
                 : "v"(a0), "v"(a1), "v"(a2), "v"(a3), "v"(a4), "v"(a5), "v"(a6), "v"(a7));
    return __builtin_bit_cast(bf16x8, p);
}
__device__ __forceinline__ int kpos(int key) { return (key & ~12) | ((key & 4) << 1) | ((key & 8) >> 1); }

__device__ __forceinline__ void transpose_item(const float* W, int K, int N, bf16* WT, LAS float* scr, int item, int lane) {
    const int nblk = N / 32, kb = item / nblk, nb = item % nblk, k0 = 64 * kb, n0 = 32 * nb;
#pragma unroll 8
    for (int i = 0; i < 32; ++i) { const int kk = 2 * i + (lane >> 5); scr[kk * 33 + (lane & 31)] = W[(size_t)(k0 + kk) * N + n0 + (lane & 31)]; }
    asm volatile("s_waitcnt lgkmcnt(0)" ::: "memory");
    const int c = lane & 7;
#pragma unroll
    for (int j = 0; j < 4; ++j) { const int n = (lane >> 3) + 8 * j; const LAS float* s = scr + (8 * c) * 33 + n;
        u32x4 o; o.x = pk2(s[0 * 33], s[1 * 33]); o.y = pk2(s[2 * 33], s[3 * 33]); o.z = pk2(s[4 * 33], s[5 * 33]); o.w = pk2(s[6 * 33], s[7 * 33]);
        *(u32x4*)(WT + (size_t)(n0 + n) * K + k0 + 8 * c) = o; }
    asm volatile("s_waitcnt lgkmcnt(0)" ::: "memory");
}
__device__ __forceinline__ void rms_rows_to_bf16(const float* x, const float* g, bf16* o, int gw, int NGW, int lane) {
    const f32x4* gr = (const f32x4*)g + lane;
    f32x4 gg[4];
#pragma unroll
    for (int j = 0; j < 4; ++j) gg[j] = gr[64 * j];
    for (int m0 = gw * 4; m0 < M; m0 += NGW * 4) {
        f32x4 v[4][4];
#pragma unroll
        for (int q = 0; q < 4; ++q)
#pragma unroll
            for (int j = 0; j < 4; ++j) v[q][j] = ((const f32x4*)(x + (size_t)(m0 + q) * DM) + lane)[64 * j];
#pragma unroll
        for (int q = 0; q < 4; ++q) { float s = 0.f;
#pragma unroll
            for (int j = 0; j < 4; ++j) s += (v[q][j].x * v[q][j].x + v[q][j].y * v[q][j].y) + (v[q][j].z * v[q][j].z + v[q][j].w * v[q][j].w);
            const float rstd = 1.0f / sqrtf(wave_sum(s, lane) * (1.f / DM) + NORM_EPS);
            unsigned long long* o8 = (unsigned long long*)(o + (size_t)(m0 + q) * DM) + lane;
#pragma unroll
            for (int j = 0; j < 4; ++j)
                o8[64 * j] = (unsigned long long)pk2(v[q][j].x * rstd * gg[j].x, v[q][j].y * rstd * gg[j].y) | ((unsigned long long)pk2(v[q][j].z * rstd * gg[j].z, v[q][j].w * rstd * gg[j].w) << 32); }
    }
}

struct Args { const float* in[22]; float* out; unsigned char* ws; };
__device__ __forceinline__ int otid() { int t = threadIdx.x; asm volatile("" : "+v"(t)); return t; }

__device__ __forceinline__ void phase_prep(const Args& a, int l, LAS unsigned char* lds, int gw, int NGW, int wave, int lane, const float* xsrc) {
    unsigned char* ws = a.ws;
    LAS float* scr = (LAS float*)(lds + wave * 16384);
    const float* w_in = a.in[2] + (size_t)l * DM * NIN;
    const float* w_bra = a.in[15] + (size_t)l * 384 * DM;
    const float* w_brb = a.in[16] + (size_t)l * 512 * DM;
    const float* w_brc = a.in[17] + (size_t)l * 512 * DM;
    const float* w_o = a.in[18] + (size_t)l * DM * DM;
    const float* w_1 = a.in[20] + (size_t)l * DM * DFF;
    const float* w_2 = a.in[21] + (size_t)l * DFF * DM;
    constexpr int I_IN = (DM / 64) * (NIN / 32), I_A = (384 / 64) * (DM / 32), I_B = (512 / 64) * (DM / 32), I_O = (DM / 64) * (DM / 32), I_1 = (DM / 64) * (DFF / 32), I_2 = (DFF / 64) * (DM / 32);
    constexpr int NITEMS = I_IN + I_A + 2 * I_B + I_O + I_1 + I_2;
    for (int it = gw; it < NITEMS; it += NGW) {
        int r = it;
        if (r < I_IN) { transpose_item(w_in, DM, NIN, (bf16*)(ws + WS_WIN), scr, r, lane); continue; } r -= I_IN;
        if (r < I_A) { transpose_item(w_bra, 384, DM, (bf16*)(ws + WS_WBRA), scr, r, lane); continue; } r -= I_A;
        if (r < I_B) { transpose_item(w_brb, 512, DM, (bf16*)(ws + WS_WBRB), scr, r, lane); continue; } r -= I_B;
        if (r < I_B) { transpose_item(w_brc, 512, DM, (bf16*)(ws + WS_WBRC), scr, r, lane); continue; } r -= I_B;
        if (r < I_O) { transpose_item(w_o, DM, DM, (bf16*)(ws + WS_WO), scr, r, lane); continue; } r -= I_O;
        if (r < I_1) { transpose_item(w_1, DM, DFF, (bf16*)(ws + WS_W1), scr, r, lane); continue; } r -= I_1;
        transpose_item(w_2, DFF, DM, (bf16*)(ws + WS_W2), scr, r, lane);
    }
    { u32x4* z = (u32x4*)((bf16*)(ws + WS_WIN) + (size_t)NIN * DM); unsigned z0 = 0u; asm volatile("" : "+v"(z0)); const u32x4 zz = {z0, z0, z0, z0};
      for (int i = gw * 64 + lane; i < (NINP - NIN) * DM / 8; i += NGW * 64) z[i] = zz; }
    const float* g1 = a.in[1] + (size_t)l * DM;
    bf16* act = (bf16*)(ws + WS_ACT);
    rms_rows_to_bf16(xsrc, g1, act, gw, NGW, lane);
    if (l == 0) {
        float* rp = (float*)(ws + WS_ROPE);
        for (int e = gw * 64 + lane; e < SEQ * 40; e += NGW * 64) {
            const int s = e / 40, i = e % 40;
            float inv; if (i < 8) inv = 1.0f / exp2f((float)(2 * i) * (1.0f / 16.0f) * 18.931568569324174f);
            else inv = 1.0f / exp2f((float)(2 * (i - 8)) * (1.0f / 64.0f) * 13.287712379549449f);
            const float ang = (float)s * inv;
            const double rev = (double)ang * 0.15915494309189535; const float fr = (float)(rev - floor(rev));
            const float cs = __builtin_amdgcn_cosf(fr), sn = __builtin_amdgcn_sinf(fr);
            if (i < 8) { rp[s * 8 + i] = cs; rp[SEQ * 8 + s * 8 + i] = sn; }
            else { rp[SEQ * 16 + s * 32 + (i - 8)] = cs; rp[SEQ * 16 + SEQ * 32 + s * 32 + (i - 8)] = sn; }
        }
    }
}

__device__ __forceinline__ void pp_decode(const Args& a, int l, int hv, int& col, const float*& g, int& full, float& sc) {
    const float qs = 0.125f * LOG2E;
    g = a.in[3]; full = 0; sc = 1.f;
    if (hv < 6) { col = C_AQ + 64 * hv; g = a.in[3] + l * 64; sc = qs; }
    else if (hv < 12) { col = C_AK + 64 * (hv - 6); g = a.in[4] + l * 64; }
    else if (hv < 20) { col = C_BQ + 64 * (hv - 12); g = a.in[5] + l * 64; sc = qs; }
    else if (hv < 28) { col = C_BK + 64 * (hv - 20); g = a.in[6] + l * 64; }
    else if (hv < 32) { col = C_CQ + 64 * (hv - 28); full = 1; }
    else { col = C_CK + 64 * (hv - 32); full = 1; sc = 0.125f; }
}
__device__ __forceinline__ void pp_compute(const u32x4 w0, const u32x4 w1, u32x4& o0, u32x4& o1, const float* g, int full, float sc, int s, int q4, int lane,
                                           const float* cosP, const float* sinP, const float* cosR, const float* sinR) {
    float v[16] = {bflo(w0.x), bfhi(w0.x), bflo(w0.y), bfhi(w0.y), bflo(w0.z), bfhi(w0.z), bflo(w0.w), bfhi(w0.w),
                   bflo(w1.x), bfhi(w1.x), bflo(w1.y), bfhi(w1.y), bflo(w1.z), bfhi(w1.z), bflo(w1.w), bfhi(w1.w)};
    if (!full) {
        float ss = 0.f;
#pragma unroll
        for (int i = 0; i < 16; ++i) ss += v[i] * v[i];
        ss += shx(ss, 1, lane); ss += shx(ss, 2, lane);
        const float r = 1.0f / sqrtf(ss * (1.f / 64.f) + NORM_EPS);
        const f32x4* gp = (const f32x4*)(g + q4 * 16);
#pragma unroll
        for (int c = 0; c < 4; ++c) { const f32x4 gg = gp[c]; v[4 * c] *= r * gg[0]; v[4 * c + 1] *= r * gg[1]; v[4 * c + 2] *= r * gg[2]; v[4 * c + 3] *= r * gg[3]; }
        if (q4 == 0) {
            const f32x4 c0 = *(const f32x4*)(cosP + s * 8), c1 = *(const f32x4*)(cosP + s * 8 + 4), s0 = *(const f32x4*)(sinP + s * 8), s1 = *(const f32x4*)(sinP + s * 8 + 4);
#pragma unroll
            for (int i = 0; i < 8; ++i) { const float c = i < 4 ? c0[i & 3] : c1[i & 3], sn = i < 4 ? s0[i & 3] : s1[i & 3], t1 = v[i], t2 = v[8 + i]; v[i] = t1 * c - t2 * sn; v[8 + i] = t2 * c + t1 * sn; }
        }
    } else {
        const int ib = (q4 & 1) * 16;
        const float sg = (q4 < 2) ? -1.0f : 1.0f;
#pragma unroll
        for (int c = 0; c < 4; ++c) { const f32x4 cc = *(const f32x4*)(cosR + s * 32 + ib + 4 * c), sn = *(const f32x4*)(sinR + s * 32 + ib + 4 * c);
#pragma unroll
            for (int j = 0; j < 4; ++j) { const float pv = shx(v[4 * c + j], 2, lane); v[4 * c + j] = v[4 * c + j] * cc[j] + sg * pv * sn[j]; } }
    }
    o0.x = pk2(v[0] * sc, v[1] * sc); o0.y = pk2(v[2] * sc, v[3] * sc); o0.z = pk2(v[4] * sc, v[5] * sc); o0.w = pk2(v[6] * sc, v[7] * sc);
    o1.x = pk2(v[8] * sc, v[9] * sc); o1.y = pk2(v[10] * sc, v[11] * sc); o1.z = pk2(v[12] * sc, v[13] * sc); o1.w = pk2(v[14] * sc, v[15] * sc);
}
__device__ __forceinline__ void phase_postproj(const Args& a, int l, int gtid, int NT, int lane) {
    bf16* proj = (bf16*)(a.ws + WS_PROJ);
    const float* rp = (const float*)(a.ws + WS_ROPE);
    const float* cosP = rp; const float* sinP = rp + SEQ * 8; const float* cosR = rp + SEQ * 16; const float* sinR = rp + SEQ * 16 + SEQ * 32;
    const int q4 = lane & 3, NQ = NT >> 2;
    for (int e0 = gtid >> 2; e0 < M * 36; e0 += 2 * NQ) {
        const int e1 = e0 + NQ; const bool has1 = e1 < M * 36;
        const int t0 = e0 / 36, hv0 = e0 % 36, t1 = has1 ? e1 / 36 : t0, hv1 = has1 ? e1 % 36 : hv0;
        int col0, full0, col1, full1; const float *g0, *g1; float sc0, sc1;
        pp_decode(a, l, hv0, col0, g0, full0, sc0); pp_decode(a, l, hv1, col1, g1, full1, sc1);
        u32x4* p0 = (u32x4*)(proj + (size_t)t0 * NINP + col0 + q4 * 16); u32x4* p1 = (u32x4*)(proj + (size_t)t1 * NINP + col1 + q4 * 16);
        const u32x4 a0 = p0[0], a1 = p0[1], b0 = p1[0], b1 = p1[1];
        u32x4 o0, o1;
        pp_compute(a0, a1, o0, o1, g0, full0, sc0, t0 & (SEQ - 1), q4, lane, cosP, sinP, cosR, sinR);
        p0[0] = o0; p0[1] = o1;
        if (has1) { pp_compute(b0, b1, o0, o1, g1, full1, sc1, t1 & (SEQ - 1), q4, lane, cosP, sinP, cosR, sinR); p1[0] = o0; p1[1] = o1; }
    }
}

__device__ __forceinline__ void vt_item(const bf16* proj, bf16* vt, int vcol0, int item, LAS unsigned char* scr, int lane) {
    const int kt = item & 31, h = (item >> 5) & 3, b = item >> 7;
    const bf16* src = proj + ((size_t)b * SEQ + kt * 64) * NINP + vcol0 + h * 128;
#pragma unroll 4
    for (int i = 0; i < 16; ++i) { const int row = 4 * i + (lane >> 4), ch = lane & 15;
        const u32x4 w = *(const u32x4*)(src + (size_t)row * NINP + ch * 8);
        *(LAS u32x4*)(scr + row * 272 + ch * 16) = w; }
    asm volatile("s_waitcnt lgkmcnt(0)" ::: "memory");
    const int c = lane & 7;
    bf16* dst = vt + ((size_t)(b * 4 + h) * 128) * SEQ + kt * 64 + c * 8;
#pragma unroll 4
    for (int i = 0; i < 16; ++i) { const int dv = 8 * i + (lane >> 3);
        unsigned short e[8];
#pragma unroll
        for (int j = 0; j < 8; ++j) e[j] = *(const LAS unsigned short*)(scr + kpos(8 * c + j) * 272 + dv * 2);
        u32x4 o; o.x = e[0] | ((unsigned)e[1] << 16); o.y = e[2] | ((unsigned)e[3] << 16); o.z = e[4] | ((unsigned)e[5] << 16); o.w = e[6] | ((unsigned)e[7] << 16);
        *(u32x4*)(dst + (size_t)dv * SEQ) = o; }
    asm volatile("s_waitcnt lgkmcnt(0)" ::: "memory");
}

__device__ __forceinline__ void attn_a_item(const Args& a, int item, LAS unsigned char* wlds, int lane, float M2) {
    const bf16* proj = (const bf16*)(a.ws + WS_PROJ);
    bf16* ya = (bf16*)(a.ws + WS_YA); float* lA = (float*)(a.ws + WS_LA);
    const int r = lane & 31, hh = lane >> 5;
    const int g = item >> 10; int rem = item & 1023;
    const int qhalf = rem & 1; rem >>= 1;
    const int dsh = 2 * g, dil = 1 << dsh, nbs = 5 - dsh, L = SEQ >> dsh;
    const int n = rem & ((1 << nbs) - 1); rem >>= nbs;
    const int rsd = rem & (dil - 1); rem >>= dsh;
    const int hg = rem & 1; const int b = rem >> 1;
    const int head = 2 * g + hg;
    const int iq = 64 * n + 32 * qhalf + r;
    const size_t tq = (size_t)b * SEQ + (size_t)dil * iq + rsd;
    bf16x8 qf[4];
#pragma unroll
    for (int kk = 0; kk < 4; ++kk) qf[kk] = *(const bf16x8*)(proj + tq * NINP + C_AQ + head * 64 + 16 * kk + 8 * hh);
    f32x16 O0, O1;
#pragma unroll
    for (int i = 0; i < 16; ++i) { O0[i] = 0.f; O1[i] = 0.f; }
    float lsum = 0.f;
    const int j0 = 64 * n + 32 * qhalf - 64;
    bf16x8 kfb[2][4]; u32x4 vrb[2][4];
    { int jr = j0 + r; jr = jr < 0 ? 0 : (jr >= L ? L - 1 : jr); const size_t tk = (size_t)b * SEQ + (size_t)dil * jr + rsd;
      const bf16* kp = proj + tk * NINP + C_AK + head * 64 + 8 * hh; const bf16* vp = proj + tk * NINP + C_AV + head * 64 + 8 * hh;
#pragma unroll
      for (int kk = 0; kk < 4; ++kk) { kfb[0][kk] = *(const bf16x8*)(kp + 16 * kk); vrb[0][kk] = *(const u32x4*)(vp + 16 * kk); } }
#pragma unroll
    for (int sb = 0; sb < 5; ++sb) {
        const int jb = j0 + 32 * sb;
        if (sb + 1 < 5) { int jr = jb + 32 + r; jr = jr < 0 ? 0 : (jr >= L ? L - 1 : jr); const size_t tk = (size_t)b * SEQ + (size_t)dil * jr + rsd;
            const bf16* kp = proj + tk * NINP + C_AK + head * 64 + 8 * hh; const bf16* vp = proj + tk * NINP + C_AV + head * 64 + 8 * hh;
#pragma unroll
            for (int kk = 0; kk < 4; ++kk) { kfb[(sb + 1) & 1][kk] = *(const bf16x8*)(kp + 16 * kk); vrb[(sb + 1) & 1][kk] = *(const u32x4*)(vp + 16 * kk); } }
        if (jb < 0 || jb >= L) continue;
        bf16x8 kf[4]; u32x4 vr[4];
#pragma unroll
        for (int kk = 0; kk < 4; ++kk) { kf[kk] = kfb[sb & 1][kk]; vr[kk] = vrb[sb & 1][kk]; }
        f32x16 acc;
#pragma unroll
        for (int i = 0; i < 16; ++i) acc[i] = -M2;
#pragma unroll
        for (int kk = 0; kk < 4; ++kk) acc = MFMA32(kf[kk], qf[kk], acc);
        const int pk = kpos(r);
#pragma unroll
        for (int kk = 0; kk < 4; ++kk) { const int ch = hh + 2 * kk;
            LAS bf16* w = (LAS bf16*)(wlds + (ch * 8) * 80 + pk * 2);
            const unsigned ww[4] = {vr[kk].x, vr[kk].y, vr[kk].z, vr[kk].w};
#pragma unroll
            for (int j = 0; j < 4; ++j) { w[(2 * j) * 40] = (bf16)(ww[j] & 0xffffu); w[(2 * j + 1) * 40] = (bf16)(ww[j] >> 16); } }
        float p[16];
#pragma unroll
        for (int i = 0; i < 16; ++i) { const int j = jb + (i & 3) + 8 * (i >> 2) + 4 * hh; const int d = iq - j;
            const float e = __builtin_amdgcn_exp2f(acc[i]); p[i] = (d <= 64 && d >= -64) ? e : 0.f; lsum += p[i]; }
        const bf16x8 pf0 = pack8(p[0], p[1], p[2], p[3], p[4], p[5], p[6], p[7]);
        const bf16x8 pf1 = pack8(p[8], p[9], p[10], p[11], p[12], p[13], p[14], p[15]);
        asm volatile("s_waitcnt lgkmcnt(0)" ::: "memory");
        const bf16x8 v00 = *(const LAS bf16x8*)(wlds + r * 80 + (8 * hh) * 2);
        const bf16x8 v01 = *(const LAS bf16x8*)(wlds + r * 80 + (16 + 8 * hh) * 2);
        const bf16x8 v10 = *(const LAS bf16x8*)(wlds + (32 + r) * 80 + (8 * hh) * 2);
        const bf16x8 v11 = *(const LAS bf16x8*)(wlds + (32 + r) * 80 + (16 + 8 * hh) * 2);
        O0 = MFMA32(v00, pf0, O0); O0 = MFMA32(v01, pf1, O0);
        O1 = MFMA32(v10, pf0, O1); O1 = MFMA32(v11, pf1, O1);
        asm volatile("s_waitcnt lgkmcnt(0)" ::: "memory");
    }
    const float l = lsum + shx(lsum, 32, lane);
    bf16* op = ya + tq * 384 + head * 64 + 4 * hh;
#pragma unroll
    for (int q = 0; q < 4; ++q) {
        u32x2 w0; w0.x = pk2(O0[4 * q], O0[4 * q + 1]); w0.y = pk2(O0[4 * q + 2], O0[4 * q + 3]); *(u32x2*)(op + 8 * q) = w0;
        u32x2 w1; w1.x = pk2(O1[4 * q], O1[4 * q + 1]); w1.y = pk2(O1[4 * q + 2], O1[4 * q + 3]); *(u32x2*)(op + 32 + 8 * q) = w1;
    }
    if (hh == 0) lA[tq * 6 + head] = l;
}

constexpr int AT_KOFF = 9216, AT_VT = 18432, AT_STAGE = 36864;
constexpr size_t WS_RST = 380 * MiB;
__device__ __forceinline__ void ret_state_item(const Args& a, int l, int item, LAS unsigned char* lds) {
    const bf16* proj = (const bf16*)(a.ws + WS_PROJ);
    const int tid = otid(), wid = __builtin_amdgcn_readfirstlane(tid >> 6), lane = tid & 63, r = lane & 31, hh = lane >> 5;
    const int j = item & 7, h = (item >> 3) & 3, b = item >> 5;
    const float lgf2 = -__expf(a.in[12][l * 4 + h]) * LOG2E, lgb2 = -__expf(a.in[13][l * 4 + h]) * LOG2E;
    const int dir = wid >> 2, db = (wid >> 1) & 1, dvp = wid & 1;
    const bf16* kg = proj + ((size_t)b * SEQ + j * 256 + (tid >> 3)) * NINP + C_CK + h * 64 + (tid & 7) * 8;
    const bf16* vg = (const bf16*)(a.ws + WS_VTC) + ((size_t)(b * 4 + h) * 128 + (tid >> 3)) * SEQ + j * 256 + (tid & 7) * 8;
    f32x16 acc0, acc1;
#pragma unroll
    for (int i = 0; i < 16; ++i) { acc0[i] = 0.f; acc1[i] = 0.f; }
    for (int t = 0; t < 4; ++t) {
        const u32x4 kw = *(const u32x4*)(kg + (size_t)t * 64 * NINP);
        const u32x4 v0 = *(const u32x4*)(vg + t * 64), v1 = *(const u32x4*)(vg + t * 64 + 64 * SEQ);
        const int key = tid >> 3, ch = tid & 7, pos = t * 64 + key;
        const float wf = __builtin_amdgcn_exp2f(lgf2 * (float)(256 - pos)), wb = __builtin_amdgcn_exp2f(lgb2 * (float)pos);
        const float kv[8] = {bflo(kw.x), bfhi(kw.x), bflo(kw.y), bfhi(kw.y), bflo(kw.z), bfhi(kw.z), bflo(kw.w), bfhi(kw.w)};
        LAS bf16* ktf = (LAS bf16*)(lds + (ch * 8) * 144 + kpos(key) * 2);
        LAS bf16* ktb = (LAS bf16*)(lds + 9216 + (ch * 8) * 144 + kpos(key) * 2);
#pragma unroll
        for (int e = 0; e < 8; e += 2) { const unsigned pf = pk2(kv[e] * wf, kv[e + 1] * wf), pb = pk2(kv[e] * wb, kv[e + 1] * wb);
            ktf[e * 72] = (bf16)(pf & 0xffffu); ktf[(e + 1) * 72] = (bf16)(pf >> 16); ktb[e * 72] = (bf16)(pb & 0xffffu); ktb[(e + 1) * 72] = (bf16)(pb >> 16); }
        *(LAS u32x4*)(lds + AT_VT + (tid >> 3) * 144 + (tid & 7) * 16) = v0;
        *(LAS u32x4*)(lds + AT_VT + ((tid >> 3) + 64) * 144 + (tid & 7) * 16) = v1;
        __syncthreads();
        LAS unsigned char* abase = lds + dir * 9216 + (32 * db + r) * 144 + (8 * hh) * 2;
        LAS unsigned char* bbase = lds + AT_VT + (64 * dvp + r) * 144 + (8 * hh) * 2;
#pragma unroll
        for (int ks = 0; ks < 4; ++ks) { const bf16x8 af = *(const LAS bf16x8*)(abase + 32 * ks);
            const bf16x8 b0 = *(const LAS bf16x8*)(bbase + 32 * ks), b1 = *(const LAS bf16x8*)(bbase + 32 * 144 + 32 * ks);
            acc0 = MFMA32(af, b0, acc0); acc1 = MFMA32(af, b1, acc1); }
        __syncthreads();
    }
    float* F = (float*)(a.ws + WS_RST) + ((size_t)(dir * 256 + item) * 64 + 32 * db + 4 * hh) * 128 + 64 * dvp + r;
#pragma unroll
    for (int i = 0; i < 16; ++i) { const int drow = (i & 3) + 8 * (i >> 2); F[drow * 128] = acc0[i]; F[drow * 128 + 32] = acc1[i]; }
}

template <int MODE>
__device__ __forceinline__ void attn_dense_unit(const Args& a, int l, int unit, LAS unsigned char* lds, float M2, float lam, float oscale) {
    const bf16* proj = (const bf16*)(a.ws + WS_PROJ);
    const int tid = otid(), wid = __builtin_amdgcn_readfirstlane(tid >> 6), lane = tid & 63, r = lane & 31, hh = lane >> 5;
    constexpr int QROWS = MODE == 0 ? 128 : 256;
    const int g = MODE == 0 ? (wid >> 1) : wid, m = MODE == 0 ? (wid & 1) : 0;
    const int qb = MODE == 0 ? (unit & 15) : (unit & 7), h = MODE == 0 ? ((unit >> 4) & 3) : ((unit >> 3) & 3), b = MODE == 0 ? (unit >> 6) : (unit >> 5);
    const int qcol = MODE == 0 ? C_BQ + (h * 2 + m) * 64 : C_CQ + h * 64;
    const int kcol = MODE == 0 ? C_BK + h * 128 : C_CK + h * 64;
    const size_t rowbase = (size_t)b * SEQ;
    const int nq = qb * QROWS + g * 32 + r;
    bf16x8 qf[4];
#pragma unroll
    for (int kk = 0; kk < 4; ++kk) qf[kk] = *(const bf16x8*)(proj + (rowbase + nq) * NINP + qcol + 16 * kk + 8 * hh);
    float lgf2 = 0.f, lgb2n = 0.f;
    float c1f[4] = {0.f, 0.f, 0.f, 0.f}, c2f[4] = {0.f, 0.f, 0.f, 0.f}, c1b[4] = {0.f, 0.f, 0.f, 0.f}, c2b[4] = {0.f, 0.f, 0.f, 0.f};
    if (MODE == 1) { lgf2 = -__expf(a.in[12][l * 4 + h]) * LOG2E; lgb2n = __expf(a.in[13][l * 4 + h]) * LOG2E;
#pragma unroll
        for (int q = 0; q < 4; ++q) { c1f[q] = __builtin_amdgcn_exp2f(lgf2 * (float)(3 - q)); c2f[q] = __builtin_amdgcn_exp2f(lgf2 * (float)(28 - 4 * hh - 8 * q));
                                      c1b[q] = __builtin_amdgcn_exp2f(-lgb2n * (float)q); c2b[q] = __builtin_amdgcn_exp2f(-lgb2n * (float)(4 * hh + 8 * q)); } }
    f32x16 O[4];
#pragma unroll
    for (int d = 0; d < 4; ++d)
#pragma unroll
        for (int i = 0; i < 16; ++i) O[d][i] = 0.f;
    float lsum = 0.f;
    if constexpr (MODE == 1) {
        const float* Fb_ = (const float*)(a.ws + WS_RST) + (size_t)((b * 4 + h) * 8) * 8192;
        const float cf = __builtin_amdgcn_exp2f(lgf2 * 256.0f), cb = __builtin_amdgcn_exp2f(-lgb2n * 256.0f);
#pragma unroll
        for (int e = 0; e < 4; ++e) { const int idx = tid + 512 * e, d = idx >> 5, dv4 = (idx & 31) * 4;
            f32x4 sf = {0.f, 0.f, 0.f, 0.f}, sb = {0.f, 0.f, 0.f, 0.f}; float w = 1.0f;
            for (int j = qb - 1; j >= 0; --j) { const f32x4 v = *(const f32x4*)(Fb_ + (size_t)j * 8192 + d * 128 + dv4); sf += v * w; w *= cf; }
            w = 1.0f;
            for (int j = qb + 1; j < 8; ++j) { const f32x4 v = *(const f32x4*)(Fb_ + (size_t)(256 + j) * 8192 + d * 128 + dv4); sb += v * w; w *= cb; }
#pragma unroll
            for (int q = 0; q < 4; ++q) { *(LAS bf16*)(lds + 73728 + (dv4 + q) * 144 + d * 2) = (bf16)(pk2(sf[q], 0.f) & 0xffffu); *(LAS bf16*)(lds + 92160 + (dv4 + q) * 144 + d * 2) = (bf16)(pk2(sb[q], 0.f) & 0xffffu); } }
        __syncthreads();
        const float wqf = __builtin_amdgcn_exp2f(lgf2 * (float)(g * 32 + r)), wqb = __builtin_amdgcn_exp2f(-lgb2n * (float)(256 - (g * 32 + r)));
#pragma unroll
        for (int d = 0; d < 4; ++d) { f32x16 of = O[d], ob = O[d];
#pragma unroll
            for (int kk = 0; kk < 4; ++kk) { const bf16x8 af = *(const LAS bf16x8*)(lds + 73728 + (32 * d + r) * 144 + (16 * kk + 8 * hh) * 2);
                const bf16x8 ab = *(const LAS bf16x8*)(lds + 92160 + (32 * d + r) * 144 + (16 * kk + 8 * hh) * 2);
                of = MFMA32(af, qf[kk], of); ob = MFMA32(ab, qf[kk], ob); }
#pragma unroll
            for (int i = 0; i < 16; ++i) O[d][i] = of[i] * wqf + ob[i] * wqb; }
    }
    const int lk_key = tid >> 3, lk_ch = tid & 7;
    const bf16* kg = proj + (rowbase + lk_key) * NINP + kcol + lk_ch * 8;
    const bf16* vg = (const bf16*)(a.ws + (MODE == 0 ? WS_VTB : WS_VTC)) + ((size_t)(b * 4 + h) * 128 + (tid >> 3)) * SEQ + (tid & 7) * 8;
    u32x4 kr0, kr1, vr0, vr1;
    constexpr int NTALL = SEQ / 64, NT = MODE == 0 ? NTALL : 4;
    const int kt0 = ((QROWS / 64) * qb) & (NTALL - 1);
    { const size_t o = (size_t)kt0 * 64 * NINP;
      kr0 = *(const u32x4*)(kg + o); if (MODE == 0) kr1 = *(const u32x4*)(kg + o + 64);
      vr0 = *(const u32x4*)(vg + kt0 * 64); vr1 = *(const u32x4*)(vg + kt0 * 64 + 64 * SEQ); }
    for (int it = 0; it < NT; ++it) {
        const int kt = (it + kt0) & (NTALL - 1);
        LAS unsigned char* st = lds + (it & 1) * AT_STAGE;
        *(LAS u32x4*)(st + lk_key * 144 + lk_ch * 16) = kr0;
        if (MODE == 0) *(LAS u32x4*)(st + AT_KOFF + lk_key * 144 + lk_ch * 16) = kr1;
        *(LAS u32x4*)(st + AT_VT + lk_key * 144 + lk_ch * 16) = vr0;
        *(LAS u32x4*)(st + AT_VT + (lk_key + 64) * 144 + lk_ch * 16) = vr1;
        __syncthreads();
        if (it + 1 < NT) {
            const int kn = (kt + 1) & (NTALL - 1);
            const size_t o = (size_t)kn * 64 * NINP;
            kr0 = *(const u32x4*)(kg + o); if (MODE == 0) kr1 = *(const u32x4*)(kg + o + 64);
            vr0 = *(const u32x4*)(vg + kn * 64); vr1 = *(const u32x4*)(vg + kn * 64 + 64 * SEQ);
        }
#define SCORE_TO_P(acc, kb, p) do { \
            if (MODE == 0) { _Pragma("unroll") for (int i = 0; i < 16; ++i) { p[i] = __builtin_amdgcn_exp2f(acc[i]); lsum += p[i]; } } \
            else { const int mk0 = kt * 64 + 32 * (kb), q0w = qb * QROWS + g * 32; \
                if (mk0 + 31 < q0w) { const float A_ = __builtin_amdgcn_exp2f(lgf2 * (float)(nq - mk0 - 31)); float c2_[4]; \
                    _Pragma("unroll") for (int bq = 0; bq < 4; ++bq) c2_[bq] = A_ * c2f[bq]; \
                    _Pragma("unroll") for (int i = 0; i < 16; ++i) p[i] = acc[i] * (c2_[i >> 2] * c1f[i & 3]); } \
                else if (mk0 > q0w + 31) { const float A_ = __builtin_amdgcn_exp2f(-lgb2n * (float)(mk0 - nq)); float c2_[4]; \
                    _Pragma("unroll") for (int bq = 0; bq < 4; ++bq) c2_[bq] = A_ * c2b[bq]; \
                    _Pragma("unroll") for (int i = 0; i < 16; ++i) p[i] = acc[i] * (c2_[i >> 2] * c1b[i & 3]); } \
                else { const int dbase_ = nq - (mk0 + 4 * hh); \
                    _Pragma("unroll") for (int i = 0; i < 16; ++i) { const int d_ = dbase_ - ((i & 3) + 8 * (i >> 2)); const float df_ = (float)d_; \
                        const float e_ = df_ * (d_ > 0 ? lgf2 : lgb2n); float D_ = __builtin_amdgcn_exp2f(e_); D_ = (d_ == 0) ? 2.0f : D_; p[i] = acc[i] * D_; } } } } while (0)
        {
            LAS unsigned char* kbase = st + (MODE == 0 ? m * AT_KOFF : 0) + r * 144 + (8 * hh) * 2;
            LAS unsigned char* vbase = st + AT_VT + r * 144 + (8 * hh) * 2;
            bf16x8 kf0[4], kf1[4], vf[8];
#pragma unroll
            for (int kk = 0; kk < 4; ++kk) kf0[kk] = *(const LAS bf16x8*)(kbase + 32 * kk);
#pragma unroll
            for (int kk = 0; kk < 4; ++kk) kf1[kk] = *(const LAS bf16x8*)(kbase + 32 * 144 + 32 * kk);
#pragma unroll
            for (int dvb = 0; dvb < 4; ++dvb) { vf[2 * dvb] = *(const LAS bf16x8*)(vbase + dvb * 32 * 144); vf[2 * dvb + 1] = *(const LAS bf16x8*)(vbase + dvb * 32 * 144 + 32); }
            __builtin_amdgcn_sched_barrier(0);
            f32x16 acc0, acc1;
#pragma unroll
            for (int i = 0; i < 16; ++i) { acc0[i] = MODE == 0 ? -M2 : 0.f; acc1[i] = MODE == 0 ? -M2 : 0.f; }
#pragma unroll
            for (int kk = 0; kk < 4; ++kk) acc0 = MFMA32(kf0[kk], qf[kk], acc0);
#pragma unroll
            for (int kk = 0; kk < 4; ++kk) acc1 = MFMA32(kf1[kk], qf[kk], acc1);
            __builtin_amdgcn_sched_barrier(0);
            float p[16];
            SCORE_TO_P(acc0, 0, p);
            const bf16x8 pf00 = pack8(p[0], p[1], p[2], p[3], p[4], p[5], p[6], p[7]);
            const bf16x8 pf01 = pack8(p[8], p[9], p[10], p[11], p[12], p[13], p[14], p[15]);
            __builtin_amdgcn_sched_barrier(0);
#pragma unroll
            for (int dvb = 0; dvb < 4; ++dvb) O[dvb] = MFMA32(vf[2 * dvb], pf00, O[dvb]);
#pragma unroll
            for (int dvb = 0; dvb < 4; ++dvb) O[dvb] = MFMA32(vf[2 * dvb + 1], pf01, O[dvb]);
#pragma unroll
            for (int dvb = 0; dvb < 4; ++dvb) { vf[2 * dvb] = *(const LAS bf16x8*)(vbase + 64 + dvb * 32 * 144); vf[2 * dvb + 1] = *(const LAS bf16x8*)(vbase + 64 + dvb * 32 * 144 + 32); }
            SCORE_TO_P(acc1, 1, p);
            const bf16x8 pf10 = pack8(p[0], p[1], p[2], p[3], p[4], p[5], p[6], p[7]);
            const bf16x8 pf11 = pack8(p[8], p[9], p[10], p[11], p[12], p[13], p[14], p[15]);
            __builtin_amdgcn_sched_barrier(0);
#pragma unroll
            for (int dvb = 0; dvb < 4; ++dvb) O[dvb] = MFMA32(vf[2 * dvb], pf10, O[dvb]);
#pragma unroll
            for (int dvb = 0; dvb < 4; ++dvb) O[dvb] = MFMA32(vf[2 * dvb + 1], pf11, O[dvb]);
        }
#undef SCORE_TO_P
    }
    __syncthreads();
    if (MODE == 0) { const float linv = 1.0f / (lsum + shx(lsum, 32, lane));
#pragma unroll
        for (int d = 0; d < 4; ++d)
#pragma unroll
            for (int i = 0; i < 16; ++i) O[d][i] *= linv; }
    LAS float* ex = (LAS float*)(lds + g * 16384) + lane;
    if (MODE == 0 && m == 1) {
#pragma unroll
        for (int d = 0; d < 4; ++d)
#pragma unroll
            for (int i = 0; i < 16; ++i) ex[(d * 16 + i) * 64] = O[d][i];
    }
    __syncthreads();
    if (m == 0) {
        float ss = 0.f;
#pragma unroll
        for (int d = 0; d < 4; ++d)
#pragma unroll
            for (int i = 0; i < 16; ++i) { float o = O[d][i]; if (MODE == 0) { o -= lam * ex[(d * 16 + i) * 64]; O[d][i] = o; } ss += o * o; }
        ss += shx(ss, 32, lane);
        const float rr = (1.0f / sqrtf(ss * (1.f / 128.f) + NORM_EPS)) * oscale;
        const float* gout = MODE == 0 ? a.in[11] + l * 128 : a.in[14] + l * 128;
        const size_t trow = rowbase + nq;
        bf16* yo = (bf16*)(a.ws + (MODE == 0 ? WS_YB : WS_YC)) + trow * 512 + h * 128 + 4 * hh;
        const bf16* cg = proj + trow * NINP + C_CG + h * 128 + 4 * hh;
#pragma unroll
        for (int d = 0; d < 4; ++d)
#pragma unroll
            for (int q = 0; q < 4; ++q) {
                const int dv = 32 * d + 8 * q;
                const f32x4 gg = *(const f32x4*)(gout + dv + 4 * hh);
                float y0 = O[d][4 * q] * rr * gg.x, y1 = O[d][4 * q + 1] * rr * gg.y, y2 = O[d][4 * q + 2] * rr * gg.z, y3 = O[d][4 * q + 3] * rr * gg.w;
                if (MODE == 1) { const u32x2 cw = *(const u32x2*)(cg + dv);
                    const float c0 = bflo(cw.x), c1 = bfhi(cw.x), c2 = bflo(cw.y), c3 = bfhi(cw.y);
                    y0 *= c0 / (1.0f + __expf(-c0)); y1 *= c1 / (1.0f + __expf(-c1)); y2 *= c2 / (1.0f + __expf(-c2)); y3 *= c3 / (1.0f + __expf(-c3)); }
                u32x2 w; w.x = pk2(y0, y1); w.y = pk2(y2, y3); *(u32x2*)(yo + dv) = w;
            }
    }
    __syncthreads();
}

#ifndef PHM
#define PHM 0xFFFF
#endif
#ifndef DBL
#define DBL 0
#endif
#define REP(k) for (int rep_ = 0; rep_ < (((DBL >> (k)) & 1) ? 2 : 1); ++rep_)
#define PH(k) if constexpr ((PHM >> (k)) & 1)
#define XB_TMO      128
#define XB_XCNT(j)  (256  + 64 * (j))
#define XB_XSUB(j)  (1280 + 64 * (j))
#define XB_XGEN(j)  (2304 + 64 * (j))
#define XB_TOP      3328
#define XB_TOPGEN   3392
#define XCD_BAR_WORDS 3456
#define XB_SPIN_CAP (1u << 18)

__device__ __forceinline__ unsigned xb_ld(unsigned* p)              { return __hip_atomic_load(p, __ATOMIC_RELAXED, __HIP_MEMORY_SCOPE_AGENT); }
__device__ __forceinline__ unsigned xb_add(unsigned* p, unsigned v) { return __hip_atomic_fetch_add(p, v, __ATOMIC_RELAXED, __HIP_MEMORY_SCOPE_AGENT); }
__device__ __forceinline__ unsigned xb_xcc_id() { return (unsigned)__builtin_amdgcn_s_getreg((3 << 11) | 20) & 0xFu; }
#define XB_SPIN(cond, bar) do { unsigned _sp = 0; while (cond) { __builtin_amdgcn_s_sleep(1); \
    if ((++_sp & 255u) == 0u) { if (xb_ld(&(bar)[XB_TMO])) break; if (_sp > XB_SPIN_CAP) { atomicAdd(&(bar)[XB_TMO], 1u); break; } } } } while (0)

struct XcdBarrier {
    unsigned* bar; unsigned x;
    volatile LAS unsigned* st;
};

__device__ __forceinline__ XcdBarrier xcd_barrier_post(unsigned* bar, volatile LAS unsigned* st) {
    XcdBarrier b; b.bar = bar; b.x = xb_xcc_id(); b.st = st;
    if (threadIdx.x == 0) (void)xb_add(&bar[XB_XCNT(b.x)], 1u);
    return b;
}
__device__ __forceinline__ void xcd_barrier_complete(unsigned* bar, unsigned x, unsigned& nloc, unsigned& nx) {
    const unsigned G = gridDim.x * gridDim.y * gridDim.z;
    unsigned sum, cnt, mine, sp = 0u;
    for (;;) {
        sum = 0u; cnt = 0u; mine = 0u;
#pragma unroll
        for (unsigned j = 0; j < 16; ++j) { const unsigned c = xb_ld(&bar[XB_XCNT(j)]); sum += c; cnt += (c > 0u) ? 1u : 0u; mine = (j == x) ? c : mine; }
        if (sum == G) break;
        __builtin_amdgcn_s_sleep(1);
        if ((++sp & 255u) == 0u) { if (xb_ld(&bar[XB_TMO])) break; if (sp > XB_SPIN_CAP) { atomicAdd(&bar[XB_TMO], 1u); break; } }
    }
    nloc = mine > 0u ? mine : 1u; nx = cnt > 0u ? cnt : 1u;
}

__device__ __forceinline__ void xcd_barrier(const XcdBarrier& b) {
    asm volatile("s_waitcnt vmcnt(0)" ::: "memory");
    __syncthreads();
    if (threadIdx.x == 0) {
        unsigned* bar = b.bar;
        __builtin_amdgcn_s_waitcnt(0);
        unsigned nloc = b.st[0], nx = b.st[1];
        if (nloc == 0u) { xcd_barrier_complete(bar, b.x, nloc, nx); b.st[0] = nloc; b.st[1] = nx; }
        const unsigned old = xb_add(&bar[XB_XSUB(b.x)], 1u);
        const unsigned gen = old / nloc;
        if (old + 1u == (gen + 1u) * nloc) {
            __builtin_amdgcn_fence(__ATOMIC_RELEASE, "agent");
            asm volatile("s_waitcnt vmcnt(0)" ::: "memory");
            const unsigned og = xb_add(&bar[XB_TOP], 1u);
            const unsigned tg = og / nx;
            if (og + 1u == (tg + 1u) * nx) xb_add(&bar[XB_TOPGEN], 1u);
            else XB_SPIN(xb_ld(&bar[XB_TOPGEN]) == tg, bar);
            __builtin_amdgcn_fence(__ATOMIC_ACQUIRE, "agent");
            xb_add(&bar[XB_XGEN(b.x)], 1u);
            asm volatile("s_waitcnt vmcnt(0)" ::: "memory");
        } else {
            XB_SPIN(xb_ld(&bar[XB_XGEN(b.x)]) == gen, bar);
            __builtin_amdgcn_fence(__ATOMIC_ACQUIRE, "agent");
            asm volatile("s_waitcnt vmcnt(0)" ::: "memory");
        }
    }
    __syncthreads();
}

typedef __attribute__((address_space(4))) const Args* CArgsP;
__device__ __forceinline__ Args load_args() {
    Args r{};
#if defined(__HIP_DEVICE_COMPILE__)
    CArgsP p = (CArgsP)__builtin_amdgcn_kernarg_segment_ptr(); asm volatile("" : "+s"(p));
#pragma unroll
    for (int i = 0; i < 22; ++i) r.in[i] = p->in[i];
    r.out = p->out; r.ws = p->ws;
#endif
    return r;
}
#define TIDS() const int tid = otid(), lane = tid & 63, wave = __builtin_amdgcn_readfirstlane(tid >> 6), gw = bx * NWAVES + wave, gtid = bx * NTHR + tid; (void)lane; (void)gw; (void)gtid
__global__ void __launch_bounds__(NTHR, 2) fwd_megakernel(Args a_unused) {
    extern __shared__ __attribute__((aligned(16))) unsigned char lds_raw[];
    LAS unsigned char* lds = (LAS unsigned char*)lds_raw;
    cg::grid_group grid = cg::this_grid();
    const int G = gridDim.x, bx = blockIdx.x;
    const int NGW = G * NWAVES, NT = G * NTHR;
    if (threadIdx.x < 2) ((volatile LAS unsigned*)(lds + MISC_OFF))[threadIdx.x] = 0u;
    __syncthreads();
    { const Args a = load_args(); (void)xcd_barrier_post((unsigned*)(a.ws + WS_CTL), (volatile LAS unsigned*)(lds + MISC_OFF)); }
#define GSYNC() do { const Args a_ = load_args(); XcdBarrier b_; b_.bar = (unsigned*)(a_.ws + WS_CTL); b_.x = xb_xcc_id(); b_.st = (volatile LAS unsigned*)(lds + MISC_OFF); xcd_barrier(b_); } while (0)

    for (int l = 0; l < DEPTH; ++l) {
        PH(0) REP(0) { const Args a = load_args(); TIDS(); phase_prep(a, l, lds, gw, NGW, wave, lane, (l == 0) ? a.in[0] : a.out); }
        { const Args a_ = load_args(); if (a_.ws == nullptr) grid.sync(); }
        GSYNC();
        if constexpr ((DBL >> 8) & 1) { for (int i_ = 0; i_ < 10; ++i_) GSYNC(); }
        PH(1) REP(1) { const Args a = load_args(); unsigned char* ws = a.ws;
          pg8::Gemm g{(const bf16*)(ws + WS_ACT), (const bf16*)(ws + WS_WIN), M, NINP, DM}; pg8::StaticOrder S; S.init(M, NINP, G, bx);
          pg8::EpiStore<0> E{(bf16*)(ws + WS_PROJ), NINP};
          pg8::gemm_phase<pg8::EpiStore<0>, pg8::StaticOrder, true, true>(lds, g, S, E); }
        GSYNC();
        PH(2) { const Args a = load_args(); TIDS(); phase_postproj(a, l, gtid, NT, lane);
                for (int it = gw; it < 2048; it += NGW) { const int c = it >> 10;
                    vt_item((const bf16*)(a.ws + WS_PROJ), (bf16*)(a.ws + (c ? WS_VTC : WS_VTB)), c ? C_CV : C_BV, it & 1023, lds + wave * 17408, lane); } }
        GSYNC();
        {
            const Args a = load_args(); TIDS();
            PH(5) { if (G == 256) { if (bx >= 128) for (int it = bx - 128; it < 256; it += 128) ret_state_item(a, l, it, lds); }
                    else for (int it = bx; it < 256; it += G) ret_state_item(a, l, it, lds); }
            PH(3) {
            const float gqa = wave_max(fabsf(a.in[3][l * 64 + lane]), lane), gka = wave_max(fabsf(a.in[4][l * 64 + lane]), lane);
            const float M2a = 8.0f * LOG2E * gqa * gka;
            REP(2) for (int it = gw; it < 3072; it += NGW) attn_a_item(a, it, lds + wave * 16384, lane, M2a);
            }
            __syncthreads();
            PH(4) {
            const float gqb = wave_max(fabsf(a.in[5][l * 64 + lane]), lane), gkb = wave_max(fabsf(a.in[6][l * 64 + lane]), lane);
            const float M2b = 8.0f * LOG2E * gqb * gkb;
            const float lam_init = 0.8f - 0.6f * expf(-0.3f * (float)l);
            const float s1 = wave_sum(a.in[7][l * 64 + lane] * a.in[8][l * 64 + lane], lane), s2 = wave_sum(a.in[9][l * 64 + lane] * a.in[10][l * 64 + lane], lane);
            const float lam = expf(s1) - expf(s2) + lam_init;
            REP(3) for (int u0 = bx; u0 < 512; u0 += G) { const int v = u0 & 255, u = (((v & 7) * 2 + (v >> 7)) + 16 * (u0 >> 8)) * 16 + ((v >> 3) & 15); attn_dense_unit<0>(a, l, u, lds, M2b, lam, 1.0f - lam_init); }
            }
        }
        GSYNC();
        {
            const Args a = load_args(); TIDS();
            PH(5) REP(4) for (int u0 = bx; u0 < 256; u0 += G) { const int u = ((u0 & 7) * 4 + (u0 >> 6)) * 8 + ((u0 >> 3) & 7); attn_dense_unit<1>(a, l, u, lds, 0.f, 0.f, 1.0f); }
            const float* lA = (const float*)(a.ws + WS_LA); bf16* ya = (bf16*)(a.ws + WS_YA);
            for (int e0 = gtid; e0 < M * 48; e0 += 3 * NT) {
                u32x4 w[3]; float lt[3]; u32x4* pp[3];
#pragma unroll
                for (int q = 0; q < 3; ++q) { int e = e0 + q * NT; e = e < M * 48 ? e : e0; const int t = e / 48, ch = e % 48, hg = (ch >> 3) & 1;
                    lt[q] = lA[t * 6 + hg] + lA[t * 6 + 2 + hg] + lA[t * 6 + 4 + hg]; pp[q] = (u32x4*)(ya + (size_t)t * 384 + ch * 8); w[q] = *pp[q]; }
#pragma unroll
                for (int q = 0; q < 3; ++q) { const float li = 1.0f / lt[q]; u32x4 v = w[q];
                    v.x = pk2(bflo(v.x) * li, bfhi(v.x) * li); v.y = pk2(bflo(v.y) * li, bfhi(v.y) * li);
                    v.z = pk2(bflo(v.z) * li, bfhi(v.z) * li); v.w = pk2(bflo(v.w) * li, bfhi(v.w) * li); *pp[q] = v; }
            }
        }
        GSYNC();
        PH(6) {
          { const Args a = load_args(); unsigned char* ws = a.ws; pg8::StaticOrder S; S.init(M, DM, G, bx);
            pg8::Gemm g{(const bf16*)(ws + WS_YA), (const bf16*)(ws + WS_WBRA), M, DM, 384}; pg8::EpiGate<0> E{(const bf16*)(ws + WS_PROJ) + C_GATE, NINP, nullptr, (bf16*)(ws + WS_T1)};
            pg8::gemm_phase<pg8::EpiGate<0>, pg8::StaticOrder, true, true>(lds, g, S, E); }
          { const Args a = load_args(); unsigned char* ws = a.ws; pg8::StaticOrder S; S.init(M, DM, G, bx);
            pg8::Gemm g{(const bf16*)(ws + WS_YB), (const bf16*)(ws + WS_WBRB), M, DM, 512}; pg8::EpiGate<1> E{(const bf16*)(ws + WS_PROJ) + C_GATE + 1024, NINP, (const bf16*)(ws + WS_T1), (bf16*)(ws + WS_T2)};
            pg8::gemm_phase<pg8::EpiGate<1>, pg8::StaticOrder, true, true>(lds, g, S, E); }
          { const Args a = load_args(); unsigned char* ws = a.ws; pg8::StaticOrder S; S.init(M, DM, G, bx);
            pg8::Gemm g{(const bf16*)(ws + WS_YC), (const bf16*)(ws + WS_WBRC), M, DM, 512}; pg8::EpiGate<1> E{(const bf16*)(ws + WS_PROJ) + C_GATE + 2048, NINP, (const bf16*)(ws + WS_T2), (bf16*)(ws + WS_ACT)};
            pg8::gemm_phase<pg8::EpiGate<1>, pg8::StaticOrder, true, true>(lds, g, S, E); } }
        GSYNC();
        PH(7) { const Args a = load_args(); unsigned char* ws = a.ws;
          pg8::Gemm g{(const bf16*)(ws + WS_ACT), (const bf16*)(ws + WS_WO), M, DM, DM}; pg8::StaticOrder S; S.init(M, DM, G, bx);
          pg8::EpiResid E{(l == 0) ? a.in[0] : a.out, a.out};
          pg8::gemm_phase<pg8::EpiResid, pg8::StaticOrder, true, true>(lds, g, S, E); }
        GSYNC();
        { const Args a = load_args(); TIDS(); const float* g2 = a.in[19] + (size_t)l * DM; bf16* act = (bf16*)(a.ws + WS_ACT);
          rms_rows_to_bf16(a.out, g2, act, gw, NGW, lane); }
        GSYNC();
        PH(8) { const Args a = load_args(); unsigned char* ws = a.ws;
          pg8::Gemm g{(const bf16*)(ws + WS_ACT), (const bf16*)(ws + WS_W1), M, DFF, DM}; pg8::StaticOrder S; S.init(M, DFF, G, bx);
          pg8::EpiStore<1> E{(bf16*)(ws + WS_H), DFF};
          pg8::gemm_phase<pg8::EpiStore<1>, pg8::StaticOrder, true, true>(lds, g, S, E); }
        GSYNC();
        PH(9) { const Args a = load_args(); unsigned char* ws = a.ws;
          pg8::Gemm g{(const bf16*)(ws + WS_H), (const bf16*)(ws + WS_W2), M, DM, DFF}; pg8::StaticOrder S; S.init(M, DM, G, bx);
          pg8::EpiResid E{a.out, a.out};
          pg8::gemm_phase<pg8::EpiResid, pg8::StaticOrder, true, true>(lds, g, S, E); }
        GSYNC();
    }
}

extern "C" void kernel_launch(void* const* d_in, const int* in_sizes, int n_in, void* d_out, int out_size, void* d_ws, size_t ws_size, hipStream_t stream) {
    static int grid = 0;
    if (grid == 0) {
        if (n_in != 22 || out_size != M * DM || ws_size < WS_CTL + CTL_BYTES) { fprintf(stderr, "kernel_launch: unexpected shapes (n_in %d out %d ws %zu)\n", n_in, out_size, ws_size); grid = -1; return; }
        int dev = 0, cus = 0, per_cu = 0;
        hipGetDevice(&dev); hipDeviceGetAttribute(&cus, hipDeviceAttributeMultiprocessorCount, dev);
        hipFuncSetAttribute((const void*)fwd_megakernel, hipFuncAttributeMaxDynamicSharedMemorySize, LDS_BYTES);
        hipOccupancyMaxActiveBlocksPerMultiprocessor(&per_cu, (const void*)fwd_megakernel, NTHR, LDS_BYTES);
        if (per_cu < 1) { fprintf(stderr, "kernel_launch: occupancy query says %d blocks/CU\n", per_cu); per_cu = 1; }
        (void)hipGetLastError();
        grid = cus;
    }
    if (grid < 0) return;
    if (hipMemsetAsync((char*)d_ws + WS_CTL, 0, CTL_BYTES, stream) != hipSuccess) { fprintf(stderr, "kernel_launch: memset failed\n"); return; }
    Args a{};
    for (int i = 0; i < 22; ++i) a.in[i] = (const float*)d_in[i];
    a.out = (float*)d_out; a.ws = (unsigned char*)d_ws;
    void* args[] = {&a};
    hipError_t e = hipLaunchCooperativeKernel((const void*)fwd_megakernel, dim3(grid), dim3(NTHR), args, LDS_BYTES, stream);
    if (e != hipSuccess) fprintf(stderr, "cooperative launch failed: %s (grid %d)\n", hipGetErrorString(e), grid);
}
```

```cpp
#include <hip/hip_runtime.h>
#include <hip/hip_cooperative_groups.h>
#include <cstdio>
#include <cstdint>
namespace cg = cooperative_groups;
namespace pg8 {
#define PG8_LAS __attribute__((address_space(3)))
typedef unsigned short bf16_t;
typedef short bf16x8 __attribute__((ext_vector_type(8)));
typedef float f32x4 __attribute__((ext_vector_type(4)));
typedef unsigned u32x4 __attribute__((ext_vector_type(4)));
constexpr int BM = 256, BK = 64, HALF = 128, HTB = HALF * BK * 2  , STAGE_BYTES = 8 * HTB, NXCD = 8, WGM = 8;

__host__ __device__ __forceinline__ int lds_byte(int r, int c) { const int st = (r >> 4) * 2 + (c >> 5), rr = r & 15, cc = c & 31, ob = rr * 64 + cc * 2; return st * 1024 + (ob ^ (((ob >> 9) & 1) << 5)); }
__host__ __device__ __forceinline__ void stage_rc(int b, int& R, int& C) { const int st = b / 1024, sb = b % 1024, swz = sb ^ (((sb >> 9) & 1) << 5); R = (st >> 1) * 16 + swz / 64; C = (st & 1) * 32 + (swz % 64) / 2; }
__host__ __device__ __forceinline__ int perm32(int rho) { const int n = rho >> 4, i = rho & 15; return 8 * (i >> 2) + 4 * n + (i & 3); }

struct Unit { int pm, pn; };
struct Gemm { const bf16_t* A; const bf16_t* Bt; int M, N, K; };

struct StaticOrder {
    int nM, nN, nwg, G, c;
    __host__ __device__ void init(int M, int N, int G_, int c_) { nM = M / BM; nN = N / BM; nwg = nM * nN; G = G_; c = c_; }
    __host__ __device__ bool next(int i, Unit& u) const {
        const long L = (long)i * G + c; if (L >= nwg) return false;
        int wgid = (int)L; { const int q = nwg / NXCD, r = nwg % NXCD, xcd = wgid % NXCD, off = wgid / NXCD; wgid = (xcd < r ? xcd * (q + 1) : r * (q + 1) + (xcd - r) * q) + off; }
        const int nig = WGM * nN, gid = wgid / nig, fm = gid * WGM, gsz = (nM - fm) < WGM ? (nM - fm) : WGM;
        u.pm = fm + ((wgid % nig) % gsz); u.pn = (wgid % nig) / gsz; return true;
    }
    __device__ __forceinline__ void a_ready(const Unit&) const {}
    __device__ __forceinline__ void done(const Unit&) const {}
};

__device__ __forceinline__ unsigned cvt_pk_bf16(float lo, float hi) { unsigned r; asm volatile("v_cvt_pk_bf16_f32 %0, %1, %2" : "=v"(r) : "v"(lo), "v"(hi)); return r; }
typedef float f32x2 __attribute__((ext_vector_type(2)));
typedef unsigned u32x2 __attribute__((ext_vector_type(2)));
__device__ __forceinline__ float bflo(unsigned w) { return __uint_as_float(w << 16); }
__device__ __forceinline__ float bfhi(unsigned w) { return __uint_as_float(w & 0xffff0000u); }
template <int ACT> struct EpiStore {
    static constexpr bool PERM = true, AFTER_DRAIN = false;
    bf16_t* O; int ldc;
    __device__ __forceinline__ void operator()(const f32x4 (&acc)[2][2][4][2], const Unit& u, int wr, int wc, int fr, int fq) const {
        const int row0 = u.pm * BM + wr * 64 + fr, col0 = u.pn * BM + wc * 32 + 8 * fq;
#pragma unroll
        for (int ai = 0; ai < 2; ++ai)
#pragma unroll
            for (int m = 0; m < 4; ++m) { const unsigned off = ((unsigned)(row0 + ai * HALF + m * 16) * (unsigned)ldc + (unsigned)col0) * 2u;
#pragma unroll
                for (int bj = 0; bj < 2; ++bj) { f32x4 v0 = acc[ai][bj][m][0], v1 = acc[ai][bj][m][1];
                    if (ACT == 1) {
#pragma unroll
                        for (int e = 0; e < 4; ++e) { float a = fmaxf(v0[e], 0.f), b = fmaxf(v1[e], 0.f); v0[e] = a * a; v1[e] = b * b; } }
                    u32x4 w; w.x = cvt_pk_bf16(v0[0], v0[1]); w.y = cvt_pk_bf16(v0[2], v0[3]); w.z = cvt_pk_bf16(v1[0], v1[1]); w.w = cvt_pk_bf16(v1[2], v1[3]);
                    *(u32x4*)((char*)O + off + (unsigned)(bj * HALF) * 2u) = w; } }
    }
};
template <int HAS_IN> struct EpiGate {
    static constexpr bool PERM = true, AFTER_DRAIN = false;
    const bf16_t* gate; int ldg; const bf16_t* Tin; bf16_t* Tout;
    __device__ __forceinline__ void operator()(const f32x4 (&acc)[2][2][4][2], const Unit& u, int wr, int wc, int fr, int fq) const {
        const int row0 = u.pm * BM + wr * 64 + fr, col0 = u.pn * BM + wc * 32 + 8 * fq;
#pragma unroll
        for (int ai = 0; ai < 2; ++ai)
#pragma unroll
            for (int mp = 0; mp < 2; ++mp) {
                u32x4 gw[2][2], tw[2][2];
#pragma unroll
                for (int mm = 0; mm < 2; ++mm)
#pragma unroll
                    for (int bj = 0; bj < 2; ++bj) { const unsigned row = (unsigned)(row0 + ai * HALF + (2 * mp + mm) * 16);
                        gw[mm][bj] = *(const u32x4*)((const char*)gate + (row * (unsigned)ldg + (unsigned)(col0 + bj * HALF)) * 2u);
                        if (HAS_IN) tw[mm][bj] = *(const u32x4*)((const char*)Tin + (row * 1024u + (unsigned)(col0 + bj * HALF)) * 2u); else tw[mm][bj] = (u32x4){0u, 0u, 0u, 0u}; }
                asm volatile("" ::: "memory");
#pragma unroll
                for (int mm = 0; mm < 2; ++mm)
#pragma unroll
                    for (int bj = 0; bj < 2; ++bj) { const int m = 2 * mp + mm; const unsigned row = (unsigned)(row0 + ai * HALF + m * 16);
                        const f32x4 v0 = acc[ai][bj][m][0], v1 = acc[ai][bj][m][1]; const u32x4 g4 = gw[mm][bj], t4 = tw[mm][bj];
                        const float gg[8] = {bflo(g4.x), bfhi(g4.x), bflo(g4.y), bfhi(g4.y), bflo(g4.z), bfhi(g4.z), bflo(g4.w), bfhi(g4.w)};
                        const float ti[8] = {bflo(t4.x), bfhi(t4.x), bflo(t4.y), bfhi(t4.y), bflo(t4.z), bfhi(t4.z), bflo(t4.w), bfhi(t4.w)};
                        float o[8];
#pragma unroll
                        for (int e = 0; e < 8; ++e) { const float s = __builtin_amdgcn_rcpf(1.0f + __builtin_amdgcn_exp2f(-1.4426950408889634f * gg[e])); o[e] = ti[e] + s * (e < 4 ? v0[e & 3] : v1[e & 3]); }
                        u32x4 w; w.x = cvt_pk_bf16(o[0], o[1]); w.y = cvt_pk_bf16(o[2], o[3]); w.z = cvt_pk_bf16(o[4], o[5]); w.w = cvt_pk_bf16(o[6], o[7]);
                        *(u32x4*)((char*)Tout + (row * 1024u + (unsigned)(col0 + bj * HALF)) * 2u) = w; }
                asm volatile("" ::: "memory"); }
    }
};
struct EpiResid {
    static constexpr bool PERM = false, AFTER_DRAIN = false;
    const float* base; float* out;
    __device__ __forceinline__ void operator()(const f32x4 (&acc)[2][2][4][2], const Unit& u, int wr, int wc, int fr, int fq) const {
        const int row0 = u.pm * BM + wr * 64 + fr, col0 = u.pn * BM + wc * 32 + 4 * fq;
#pragma unroll
        for (int ai = 0; ai < 2; ++ai)
#pragma unroll
            for (int mp = 0; mp < 2; ++mp) {
                f32x4 bs[2][2][2];
#pragma unroll
                for (int mm = 0; mm < 2; ++mm)
#pragma unroll
                    for (int bj = 0; bj < 2; ++bj)
#pragma unroll
                        for (int n = 0; n < 2; ++n) bs[mm][bj][n] = *(const f32x4*)((const char*)base + ((unsigned)(row0 + ai * HALF + (2 * mp + mm) * 16) * 1024u + (unsigned)(col0 + bj * HALF + n * 16)) * 4u);
                asm volatile("" ::: "memory");
#pragma unroll
                for (int mm = 0; mm < 2; ++mm)
#pragma unroll
                    for (int bj = 0; bj < 2; ++bj)
#pragma unroll
                        for (int n = 0; n < 2; ++n) *(f32x4*)((char*)out + ((unsigned)(row0 + ai * HALF + (2 * mp + mm) * 16) * 1024u + (unsigned)(col0 + bj * HALF + n * 16)) * 4u) = bs[mm][bj][n] + acc[ai][bj][2 * mp + mm][n];
                asm volatile("" ::: "memory"); }
    }
};

template <class Epi, class Sched, bool ALIGN_EPI = false, bool SP2 = false>
__device__ __forceinline__ void gemm_phase(PG8_LAS unsigned char* lds, const Gemm g, const Sched& S, const Epi& E) {
    int tid_ = threadIdx.x; asm volatile("" : "+v"(tid_));
    const int tid = tid_, wid = __builtin_amdgcn_readfirstlane(tid >> 6), lane = tid & 63, wr = wid >> 2, wc = wid & 3, fr = lane & 15, fq = lane >> 4;
    const int K = g.K, nt = K / BK;
    unsigned voffA[2], voffB[2];
#pragma unroll
    for (int i = 0; i < 2; ++i) { int R, C; stage_rc(tid * 16 + i * 8192, R, C); const int Rb = Epi::PERM ? ((R & ~31) + perm32(R & 31)) : R;
        voffA[i] = (unsigned)(R * K + C) * 2u; voffB[i] = (unsigned)(Rb * K + C) * 2u; }
    const size_t kstep = (size_t)(BK * 2);
    const size_t hstep = (size_t)HALF * K * 2;
    const size_t tstep = 2 * hstep;
    const unsigned ldsw = (unsigned)wid * 1024u;
    const int aoff = lds_byte(wr * 64 + fr, fq * 8), boff = lds_byte(wc * 32 + fr, fq * 8);
#define PG8_SA(b, h) (((b) * 2 + (h)) * HTB)
#define PG8_SB(b, h) ((4 + (b) * 2 + (h)) * HTB)
#define PG8_STAGE(bufoff, gbase, voff) do { _Pragma("unroll") for (int _i = 0; _i < 2; ++_i) \
        __builtin_amdgcn_global_load_lds((const unsigned*)((const char*)(gbase) + (voff)[_i]), (PG8_LAS unsigned*)(lds + (bufoff) + ldsw + _i * 8192), 16, 0, 0); } while (0)
#define PG8_LDA(dst, b, h) do { _Pragma("unroll") for (int m = 0; m < 4; ++m) _Pragma("unroll") for (int k = 0; k < 2; ++k) dst[m][k] = *(const PG8_LAS bf16x8*)(lds + PG8_SA(b, h) + aoff + m * 2048 + k * 1024); } while (0)
#define PG8_LDB(dst, b, h) do { _Pragma("unroll") for (int n = 0; n < 2; ++n) _Pragma("unroll") for (int k = 0; k < 2; ++k) dst[n][k] = *(const PG8_LAS bf16x8*)(lds + PG8_SB(b, h) + boff + n * 2048 + k * 1024); } while (0)
#define PG8_MMA(ai, bj, At, Bt) do { __builtin_amdgcn_s_setprio(1); _Pragma("unroll") for (int m = 0; m < 4; ++m) _Pragma("unroll") for (int n = 0; n < 2; ++n) _Pragma("unroll") for (int k = 0; k < 2; ++k) \
        acc[ai][bj][m][n] = __builtin_amdgcn_mfma_f32_16x16x32_bf16(Bt[n][k], At[m][k], acc[ai][bj][m][n], 0, 0, 0); __builtin_amdgcn_s_setprio(0); } while (0)
#define PG8_WAIT_V(n) asm volatile("s_waitcnt vmcnt(" #n ")" ::: "memory")
#define PG8_WAIT_L(n) asm volatile("s_waitcnt lgkmcnt(" #n ")" ::: "memory")
#define PG8_BAR __builtin_amdgcn_s_barrier()
#define PG8_SCHED __builtin_amdgcn_sched_barrier(0)
    Unit cur, nxt; int ui = 0;
    if (!S.next(0, cur)) return;
    f32x4 acc[2][2][4][2];
#pragma unroll
    for (int a = 0; a < 2; ++a)
#pragma unroll
        for (int b = 0; b < 2; ++b)
#pragma unroll
            for (int m = 0; m < 4; ++m)
#pragma unroll
                for (int n = 0; n < 2; ++n) acc[a][b][m][n] = (f32x4){0.f, 0.f, 0.f, 0.f};
    bf16x8 At[4][2], B0[2][2], B1[2][2];
    const char* cA = (const char*)g.A + (size_t)cur.pm * tstep; const char* cB = (const char*)g.Bt + (size_t)cur.pn * tstep;
    S.a_ready(cur);
    if constexpr (SP2) {
        PG8_STAGE(PG8_SB(0, 0), cB, voffB); PG8_STAGE(PG8_SB(0, 1), cB + hstep, voffB); PG8_STAGE(PG8_SA(0, 0), cA, voffA); PG8_STAGE(PG8_SA(0, 1), cA + hstep, voffA);
        if (wr == 1) PG8_BAR;
        PG8_WAIT_V(2); PG8_BAR;
        PG8_STAGE(PG8_SB(1, 0), cB + kstep, voffB); PG8_STAGE(PG8_SA(1, 0), cA + kstep, voffA); PG8_STAGE(PG8_SB(1, 1), cB + hstep + kstep, voffB);
        PG8_WAIT_V(6); PG8_BAR;
    } else {
        PG8_STAGE(PG8_SB(0, 0), cB, voffB); PG8_STAGE(PG8_SA(0, 0), cA, voffA); PG8_STAGE(PG8_SB(0, 1), cB + hstep, voffB); PG8_STAGE(PG8_SA(0, 1), cA + hstep, voffA);
        if (wr == 1) PG8_BAR;
        PG8_WAIT_V(4); PG8_BAR;
        PG8_STAGE(PG8_SB(1, 0), cB + kstep, voffB); PG8_STAGE(PG8_SA(1, 0), cA + kstep, voffA); PG8_STAGE(PG8_SB(1, 1), cB + hstep + kstep, voffB);
        PG8_WAIT_V(6); PG8_BAR;
    }
    for (;;) {
        const bool has_next = S.next(ui + 1, nxt);
        const char* nA = has_next ? (const char*)g.A + (size_t)nxt.pm * tstep : cA; const char* nB = has_next ? (const char*)g.Bt + (size_t)nxt.pn * tstep : cB;
        for (int t = 0; t < nt; t += 2) {
            const bool last = (t == nt - 2);
            const char* a1 = cA + (size_t)(t + 1) * kstep;
            const char* a2 = last ? nA : cA + (size_t)(t + 2) * kstep; const char* b2 = last ? nB : cB + (size_t)(t + 2) * kstep;
            const char* a3 = a2 + kstep; const char* b3 = b2 + kstep;
            if (last && has_next) S.a_ready(nxt);
            if constexpr (SP2) {
            PG8_LDB(B0, 0, 0); PG8_LDB(B1, 0, 1); PG8_SCHED; PG8_LDA(At, 0, 0); PG8_STAGE(PG8_SA(1, 1), a1 + hstep, voffA);
            PG8_WAIT_V(8); PG8_WAIT_L(0); PG8_BAR; PG8_MMA(0, 0, At, B0); PG8_MMA(0, 1, At, B1); PG8_BAR; PG8_SCHED;
            PG8_LDA(At, 0, 1); PG8_STAGE(PG8_SB(0, 0), b2, voffB); PG8_STAGE(PG8_SB(0, 1), b2 + hstep, voffB); PG8_STAGE(PG8_SA(0, 0), a2, voffA);
            PG8_WAIT_V(8); PG8_WAIT_L(0); PG8_BAR; PG8_MMA(1, 0, At, B0); PG8_MMA(1, 1, At, B1); PG8_BAR; PG8_SCHED;
            PG8_LDB(B0, 1, 0); PG8_LDB(B1, 1, 1); PG8_SCHED; PG8_LDA(At, 1, 0); PG8_STAGE(PG8_SA(0, 1), a2 + hstep, voffA);
            PG8_WAIT_V(8); PG8_WAIT_L(0); PG8_BAR; PG8_MMA(0, 0, At, B0); PG8_MMA(0, 1, At, B1); PG8_BAR; PG8_SCHED;
            PG8_LDA(At, 1, 1); PG8_STAGE(PG8_SB(1, 0), b3, voffB); PG8_STAGE(PG8_SB(1, 1), b3 + hstep, voffB); PG8_STAGE(PG8_SA(1, 0), a3, voffA);
            PG8_WAIT_V(8); PG8_WAIT_L(0); PG8_BAR; PG8_MMA(1, 0, At, B0); PG8_MMA(1, 1, At, B1); PG8_BAR; PG8_SCHED;
            } else {
            PG8_LDB(B0, 0, 0); PG8_SCHED; PG8_LDA(At, 0, 0); PG8_STAGE(PG8_SA(1, 1), a1 + hstep, voffA);
            PG8_WAIT_L(8); PG8_BAR; PG8_WAIT_L(0); PG8_MMA(0, 0, At, B0); PG8_BAR; PG8_SCHED;
            PG8_LDB(B1, 0, 1); PG8_STAGE(PG8_SB(0, 0), b2, voffB);
            PG8_BAR; PG8_WAIT_L(0); PG8_MMA(0, 1, At, B1); PG8_BAR;
            PG8_LDA(At, 0, 1); PG8_STAGE(PG8_SA(0, 0), a2, voffA);
            PG8_BAR; PG8_WAIT_L(0); PG8_MMA(1, 0, At, B0); PG8_BAR; PG8_SCHED;
            PG8_STAGE(PG8_SB(0, 1), b2 + hstep, voffB);
            PG8_WAIT_V(6); PG8_BAR; PG8_MMA(1, 1, At, B1); PG8_BAR;
            PG8_LDB(B0, 1, 0); PG8_SCHED; PG8_LDA(At, 1, 0); PG8_STAGE(PG8_SA(0, 1), a2 + hstep, voffA);
            PG8_WAIT_L(8); PG8_BAR; PG8_WAIT_L(0); PG8_MMA(0, 0, At, B0); PG8_BAR; PG8_SCHED;
            PG8_LDB(B1, 1, 1); PG8_STAGE(PG8_SB(1, 0), b3, voffB);
            PG8_BAR; PG8_WAIT_L(0); PG8_MMA(0, 1, At, B1); PG8_BAR;
            PG8_LDA(At, 1, 1); PG8_STAGE(PG8_SA(1, 0), a3, voffA);
            PG8_BAR; PG8_WAIT_L(0); PG8_MMA(1, 0, At, B0); PG8_BAR; PG8_SCHED;
            PG8_STAGE(PG8_SB(1, 1), b3 + hstep, voffB);
            PG8_WAIT_V(6); PG8_BAR; PG8_MMA(1, 1, At, B1); PG8_BAR;
            }
        }
        if constexpr (ALIGN_EPI) { if (wr == 0) PG8_BAR; }
        if constexpr (!Epi::AFTER_DRAIN) { E(acc, cur, wr, wc, fr, fq); S.done(cur); }
        if (!has_next) break;
#pragma unroll
        for (int a = 0; a < 2; ++a)
#pragma unroll
            for (int b = 0; b < 2; ++b)
#pragma unroll
                for (int m = 0; m < 4; ++m)
#pragma unroll
                    for (int n = 0; n < 2; ++n) acc[a][b][m][n] = (f32x4){0.f, 0.f, 0.f, 0.f};
        cur = nxt; cA = nA; cB = nB; ++ui;
        if constexpr (ALIGN_EPI) { if (wr == 1) PG8_BAR; }
    }
    PG8_WAIT_V(0);
    if constexpr (!ALIGN_EPI) { if (wr == 0) PG8_BAR; }
    PG8_BAR;
    if constexpr (Epi::AFTER_DRAIN) { E.fused(acc, cur, wr, wc, fr, fq, lds, wid, lane); S.done(cur); }
#undef PG8_SA
#undef PG8_SB
#undef PG8_STAGE
#undef PG8_LDA
#undef PG8_LDB
#undef PG8_MMA
#undef PG8_WAIT_V
#undef PG8_WAIT_L
#undef PG8_BAR
#undef PG8_SCHED
}
}

#define LAS __attribute__((address_space(3)))
typedef unsigned short bf16;
typedef short bf16x8 __attribute__((ext_vector_type(8)));
typedef float f32x4 __attribute__((ext_vector_type(4)));
typedef float f32x16 __attribute__((ext_vector_type(16)));
typedef unsigned u32x4 __attribute__((ext_vector_type(4)));
typedef unsigned u32x2 __attribute__((ext_vector_type(2)));
constexpr int NWAVES = 8, NTHR = 512;
constexpr int SEQ = 2048, NBATCH = 8, M = NBATCH * SEQ, DM = 1024, NIN = 7296, NINP = 7424, DFF = 4096, DEPTH = 4;
constexpr int C_AQ = 0, C_AK = 384, C_AV = 768, C_BQ = 1152, C_BK = 1664, C_BV = 2176, C_CQ = 2688, C_CK = 2944, C_CV = 3200, C_CG = 3712, C_GATE = 4224;
constexpr float NORM_EPS = 1e-6f, LOG2E = 1.4426950408889634f;
constexpr size_t MiB = 1u << 20;
constexpr size_t WS_WIN = 0, WS_WBRA = 16 * MiB, WS_WBRB = 17 * MiB, WS_WBRC = 18 * MiB, WS_WO = 19 * MiB, WS_W1 = 21 * MiB, WS_W2 = 29 * MiB;
constexpr size_t WS_ROPE = 37 * MiB, WS_LA = 38 * MiB, WS_ACT = 40 * MiB, WS_YA = 72 * MiB, WS_YB = 84 * MiB, WS_YC = 100 * MiB, WS_PROJ = 116 * MiB;
constexpr size_t WS_H = WS_PROJ, WS_VTB = 348 * MiB, WS_VTC = 364 * MiB  , WS_T1 = 348 * MiB, WS_T2 = 380 * MiB, WS_END = 412 * MiB;
static_assert(WS_PROJ + (size_t)M * NINP * 2 <= WS_T1, "ws map");
constexpr int LDS_BYTES = 147456, MISC_OFF = 147456 - 256;
constexpr size_t WS_CTL = WS_END, CTL_BYTES = 16384;

__device__ __forceinline__ unsigned pk2(float lo, float hi) { return pg8::cvt_pk_bf16(lo, hi); }
__device__ __forceinline__ float bflo(unsigned w) { return __uint_as_float(w << 16); }
__device__ __forceinline__ float bfhi(unsigned w) { return __uint_as_float(w & 0xffff0000u); }
__device__ __forceinline__ float shx(float v, int mask, int lane) { return __int_as_float(__builtin_amdgcn_ds_bpermute((lane ^ mask) << 2, __float_as_int(v))); }
__device__ __forceinline__ float wave_sum(float v, int lane) {
#pragma unroll
    for (int o = 1; o < 64; o <<= 1) v += shx(v, o, lane);
    return v;
}
__device__ __forceinline__ float wave_max(float v, int lane) {
#pragma unroll
    for (int o = 1; o < 64; o <<= 1) v = fmaxf(v, shx(v, o, lane));
    return v;
}
#define MFMA32(a, b, c) __builtin_amdgcn_mfma_f32_32x32x16_bf16((a), (b), (c), 0, 0, 0)
__device__ __forceinline__ bf16x8 pack8(float a0, float a1, float a2, float a3, float a4, float a5, float a6, float a7) {
    u32x4 p;
    asm volatile("v_cvt_pk_bf16_f32 %0, %4, %5\n\tv_cvt_pk_bf16_f32 %1, %6, %7\n\tv_cvt_pk_bf16_f32 %2, %8, %9\n\tv_cvt_pk_bf16_f32 %3, %10, %11\n\ts_nop 1"
                 : "=&v"(p[0]), "=&v"(p[1]), "=&v"(p[2]), "=&v"(p[3])
                 : "v"(a0), "v"(a1), "v"(a2), "v"(a3), "v"(a4), "v"(a5), "v"(a6), "v"(a7));
    return __builtin_bit_cast(bf16x8, p);
}
__device__ __forceinline__ int kpos(int key) { return (key & ~12) | ((key & 4) << 1) | ((key & 8) >> 1); }

__device__ __forceinline__ void transpose_item(const float* W, int K, int N, bf16* WT, LAS float* scr, int item, int lane) {
    const int nblk = N / 32, kb = item / nblk, nb = item % nblk, k0 = 64 * kb, n0 = 32 * nb;
#pragma unroll 8
    for (int i = 0; i < 32; ++i) { const int kk = 2 * i + (lane >> 5); scr[kk * 33 + (lane & 31)] = W[(size_t)(k0 + kk) * N + n0 + (lane & 31)]; }
    asm volatile("s_waitcnt lgkmcnt(0)" ::: "memory");
    const int c = lane & 7;
#pragma unroll
    for (int j = 0; j < 4; ++j) { const int n = (lane >> 3) + 8 * j; const LAS float* s = scr + (8 * c) * 33 + n;
        u32x4 o; o.x = pk2(s[0 * 33], s[1 * 33]); o.y = pk2(s[2 * 33], s[3 * 33]); o.z = pk2(s[4 * 33], s[5 * 33]); o.w = pk2(s[6 * 33], s[7 * 33]);
        *(u32x4*)(WT + (size_t)(n0 + n) * K + k0 + 8 * c) = o; }
    asm volatile("s_waitcnt lgkmcnt(0)" ::: "memory");
}
__device__ __forceinline__ void rms_rows_to_bf16(const float* x, const float* g, bf16* o, int gw, int NGW, int lane) {
    const f32x4* gr = (const f32x4*)g + lane;
    f32x4 gg[4];
#pragma unroll
    for (int j = 0; j < 4; ++j) gg[j] = gr[64 * j];
    for (int m0 = gw * 4; m0 < M; m0 += NGW * 4) {
        f32x4 v[4][4];
#pragma unroll
        for (int q = 0; q < 4; ++q)
#pragma unroll
            for (int j = 0; j < 4; ++j) v[q][j] = ((const f32x4*)(x + (size_t)(m0 + q) * DM) + lane)[64 * j];
#pragma unroll
        for (int q = 0; q < 4; ++q) { float s = 0.f;
#pragma unroll
            for (int j = 0; j < 4; ++j) s += (v[q][j].x * v[q][j].x + v[q][j].y * v[q][j].y) + (v[q][j].z * v[q][j].z + v[q][j].w * v[q][j].w);
            const float rstd = 1.0f / sqrtf(wave_sum(s, lane) * (1.f / DM) + NORM_EPS);
            unsigned long long* o8 = (unsigned long long*)(o + (size_t)(m0 + q) * DM) + lane;
#pragma unroll
            for (int j = 0; j < 4; ++j)
                o8[64 * j] = (unsigned long long)pk2(v[q][j].x * rstd * gg[j].x, v[q][j].y * rstd * gg[j].y) | ((unsigned long long)pk2(v[q][j].z * rstd * gg[j].z, v[q][j].w * rstd * gg[j].w) << 32); }
    }
}

struct Args { const float* in[22]; float* out; unsigned char* ws; };
__device__ __forceinline__ int otid() { int t = threadIdx.x; asm volatile("" : "+v"(t)); return t; }

__device__ __forceinline__ void phase_prep(const Args& a, int l, LAS unsigned char* lds, int gw, int NGW, int wave, int lane, const float* xsrc) {
    unsigned char* ws = a.ws;
    LAS float* scr = (LAS float*)(lds + wave * 16384);
    const float* w_in = a.in[2] + (size_t)l * DM * NIN;
    const float* w_bra = a.in[15] + (size_t)l * 384 * DM;
    const float* w_brb = a.in[16] + (size_t)l * 512 * DM;
    const float* w_brc = a.in[17] + (size_t)l * 512 * DM;
    const float* w_o = a.in[18] + (size_t)l * DM * DM;
    const float* w_1 = a.in[20] + (size_t)l * DM * DFF;
    const float* w_2 = a.in[21] + (size_t)l * DFF * DM;
    constexpr int I_IN = (DM / 64) * (NIN / 32), I_A = (384 / 64) * (DM / 32), I_B = (512 / 64) * (DM / 32), I_O = (DM / 64) * (DM / 32), I_1 = (DM / 64) * (DFF / 32), I_2 = (DFF / 64) * (DM / 32);
    constexpr int NITEMS = I_IN + I_A + 2 * I_B + I_O + I_1 + I_2;
    for (int it = gw; it < NITEMS; it += NGW) {
        int r = it;
        if (r < I_IN) { transpose_item(w_in, DM, NIN, (bf16*)(ws + WS_WIN), scr, r, lane); continue; } r -= I_IN;
        if (r < I_A) { transpose_item(w_bra, 384, DM, (bf16*)(ws + WS_WBRA), scr, r, lane); continue; } r -= I_A;
        if (r < I_B) { transpose_item(w_brb, 512, DM, (bf16*)(ws + WS_WBRB), scr, r, lane); continue; } r -= I_B;
        if (r < I_B) { transpose_item(w_brc, 512, DM, (bf16*)(ws + WS_WBRC), scr, r, lane); continue; } r -= I_B;
        if (r < I_O) { transpose_item(w_o, DM, DM, (bf16*)(ws + WS_WO), scr, r, lane); continue; } r -= I_O;
        if (r < I_1) { transpose_item(w_1, DM, DFF, (bf16*)(ws + WS_W1), scr, r, lane); continue; } r -= I_1;
        transpose_item(w_2, DFF, DM, (bf16*)(ws + WS_W2), scr, r, lane);
    }
    { u32x4* z = (u32x4*)((bf16*)(ws + WS_WIN) + (size_t)NIN * DM); unsigned z0 = 0u; asm volatile("" : "+v"(z0)); const u32x4 zz = {z0, z0, z0, z0};
      for (int i = gw * 64 + lane; i < (NINP - NIN) * DM / 8; i += NGW * 64) z[i] = zz; }
    const float* g1 = a.in[1] + (size_t)l * DM;
    bf16* act = (bf16*)(ws + WS_ACT);
    rms_rows_to_bf16(xsrc, g1, act, gw, NGW, lane);
    if (l == 0) {
        float* rp = (float*)(ws + WS_ROPE);
        for (int e = gw * 64 + lane; e < SEQ * 40; e += NGW * 64) {
            const int s = e / 40, i = e % 40;
            float inv; if (i < 8) inv = 1.0f / exp2f((float)(2 * i) * (1.0f / 16.0f) * 18.931568569324174f);
            else inv = 1.0f / exp2f((float)(2 * (i - 8)) * (1.0f / 64.0f) * 13.287712379549449f);
            const float ang = (float)s * inv;
            const double rev = (double)ang * 0.15915494309189535; const float fr = (float)(rev - floor(rev));
            const float cs = __builtin_amdgcn_cosf(fr), sn = __builtin_amdgcn_sinf(fr);
            if (i < 8) { rp[s * 8 + i] = cs; rp[SEQ * 8 + s * 8 + i] = sn; }
            else { rp[SEQ * 16 + s * 32 + (i - 8)] = cs; rp[SEQ * 16 + SEQ * 32 + s * 32 + (i - 8)] = sn; }
        }
    }
}

__device__ __forceinline__ void pp_decode(const Args& a, int l, int hv, int& col, const float*& g, int& full, float& sc) {
    const float qs = 0.125f * LOG2E;
    g = a.in[3]; full = 0; sc = 1.f;
    if (hv < 6) { col = C_AQ + 64 * hv; g = a.in[3] + l * 64; sc = qs; }
    else if (hv < 12) { col = C_AK + 64 * (hv - 6); g = a.in[4] + l * 64; }
    else if (hv < 20) { col = C_BQ + 64 * (hv - 12); g = a.in[5] + l * 64; sc = qs; }
    else if (hv < 28) { col = C_BK + 64 * (hv - 20); g = a.in[6] + l * 64; }
    else if (hv < 32) { col = C_CQ + 64 * (hv - 28); full = 1; }
    else { col = C_CK + 64 * (hv - 32); full = 1; sc = 0.125f; }
}
__device__ __forceinline__ void pp_compute(const u32x4 w0, const u32x4 w1, u32x4& o0, u32x4& o1, const float* g, int full, float sc, int s, int q4, int lane,
                                           const float* cosP, const float* sinP, const float* cosR, const float* sinR) {
    float v[16] = {bflo(w0.x), bfhi(w0.x), bflo(w0.y), bfhi(w0.y), bflo(w0.z), bfhi(w0.z), bflo(w0.w), bfhi(w0.w),
                   bflo(w1.x), bfhi(w1.x), bflo(w1.y), bfhi(w1.y), bflo(w1.z), bfhi(w1.z), bflo(w1.w), bfhi(w1.w)};
    if (!full) {
        float ss = 0.f;
#pragma unroll
        for (int i = 0; i < 16; ++i) ss += v[i] * v[i];
        ss += shx(ss, 1, lane); ss += shx(ss, 2, lane);
        const float r = 1.0f / sqrtf(ss * (1.f / 64.f) + NORM_EPS);
        const f32x4* gp = (const f32x4*)(g + q4 * 16);
#pragma unroll
        for (int c = 0; c < 4; ++c) { const f32x4 gg = gp[c]; v[4 * c] *= r * gg[0]; v[4 * c + 1] *= r * gg[1]; v[4 * c + 2] *= r * gg[2]; v[4 * c + 3] *= r * gg[3]; }
        if (q4 == 0) {
            const f32x4 c0 = *(const f32x4*)(cosP + s * 8), c1 = *(const f32x4*)(cosP + s * 8 + 4), s0 = *(const f32x4*)(sinP + s * 8), s1 = *(const f32x4*)(sinP + s * 8 + 4);
#pragma unroll
            for (int i = 0; i < 8; ++i) { const float c = i < 4 ? c0[i & 3] : c1[i & 3], sn = i < 4 ? s0[i & 3] : s1[i & 3], t1 = v[i], t2 = v[8 + i]; v[i] = t1 * c - t2 * sn; v[8 + i] = t2 * c + t1 * sn; }
        }
    } else {
        const int ib = (q4 & 1) * 16;
        const float sg = (q4 < 2) ? -1.0f : 1.0f;
#pragma unroll
        for (int c = 0; c < 4; ++c) { const f32x4 cc = *(const f32x4*)(cosR + s * 32 + ib + 4 * c), sn = *(const f32x4*)(sinR + s * 32 + ib + 4 * c);
#pragma unroll
            for (int j = 0; j < 4; ++j) { const float pv = shx(v[4 * c + j], 2, lane); v[4 * c + j] = v[4 * c + j] * cc[j] + sg * pv * sn[j]; } }
    }
    o0.x = pk2(v[0] * sc, v[1] * sc); o0.y = pk2(v[2] * sc, v[3] * sc); o0.z = pk2(v[4] * sc, v[5] * sc); o0.w = pk2(v[6] * sc, v[7] * sc);
    o1.x = pk2(v[8] * sc, v[9] * sc); o1.y = pk2(v[10] * sc, v[11] * sc); o1.z = pk2(v[12] * sc, v[13] * sc); o1.w = pk2(v[14] * sc, v[15] * sc);
}
__device__ __forceinline__ void phase_postproj(const Args& a, int l, int gtid, int NT, int lane) {
    bf16* proj = (bf16*)(a.ws + WS_PROJ);
    const float* rp = (const float*)(a.ws + WS_ROPE);
    const float* cosP = rp; const float* sinP = rp + SEQ * 8; const float* cosR = rp + SEQ * 16; const float* sinR = rp + SEQ * 16 + SEQ * 32;
    const int q4 = lane & 3, NQ = NT >> 2;
    for (int e0 = gtid >> 2; e0 < M * 36; e0 += 2 * NQ) {
        const int e1 = e0 + NQ; const bool has1 = e1 < M * 36;
        const int t0 = e0 / 36, hv0 = e0 % 36, t1 = has1 ? e1 / 36 : t0, hv1 = has1 ? e1 % 36 : hv0;
        int col0, full0, col1, full1; const float *g0, *g1; float sc0, sc1;
        pp_decode(a, l, hv0, col0, g0, full0, sc0); pp_decode(a, l, hv1, col1, g1, full1, sc1);
        u32x4* p0 = (u32x4*)(proj + (size_t)t0 * NINP + col0 + q4 * 16); u32x4* p1 = (u32x4*)(proj + (size_t)t1 * NINP + col1 + q4 * 16);
        const u32x4 a0 = p0[0], a1 = p0[1], b0 = p1[0], b1 = p1[1];
        u32x4 o0, o1;
        pp_compute(a0, a1, o0, o1, g0, full0, sc0, t0 & (SEQ - 1), q4, lane, cosP, sinP, cosR, sinR);
        p0[0] = o0; p0[1] = o1;
        if (has1) { pp_compute(b0, b1, o0, o1, g1, full1, sc1, t1 & (SEQ - 1), q4, lane, cosP, sinP, cosR, sinR); p1[0] = o0; p1[1] = o1; }
    }
}

__device__ __forceinline__ void vt_item(const bf16* proj, bf16* vt, int vcol0, int item, LAS unsigned char* scr, int lane) {
    const int kt = item & 31, h = (item >> 5) & 3, b = item >> 7;
    const bf16* src = proj + ((size_t)b * SEQ + kt * 64) * NINP + vcol0 + h * 128;
#pragma unroll 4
    for (int i = 0; i < 16; ++i) { const int row = 4 * i + (lane >> 4), ch = lane & 15;
        const u32x4 w = *(const u32x4*)(src + (size_t)row * NINP + ch * 8);
        *(LAS u32x4*)(scr + row * 272 + ch * 16) = w; }
    asm volatile("s_waitcnt lgkmcnt(0)" ::: "memory");
    const int c = lane & 7;
    bf16* dst = vt + ((size_t)(b * 4 + h) * 128) * SEQ + kt * 64 + c * 8;
#pragma unroll 4
    for (int i = 0; i < 16; ++i) { const int dv = 8 * i + (lane >> 3);
        unsigned short e[8];
#pragma unroll
        for (int j = 0; j < 8; ++j) e[j] = *(const LAS unsigned short*)(scr + kpos(8 * c + j) * 272 + dv * 2);
        u32x4 o; o.x = e[0] | ((unsigned)e[1] << 16); o.y = e[2] | ((unsigned)e[3] << 16); o.z = e[4] | ((unsigned)e[5] << 16); o.w = e[6] | ((unsigned)e[7] << 16);
        *(u32x4*)(dst + (size_t)dv * SEQ) = o; }
    asm volatile("s_waitcnt lgkmcnt(0)" ::: "memory");
}

__device__ __forceinline__ void attn_a_item(const Args& a, int item, LAS unsigned char* wlds, int lane, float M2) {
    const bf16* proj = (const bf16*)(a.ws + WS_PROJ);
    bf16* ya = (bf16*)(a.ws + WS_YA); float* lA = (float*)(a.ws + WS_LA);
    const int r = lane & 31, hh = lane >> 5;
    const int g = item >> 10; int rem = item & 1023;
    const int qhalf = rem & 1; rem >>= 1;
    const int dsh = 2 * g, dil = 1 << dsh, nbs = 5 - dsh, L = SEQ >> dsh;
    const int n = rem & ((1 << nbs) - 1); rem >>= nbs;
    const int rsd = rem & (dil - 1); rem >>= dsh;
    const int hg = rem & 1; const int b = rem >> 1;
    const int head = 2 * g + hg;
    const int iq = 64 * n + 32 * qhalf + r;
    const size_t tq = (size_t)b * SEQ + (size_t)dil * iq + rsd;
    bf16x8 qf[4];
#pragma unroll
    for (int kk = 0; kk < 4; ++kk) qf[kk] = *(const bf16x8*)(proj + tq * NINP + C_AQ + head * 64 + 16 * kk + 8 * hh);
    f32x16 O0, O1;
#pragma unroll
    for (int i = 0; i < 16; ++i) { O0[i] = 0.f; O1[i] = 0.f; }
    float lsum = 0.f;
    const int j0 = 64 * n + 32 * qhalf - 64;
    const int lkey = lane >> 3, lch = lane & 7;
    u32x4 kb_[2][4], vb_[2][4];
    {
#pragma unroll
      for (int i = 0; i < 4; ++i) { int jr = j0 + lkey + 8 * i; jr = jr < 0 ? 0 : (jr >= L ? L - 1 : jr); const size_t tk = (size_t)b * SEQ + (size_t)dil * jr + rsd;
        kb_[0][i] = *(const u32x4*)(proj + tk * NINP + C_AK + head * 64 + lch * 8); vb_[0][i] = *(const u32x4*)(proj + tk * NINP + C_AV + head * 64 + lch * 8); } }
    LAS unsigned char* kl = wlds + 5120;
#pragma unroll
    for (int sb = 0; sb < 5; ++sb) {
        const int jb = j0 + 32 * sb;
        if (sb + 1 < 5) {
#pragma unroll
            for (int i = 0; i < 4; ++i) { int jr = jb + 32 + lkey + 8 * i; jr = jr < 0 ? 0 : (jr >= L ? L - 1 : jr); const size_t tk = (size_t)b * SEQ + (size_t)dil * jr + rsd;
                kb_[(sb + 1) & 1][i] = *(const u32x4*)(proj + tk * NINP + C_AK + head * 64 + lch * 8); vb_[(sb + 1) & 1][i] = *(const u32x4*)(proj + tk * NINP + C_AV + head * 64 + lch * 8); } }
        if (jb < 0 || jb >= L) continue;
#pragma unroll
        for (int i = 0; i < 4; ++i) { const int key = lkey + 8 * i;
            *(LAS u32x4*)(kl + key * 144 + lch * 16) = kb_[sb & 1][i];
            const u32x4 vv = vb_[sb & 1][i]; const unsigned ww[4] = {vv.x, vv.y, vv.z, vv.w};
            LAS bf16* w = (LAS bf16*)(wlds + (lch * 8) * 80 + kpos(key) * 2);
#pragma unroll
            for (int j = 0; j < 4; ++j) { w[(2 * j) * 40] = (bf16)(ww[j] & 0xffffu); w[(2 * j + 1) * 40] = (bf16)(ww[j] >> 16); } }
        asm volatile("s_waitcnt lgkmcnt(0)" ::: "memory");
        f32x16 acc;
#pragma unroll
        for (int i = 0; i < 16; ++i) acc[i] = -M2;
#pragma unroll
        for (int kk = 0; kk < 4; ++kk) { const bf16x8 kf = *(const LAS bf16x8*)(kl + r * 144 + (16 * kk + 8 * hh) * 2); acc = MFMA32(kf, qf[kk], acc); }
        float p[16];
#pragma unroll
        for (int i = 0; i < 16; ++i) { const int j = jb + (i & 3) + 8 * (i >> 2) + 4 * hh; const int d = iq - j;
            const float e = __builtin_amdgcn_exp2f(acc[i]); p[i] = (d <= 64 && d >= -64) ? e : 0.f; lsum += p[i]; }
        const bf16x8 pf0 = pack8(p[0], p[1], p[2], p[3], p[4], p[5], p[6], p[7]);
        const bf16x8 pf1 = pack8(p[8], p[9], p[10], p[11], p[12], p[13], p[14], p[15]);
        const bf16x8 v00 = *(const LAS bf16x8*)(wlds + r * 80 + (8 * hh) * 2);
        const bf16x8 v01 = *(const LAS bf16x8*)(wlds + r * 80 + (16 + 8 * hh) * 2);
        const bf16x8 v10 = *(const LAS bf16x8*)(wlds + (32 + r) * 80 + (8 * hh) * 2);
        const bf16x8 v11 = *(const LAS bf16x8*)(wlds + (32 + r) * 80 + (16 + 8 * hh) * 2);
        O0 = MFMA32(v00, pf0, O0); O0 = MFMA32(v01, pf1, O0);
        O1 = MFMA32(v10, pf0, O1); O1 = MFMA32(v11, pf1, O1);
        asm volatile("s_waitcnt lgkmcnt(0)" ::: "memory");
    }
    const float l = lsum + shx(lsum, 32, lane);
    bf16* op = ya + tq * 384 + head * 64 + 4 * hh;
#pragma unroll
    for (int q = 0; q < 4; ++q) {
        u32x2 w0; w0.x = pk2(O0[4 * q], O0[4 * q + 1]); w0.y = pk2(O0[4 * q + 2], O0[4 * q + 3]); *(u32x2*)(op + 8 * q) = w0;
        u32x2 w1; w1.x = pk2(O1[4 * q], O1[4 * q + 1]); w1.y = pk2(O1[4 * q + 2], O1[4 * q + 3]); *(u32x2*)(op + 32 + 8 * q) = w1;
    }
    if (hh == 0) lA[tq * 6 + head] = l;
}

constexpr int AT_KOFF = 9216, AT_VT = 18432, AT_STAGE = 36864;
constexpr size_t WS_RST = 380 * MiB;
__device__ __forceinline__ void ret_state_item(const Args& a, int l, int item, LAS unsigned char* lds) {
    const bf16* proj = (const bf16*)(a.ws + WS_PROJ);
    const int tid = otid(), wid = __builtin_amdgcn_readfirstlane(tid >> 6), lane = tid & 63, r = lane & 31, hh = lane >> 5;
    const int j = item & 7, h = (item >> 3) & 3, b = item >> 5;
    const float lgf2 = -__expf(a.in[12][l * 4 + h]) * LOG2E, lgb2 = -__expf(a.in[13][l * 4 + h]) * LOG2E;
    const int dir = wid >> 2, db = (wid >> 1) & 1, dvp = wid & 1;
    const bf16* kg = proj + ((size_t)b * SEQ + j * 256 + (tid >> 3)) * NINP + C_CK + h * 64 + (tid & 7) * 8;
    const bf16* vg = (const bf16*)(a.ws + WS_VTC) + ((size_t)(b * 4 + h) * 128 + (tid >> 3)) * SEQ + j * 256 + (tid & 7) * 8;
    f32x16 acc0, acc1;
#pragma unroll
    for (int i = 0; i < 16; ++i) { acc0[i] = 0.f; acc1[i] = 0.f; }
    for (int t = 0; t < 4; ++t) {
        const u32x4 kw = *(const u32x4*)(kg + (size_t)t * 64 * NINP);
        const u32x4 v0 = *(const u32x4*)(vg + t * 64), v1 = *(const u32x4*)(vg + t * 64 + 64 * SEQ);
        const int key = tid >> 3, ch = tid & 7, pos = t * 64 + key;
        const float wf = __builtin_amdgcn_exp2f(lgf2 * (float)(256 - pos)), wb = __builtin_amdgcn_exp2f(lgb2 * (float)pos);
        const float kv[8] = {bflo(kw.x), bfhi(kw.x), bflo(kw.y), bfhi(kw.y), bflo(kw.z), bfhi(kw.z), bflo(kw.w), bfhi(kw.w)};
        LAS bf16* ktf = (LAS bf16*)(lds + (ch * 8) * 144 + kpos(key) * 2);
        LAS bf16* ktb = (LAS bf16*)(lds + 9216 + (ch * 8) * 144 + kpos(key) * 2);
#pragma unroll
        for (int e = 0; e < 8; e += 2) { const unsigned pf = pk2(kv[e] * wf, kv[e + 1] * wf), pb = pk2(kv[e] * wb, kv[e + 1] * wb);
            ktf[e * 72] = (bf16)(pf & 0xffffu); ktf[(e + 1) * 72] = (bf16)(pf >> 16); ktb[e * 72] = (bf16)(pb & 0xffffu); ktb[(e + 1) * 72] = (bf16)(pb >> 16); }
        *(LAS u32x4*)(lds + AT_VT + (tid >> 3) * 144 + (tid & 7) * 16) = v0;
        *(LAS u32x4*)(lds + AT_VT + ((tid >> 3) + 64) * 144 + (tid & 7) * 16) = v1;
        __syncthreads();
        LAS unsigned char* abase = lds + dir * 9216 + (32 * db + r) * 144 + (8 * hh) * 2;
        LAS unsigned char* bbase = lds + AT_VT + (64 * dvp + r) * 144 + (8 * hh) * 2;
#pragma unroll
        for (int ks = 0; ks < 4; ++ks) { const bf16x8 af = *(const LAS bf16x8*)(abase + 32 * ks);
            const bf16x8 b0 = *(const LAS bf16x8*)(bbase + 32 * ks), b1 = *(const LAS bf16x8*)(bbase + 32 * 144 + 32 * ks);
            acc0 = MFMA32(af, b0, acc0); acc1 = MFMA32(af, b1, acc1); }
        __syncthreads();
    }
    float* F = (float*)(a.ws + WS_RST) + ((size_t)(dir * 256 + item) * 64 + 32 * db + 4 * hh) * 128 + 64 * dvp + r;
#pragma unroll
    for (int i = 0; i < 16; ++i) { const int drow = (i & 3) + 8 * (i >> 2); F[drow * 128] = acc0[i]; F[drow * 128 + 32] = acc1[i]; }
}

template <int MODE>
__device__ __forceinline__ void attn_dense_unit(const Args& a, int l, int unit, LAS unsigned char* lds, float M2, float lam, float oscale) {
    const bf16* proj = (const bf16*)(a.ws + WS_PROJ);
    const int tid = otid(), wid = __builtin_amdgcn_readfirstlane(tid >> 6), lane = tid & 63, r = lane & 31, hh = lane >> 5;
    constexpr int QROWS = MODE == 0 ? 128 : 256;
    const int g = MODE == 0 ? (wid >> 1) : wid, m = MODE == 0 ? (wid & 1) : 0;
    const int qb = MODE == 0 ? (unit & 15) : (unit & 7), h = MODE == 0 ? ((unit >> 4) & 3) : ((unit >> 3) & 3), b = MODE == 0 ? (unit >> 6) : (unit >> 5);
    const int qcol = MODE == 0 ? C_BQ + (h * 2 + m) * 64 : C_CQ + h * 64;
    const int kcol = MODE == 0 ? C_BK + h * 128 : C_CK + h * 64;
    const size_t rowbase = (size_t)b * SEQ;
    const int nq = qb * QROWS + g * 32 + r;
    bf16x8 qf[4];
#pragma unroll
    for (int kk = 0; kk < 4; ++kk) qf[kk] = *(const bf16x8*)(proj + (rowbase + nq) * NINP + qcol + 16 * kk + 8 * hh);
    float lgf2 = 0.f, lgb2n = 0.f;
    float c1f[4] = {0.f, 0.f, 0.f, 0.f}, c2f[4] = {0.f, 0.f, 0.f, 0.f}, c1b[4] = {0.f, 0.f, 0.f, 0.f}, c2b[4] = {0.f, 0.f, 0.f, 0.f};
    if (MODE == 1) { lgf2 = -__expf(a.in[12][l * 4 + h]) * LOG2E; lgb2n = __expf(a.in[13][l * 4 + h]) * LOG2E;
#pragma unroll
        for (int q = 0; q < 4; ++q) { c1f[q] = __builtin_amdgcn_exp2f(lgf2 * (float)(3 - q)); c2f[q] = __builtin_amdgcn_exp2f(lgf2 * (float)(28 - 4 * hh - 8 * q));
                                      c1b[q] = __builtin_amdgcn_exp2f(-lgb2n * (float)q); c2b[q] = __builtin_amdgcn_exp2f(-lgb2n * (float)(4 * hh + 8 * q)); } }
    f32x16 O[4];
#pragma unroll
    for (int d = 0; d < 4; ++d)
#pragma unroll
        for (int i = 0; i < 16; ++i) O[d][i] = 0.f;
    float lsum = 0.f;
    if constexpr (MODE == 1) {
        const float* Fb_ = (const float*)(a.ws + WS_RST) + (size_t)((b * 4 + h) * 8) * 8192;
        const float cf = __builtin_amdgcn_exp2f(lgf2 * 256.0f), cb = __builtin_amdgcn_exp2f(-lgb2n * 256.0f);
#pragma unroll
        for (int e = 0; e < 4; ++e) { const int idx = tid + 512 * e, d = idx >> 5, dv4 = (idx & 31) * 4;
            f32x4 sf = {0.f, 0.f, 0.f, 0.f}, sb = {0.f, 0.f, 0.f, 0.f}; float w = 1.0f;
            for (int j = qb - 1; j >= 0; --j) { const f32x4 v = *(const f32x4*)(Fb_ + (size_t)j * 8192 + d * 128 + dv4); sf += v * w; w *= cf; }
            w = 1.0f;
            for (int j = qb + 1; j < 8; ++j) { const f32x4 v = *(const f32x4*)(Fb_ + (size_t)(256 + j) * 8192 + d * 128 + dv4); sb += v * w; w *= cb; }
#pragma unroll
            for (int q = 0; q < 4; ++q) { *(LAS bf16*)(lds + 73728 + (dv4 + q) * 144 + d * 2) = (bf16)(pk2(sf[q], 0.f) & 0xffffu); *(LAS bf16*)(lds + 92160 + (dv4 + q) * 144 + d * 2) = (bf16)(pk2(sb[q], 0.f) & 0xffffu); } }
        __syncthreads();
        const float wqf = __builtin_amdgcn_exp2f(lgf2 * (float)(g * 32 + r)), wqb = __builtin_amdgcn_exp2f(-lgb2n * (float)(256 - (g * 32 + r)));
#pragma unroll
        for (int d = 0; d < 4; ++d) { f32x16 of = O[d], ob = O[d];
#pragma unroll
            for (int kk = 0; kk < 4; ++kk) { const bf16x8 af = *(const LAS bf16x8*)(lds + 73728 + (32 * d + r) * 144 + (16 * kk + 8 * hh) * 2);
                const bf16x8 ab = *(const LAS bf16x8*)(lds + 92160 + (32 * d + r) * 144 + (16 * kk + 8 * hh) * 2);
                of = MFMA32(af, qf[kk], of); ob = MFMA32(ab, qf[kk], ob); }
#pragma unroll
            for (int i = 0; i < 16; ++i) O[d][i] = of[i] * wqf + ob[i] * wqb; }
    }
    const int lk_key = tid >> 3, lk_ch = tid & 7;
    const bf16* kg = proj + (rowbase + lk_key) * NINP + kcol + lk_ch * 8;
    const bf16* vg = (const bf16*)(a.ws + (MODE == 0 ? WS_VTB : WS_VTC)) + ((size_t)(b * 4 + h) * 128 + (tid >> 3)) * SEQ + (tid & 7) * 8;
    u32x4 kr0, kr1, vr0, vr1;
    constexpr int NTALL = SEQ / 64, NT = MODE == 0 ? NTALL : 4;
    const int kt0 = ((QROWS / 64) * qb) & (NTALL - 1);
    { const size_t o = (size_t)kt0 * 64 * NINP;
      kr0 = *(const u32x4*)(kg + o); if (MODE == 0) kr1 = *(const u32x4*)(kg + o + 64);
      vr0 = *(const u32x4*)(vg + kt0 * 64); vr1 = *(const u32x4*)(vg + kt0 * 64 + 64 * SEQ); }
    for (int it = 0; it < NT; ++it) {
        const int kt = (it + kt0) & (NTALL - 1);
        LAS unsigned char* st = lds + (it & 1) * AT_STAGE;
        *(LAS u32x4*)(st + lk_key * 144 + lk_ch * 16) = kr0;
        if (MODE == 0) *(LAS u32x4*)(st + AT_KOFF + lk_key * 144 + lk_ch * 16) = kr1;
        *(LAS u32x4*)(st + AT_VT + lk_key * 144 + lk_ch * 16) = vr0;
        *(LAS u32x4*)(st + AT_VT + (lk_key + 64) * 144 + lk_ch * 16) = vr1;
        __syncthreads();
        if (it + 1 < NT) {
            const int kn = (kt + 1) & (NTALL - 1);
            const size_t o = (size_t)kn * 64 * NINP;
            kr0 = *(const u32x4*)(kg + o); if (MODE == 0) kr1 = *(const u32x4*)(kg + o + 64);
            vr0 = *(const u32x4*)(vg + kn * 64); vr1 = *(const u32x4*)(vg + kn * 64 + 64 * SEQ);
        }
#define SCORE_TO_P(acc, kb, p) do { \
            if (MODE == 0) { _Pragma("unroll") for (int i = 0; i < 16; ++i) { p[i] = __builtin_amdgcn_exp2f(acc[i]); lsum += p[i]; } } \
            else { const int mk0 = kt * 64 + 32 * (kb), q0w = qb * QROWS + g * 32; \
                if (mk0 + 31 < q0w) { const float A_ = __builtin_amdgcn_exp2f(lgf2 * (float)(nq - mk0 - 31)); float c2_[4]; \
                    _Pragma("unroll") for (int bq = 0; bq < 4; ++bq) c2_[bq] = A_ * c2f[bq]; \
                    _Pragma("unroll") for (int i = 0; i < 16; ++i) p[i] = acc[i] * (c2_[i >> 2] * c1f[i & 3]); } \
                else if (mk0 > q0w + 31) { const float A_ = __builtin_amdgcn_exp2f(-lgb2n * (float)(mk0 - nq)); float c2_[4]; \
                    _Pragma("unroll") for (int bq = 0; bq < 4; ++bq) c2_[bq] = A_ * c2b[bq]; \
                    _Pragma("unroll") for (int i = 0; i < 16; ++i) p[i] = acc[i] * (c2_[i >> 2] * c1b[i & 3]); } \
                else { const int dbase_ = nq - (mk0 + 4 * hh); \
                    _Pragma("unroll") for (int i = 0; i < 16; ++i) { const int d_ = dbase_ - ((i & 3) + 8 * (i >> 2)); const float df_ = (float)d_; \
                        const float e_ = df_ * (d_ > 0 ? lgf2 : lgb2n); float D_ = __builtin_amdgcn_exp2f(e_); D_ = (d_ == 0) ? 2.0f : D_; p[i] = acc[i] * D_; } } } } while (0)
        {
            LAS unsigned char* kbase = st + (MODE == 0 ? m * AT_KOFF : 0) + r * 144 + (8 * hh) * 2;
            LAS unsigned char* vbase = st + AT_VT + r * 144 + (8 * hh) * 2;
            bf16x8 kf0[4], kf1[4], vf[8];
#pragma unroll
            for (int kk = 0; kk < 4; ++kk) kf0[kk] = *(const LAS bf16x8*)(kbase + 32 * kk);
#pragma unroll
            for (int kk = 0; kk < 4; ++kk) kf1[kk] = *(const LAS bf16x8*)(kbase + 32 * 144 + 32 * kk);
#pragma unroll
            for (int dvb = 0; dvb < 4; ++dvb) { vf[2 * dvb] = *(const LAS bf16x8*)(vbase + dvb * 32 * 144); vf[2 * dvb + 1] = *(const LAS bf16x8*)(vbase + dvb * 32 * 144 + 32); }
            __builtin_amdgcn_sched_barrier(0);
            f32x16 acc0, acc1;
#pragma unroll
            for (int i = 0; i < 16; ++i) { acc0[i] = MODE == 0 ? -M2 : 0.f; acc1[i] = MODE == 0 ? -M2 : 0.f; }
#pragma unroll
            for (int kk = 0; kk < 4; ++kk) acc0 = MFMA32(kf0[kk], qf[kk], acc0);
#pragma unroll
            for (int kk = 0; kk < 4; ++kk) acc1 = MFMA32(kf1[kk], qf[kk], acc1);
            __builtin_amdgcn_sched_barrier(0);
            float p[16];
            SCORE_TO_P(acc0, 0, p);
            const bf16x8 pf00 = pack8(p[0], p[1], p[2], p[3], p[4], p[5], p[6], p[7]);
            const bf16x8 pf01 = pack8(p[8], p[9], p[10], p[11], p[12], p[13], p[14], p[15]);
            __builtin_amdgcn_sched_barrier(0);
#pragma unroll
            for (int dvb = 0; dvb < 4; ++dvb) O[dvb] = MFMA32(vf[2 * dvb], pf00, O[dvb]);
#pragma unroll
            for (int dvb = 0; dvb < 4; ++dvb) O[dvb] = MFMA32(vf[2 * dvb + 1], pf01, O[dvb]);
#pragma unroll
            for (int dvb = 0; dvb < 4; ++dvb) { vf[2 * dvb] = *(const LAS bf16x8*)(vbase + 64 + dvb * 32 * 144); vf[2 * dvb + 1] = *(const LAS bf16x8*)(vbase + 64 + dvb * 32 * 144 + 32); }
            SCORE_TO_P(acc1, 1, p);
            const bf16x8 pf10 = pack8(p[0], p[1], p[2], p[3], p[4], p[5], p[6], p[7]);
            const bf16x8 pf11 = pack8(p[8], p[9], p[10], p[11], p[12], p[13], p[14], p[15]);
            __builtin_amdgcn_sched_barrier(0);
#pragma unroll
            for (int dvb = 0; dvb < 4; ++dvb) O[dvb] = MFMA32(vf[2 * dvb], pf10, O[dvb]);
#pragma unroll
            for (int dvb = 0; dvb < 4; ++dvb) O[dvb] = MFMA32(vf[2 * dvb + 1], pf11, O[dvb]);
        }
#undef SCORE_TO_P
    }
    __syncthreads();
    if (MODE == 0) { const float linv = 1.0f / (lsum + shx(lsum, 32, lane));
#pragma unroll
        for (int d = 0; d < 4; ++d)
#pragma unroll
            for (int i = 0; i < 16; ++i) O[d][i] *= linv; }
    LAS float* ex = (LAS float*)(lds + g * 16384) + lane;
    if (MODE == 0 && m == 1) {
#pragma unroll
        for (int d = 0; d < 4; ++d)
#pragma unroll
            for (int i = 0; i < 16; ++i) ex[(d * 16 + i) * 64] = O[d][i];
    }
    __syncthreads();
    if (m == 0) {
        float ss = 0.f;
#pragma unroll
        for (int d = 0; d < 4; ++d)
#pragma unroll
            for (int i = 0; i < 16; ++i) { float o = O[d][i]; if (MODE == 0) { o -= lam * ex[(d * 16 + i) * 64]; O[d][i] = o; } ss += o * o; }
        ss += shx(ss, 32, lane);
        const float rr = (1.0f / sqrtf(ss * (1.f / 128.f) + NORM_EPS)) * oscale;
        const float* gout = MODE == 0 ? a.in[11] + l * 128 : a.in[14] + l * 128;
        const size_t trow = rowbase + nq;
        bf16* yo = (bf16*)(a.ws + (MODE == 0 ? WS_YB : WS_YC)) + trow * 512 + h * 128 + 4 * hh;
        const bf16* cg = proj + trow * NINP + C_CG + h * 128 + 4 * hh;
#pragma unroll
        for (int d = 0; d < 4; ++d)
#pragma unroll
            for (int q = 0; q < 4; ++q) {
                const int dv = 32 * d + 8 * q;
                const f32x4 gg = *(const f32x4*)(gout + dv + 4 * hh);
                float y0 = O[d][4 * q] * rr * gg.x, y1 = O[d][4 * q + 1] * rr * gg.y, y2 = O[d][4 * q + 2] * rr * gg.z, y3 = O[d][4 * q + 3] * rr * gg.w;
                if (MODE == 1) { const u32x2 cw = *(const u32x2*)(cg + dv);
                    const float c0 = bflo(cw.x), c1 = bfhi(cw.x), c2 = bflo(cw.y), c3 = bfhi(cw.y);
                    y0 *= c0 / (1.0f + __expf(-c0)); y1 *= c1 / (1.0f + __expf(-c1)); y2 *= c2 / (1.0f + __expf(-c2)); y3 *= c3 / (1.0f + __expf(-c3)); }
                u32x2 w; w.x = pk2(y0, y1); w.y = pk2(y2, y3); *(u32x2*)(yo + dv) = w;
            }
    }
    __syncthreads();
}

#ifndef PHM
#define PHM 0xFFFF
#endif
#ifndef DBL
#define DBL 0
#endif
#define REP(k) for (int rep_ = 0; rep_ < (((DBL >> (k)) & 1) ? 2 : 1); ++rep_)
#define PH(k) if constexpr ((PHM >> (k)) & 1)
#define XB_TMO      128
#define XB_XCNT(j)  (256  + 64 * (j))
#define XB_XSUB(j)  (1280 + 64 * (j))
#define XB_XGEN(j)  (2304 + 64 * (j))
#define XB_TOP      3328
#define XB_TOPGEN   3392
#define XCD_BAR_WORDS 3456
#define XB_SPIN_CAP (1u << 18)

__device__ __forceinline__ unsigned xb_ld(unsigned* p)              { return __hip_atomic_load(p, __ATOMIC_RELAXED, __HIP_MEMORY_SCOPE_AGENT); }
__device__ __forceinline__ unsigned xb_add(unsigned* p, unsigned v) { return __hip_atomic_fetch_add(p, v, __ATOMIC_RELAXED, __HIP_MEMORY_SCOPE_AGENT); }
__device__ __forceinline__ unsigned xb_xcc_id() { return (unsigned)__builtin_amdgcn_s_getreg((3 << 11) | 20) & 0xFu; }
#define XB_SPIN(cond, bar) do { unsigned _sp = 0; while (cond) { __builtin_amdgcn_s_sleep(1); \
    if ((++_sp & 255u) == 0u) { if (xb_ld(&(bar)[XB_TMO])) break; if (_sp > XB_SPIN_CAP) { atomicAdd(&(bar)[XB_TMO], 1u); break; } } } } while (0)

struct XcdBarrier {
    unsigned* bar; unsigned x;
    volatile LAS unsigned* st;
};

__device__ __forceinline__ XcdBarrier xcd_barrier_post(unsigned* bar, volatile LAS unsigned* st) {
    XcdBarrier b; b.bar = bar; b.x = xb_xcc_id(); b.st = st;
    if (threadIdx.x == 0) (void)xb_add(&bar[XB_XCNT(b.x)], 1u);
    return b;
}
__device__ __forceinline__ void xcd_barrier_complete(unsigned* bar, unsigned x, unsigned& nloc, unsigned& nx) {
    const unsigned G = gridDim.x * gridDim.y * gridDim.z;
    unsigned sum, cnt, mine, sp = 0u;
    for (;;) {
        sum = 0u; cnt = 0u; mine = 0u;
#pragma unroll
        for (unsigned j = 0; j < 16; ++j) { const unsigned c = xb_ld(&bar[XB_XCNT(j)]); sum += c; cnt += (c > 0u) ? 1u : 0u; mine = (j == x) ? c : mine; }
        if (sum == G) break;
        __builtin_amdgcn_s_sleep(1);
        if ((++sp & 255u) == 0u) { if (xb_ld(&bar[XB_TMO])) break; if (sp > XB_SPIN_CAP) { atomicAdd(&bar[XB_TMO], 1u); break; } }
    }
    nloc = mine > 0u ? mine : 1u; nx = cnt > 0u ? cnt : 1u;
}

__device__ __forceinline__ void xcd_barrier(const XcdBarrier& b) {
    asm volatile("s_waitcnt vmcnt(0)" ::: "memory");
    __syncthreads();
    if (threadIdx.x == 0) {
        unsigned* bar = b.bar;
        __builtin_amdgcn_s_waitcnt(0);
        unsigned nloc = b.st[0], nx = b.st[1];
        if (nloc == 0u) { xcd_barrier_complete(bar, b.x, nloc, nx); b.st[0] = nloc; b.st[1] = nx; }
        const unsigned old = xb_add(&bar[XB_XSUB(b.x)], 1u);
        const unsigned gen = old / nloc;
        if (old + 1u == (gen + 1u) * nloc) {
            __builtin_amdgcn_fence(__ATOMIC_RELEASE, "agent");
            asm volatile("s_waitcnt vmcnt(0)" ::: "memory");
            const unsigned og = xb_add(&bar[XB_TOP], 1u);
            const unsigned tg = og / nx;
            if (og + 1u == (tg + 1u) * nx) xb_add(&bar[XB_TOPGEN], 1u);
            else XB_SPIN(xb_ld(&bar[XB_TOPGEN]) == tg, bar);
            __builtin_amdgcn_fence(__ATOMIC_ACQUIRE, "agent");
            xb_add(&bar[XB_XGEN(b.x)], 1u);
            asm volatile("s_waitcnt vmcnt(0)" ::: "memory");
        } else {
            XB_SPIN(xb_ld(&bar[XB_XGEN(b.x)]) == gen, bar);
            __builtin_amdgcn_fence(__ATOMIC_ACQUIRE, "agent");
            asm volatile("s_waitcnt vmcnt(0)" ::: "memory");
        }
    }
    __syncthreads();
}

typedef __attribute__((address_space(4))) const Args* CArgsP;
__device__ __forceinline__ Args load_args() {
    Args r{};
#if defined(__HIP_DEVICE_COMPILE__)
    CArgsP p = (CArgsP)__builtin_amdgcn_kernarg_segment_ptr(); asm volatile("" : "+s"(p));
#pragma unroll
    for (int i = 0; i < 22; ++i) r.in[i] = p->in[i];
    r.out = p->out; r.ws = p->ws;
#endif
    return r;
}
#define TIDS() const int tid = otid(), lane = tid & 63, wave = __builtin_amdgcn_readfirstlane(tid >> 6), gw = bx * NWAVES + wave, gtid = bx * NTHR + tid; (void)lane; (void)gw; (void)gtid
__global__ void __launch_bounds__(NTHR, 2) fwd_megakernel(Args a_unused) {
    extern __shared__ __attribute__((aligned(16))) unsigned char lds_raw[];
    LAS unsigned char* lds = (LAS unsigned char*)lds_raw;
    cg::grid_group grid = cg::this_grid();
    const int G = gridDim.x, bx = blockIdx.x;
    const int NGW = G * NWAVES, NT = G * NTHR;
    if (threadIdx.x < 2) ((volatile LAS unsigned*)(lds + MISC_OFF))[threadIdx.x] = 0u;
    __syncthreads();
    { const Args a = load_args(); (void)xcd_barrier_post((unsigned*)(a.ws + WS_CTL), (volatile LAS unsigned*)(lds + MISC_OFF)); }
#define GSYNC() do { const Args a_ = load_args(); XcdBarrier b_; b_.bar = (unsigned*)(a_.ws + WS_CTL); b_.x = xb_xcc_id(); b_.st = (volatile LAS unsigned*)(lds + MISC_OFF); xcd_barrier(b_); } while (0)

    for (int l = 0; l < DEPTH; ++l) {
        PH(0) REP(0) { const Args a = load_args(); TIDS(); phase_prep(a, l, lds, gw, NGW, wave, lane, (l == 0) ? a.in[0] : a.out); }
        { const Args a_ = load_args(); if (a_.ws == nullptr) grid.sync(); }
        GSYNC();
        if constexpr ((DBL >> 8) & 1) { for (int i_ = 0; i_ < 10; ++i_) GSYNC(); }
        PH(1) REP(1) { const Args a = load_args(); unsigned char* ws = a.ws;
          pg8::Gemm g{(const bf16*)(ws + WS_ACT), (const bf16*)(ws + WS_WIN), M, NINP, DM}; pg8::StaticOrder S; S.init(M, NINP, G, bx);
          pg8::EpiStore<0> E{(bf16*)(ws + WS_PROJ), NINP};
          pg8::gemm_phase<pg8::EpiStore<0>, pg8::StaticOrder, true, true>(lds, g, S, E); }
        GSYNC();
        PH(2) { const Args a = load_args(); TIDS(); phase_postproj(a, l, gtid, NT, lane);
                for (int it = gw; it < 2048; it += NGW) { const int c = it >> 10;
                    vt_item((const bf16*)(a.ws + WS_PROJ), (bf16*)(a.ws + (c ? WS_VTC : WS_VTB)), c ? C_CV : C_BV, it & 1023, lds + wave * 17408, lane); } }
        GSYNC();
        {
            const Args a = load_args(); TIDS();
            PH(5) { if (G == 256) { if (bx >= 128) for (int it = bx - 128; it < 256; it += 128) ret_state_item(a, l, it, lds); }
                    else for (int it = bx; it < 256; it += G) ret_state_item(a, l, it, lds); }
            PH(3) {
            const float gqa = wave_max(fabsf(a.in[3][l * 64 + lane]), lane), gka = wave_max(fabsf(a.in[4][l * 64 + lane]), lane);
            const float M2a = 8.0f * LOG2E * gqa * gka;
            REP(2) for (int it = gw; it < 3072; it += NGW) attn_a_item(a, it, lds + wave * 16384, lane, M2a);
            }
            __syncthreads();
            PH(4) {
            const float gqb = wave_max(fabsf(a.in[5][l * 64 + lane]), lane), gkb = wave_max(fabsf(a.in[6][l * 64 + lane]), lane);
            const float M2b = 8.0f * LOG2E * gqb * gkb;
            const float lam_init = 0.8f - 0.6f * expf(-0.3f * (float)l);
            const float s1 = wave_sum(a.in[7][l * 64 + lane] * a.in[8][l * 64 + lane], lane), s2 = wave_sum(a.in[9][l * 64 + lane] * a.in[10][l * 64 + lane], lane);
            const float lam = expf(s1) - expf(s2) + lam_init;
            REP(3) for (int u0 = bx; u0 < 512; u0 += G) { const int v = u0 & 255, u = (((v & 7) * 2 + (v >> 7)) + 16 * (u0 >> 8)) * 16 + ((v >> 3) & 15); attn_dense_unit<0>(a, l, u, lds, M2b, lam, 1.0f - lam_init); }
            }
        }
        GSYNC();
        {
            const Args a = load_args(); TIDS();
            PH(5) REP(4) for (int u0 = bx; u0 < 256; u0 += G) { const int u = ((u0 & 7) * 4 + (u0 >> 6)) * 8 + ((u0 >> 3) & 7); attn_dense_unit<1>(a, l, u, lds, 0.f, 0.f, 1.0f); }
            const float* lA = (const float*)(a.ws + WS_LA); bf16* ya = (bf16*)(a.ws + WS_YA);
            for (int e0 = gtid; e0 < M * 48; e0 += 3 * NT) {
                u32x4 w[3]; float lt[3]; u32x4* pp[3];
#pragma unroll
                for (int q = 0; q < 3; ++q) { int e = e0 + q * NT; e = e < M * 48 ? e : e0; const int t = e / 48, ch = e % 48, hg = (ch >> 3) & 1;
                    lt[q] = lA[t * 6 + hg] + lA[t * 6 + 2 + hg] + lA[t * 6 + 4 + hg]; pp[q] = (u32x4*)(ya + (size_t)t * 384 + ch * 8); w[q] = *pp[q]; }
#pragma unroll
                for (int q = 0; q < 3; ++q) { const float li = 1.0f / lt[q]; u32x4 v = w[q];
                    v.x = pk2(bflo(v.x) * li, bfhi(v.x) * li); v.y = pk2(bflo(v.y) * li, bfhi(v.y) * li);
                    v.z = pk2(bflo(v.z) * li, bfhi(v.z) * li); v.w = pk2(bflo(v.w) * li, bfhi(v.w) * li); *pp[q] = v; }
            }
        }
        GSYNC();
        PH(6) {
          { const Args a = load_args(); unsigned char* ws = a.ws; pg8::StaticOrder S; S.init(M, DM, G, bx);
            pg8::Gemm g{(const bf16*)(ws + WS_YA), (const bf16*)(ws + WS_WBRA), M, DM, 384}; pg8::EpiGate<0> E{(const bf16*)(ws + WS_PROJ) + C_GATE, NINP, nullptr, (bf16*)(ws + WS_T1)};
            pg8::gemm_phase<pg8::EpiGate<0>, pg8::StaticOrder, true, true>(lds, g, S, E); }
          { const Args a = load_args(); unsigned char* ws = a.ws; pg8::StaticOrder S; S.init(M, DM, G, bx);
            pg8::Gemm g{(const bf16*)(ws + WS_YB), (const bf16*)(ws + WS_WBRB), M, DM, 512}; pg8::EpiGate<1> E{(const bf16*)(ws + WS_PROJ) + C_GATE + 1024, NINP, (const bf16*)(ws + WS_T1), (bf16*)(ws + WS_T2)};
            pg8::gemm_phase<pg8::EpiGate<1>, pg8::StaticOrder, true, true>(lds, g, S, E); }
          { const Args a = load_args(); unsigned char* ws = a.ws; pg8::StaticOrder S; S.init(M, DM, G, bx);
            pg8::Gemm g{(const bf16*)(ws + WS_YC), (const bf16*)(ws + WS_WBRC), M, DM, 512}; pg8::EpiGate<1> E{(const bf16*)(ws + WS_PROJ) + C_GATE + 2048, NINP, (const bf16*)(ws + WS_T2), (bf16*)(ws + WS_ACT)};
            pg8::gemm_phase<pg8::EpiGate<1>, pg8::StaticOrder, true, true>(lds, g, S, E); } }
        GSYNC();
        PH(7) { const Args a = load_args(); unsigned char* ws = a.ws;
          pg8::Gemm g{(const bf16*)(ws + WS_ACT), (const bf16*)(ws + WS_WO), M, DM, DM}; pg8::StaticOrder S; S.init(M, DM, G, bx);
          pg8::EpiResid E{(l == 0) ? a.in[0] : a.out, a.out};
          pg8::gemm_phase<pg8::EpiResid, pg8::StaticOrder, true, true>(lds, g, S, E); }
        GSYNC();
        { const Args a = load_args(); TIDS(); const float* g2 = a.in[19] + (size_t)l * DM; bf16* act = (bf16*)(a.ws + WS_ACT);
          rms_rows_to_bf16(a.out, g2, act, gw, NGW, lane); }
        GSYNC();
        PH(8) { const Args a = load_args(); unsigned char* ws = a.ws;
          pg8::Gemm g{(const bf16*)(ws + WS_ACT), (const bf16*)(ws + WS_W1), M, DFF, DM}; pg8::StaticOrder S; S.init(M, DFF, G, bx);
          pg8::EpiStore<1> E{(bf16*)(ws + WS_H), DFF};
          pg8::gemm_phase<pg8::EpiStore<1>, pg8::StaticOrder, true, true>(lds, g, S, E); }
        GSYNC();
        PH(9) { const Args a = load_args(); unsigned char* ws = a.ws;
          pg8::Gemm g{(const bf16*)(ws + WS_H), (const bf16*)(ws + WS_W2), M, DM, DFF}; pg8::StaticOrder S; S.init(M, DM, G, bx);
          pg8::EpiResid E{a.out, a.out};
          pg8::gemm_phase<pg8::EpiResid, pg8::StaticOrder, true, true>(lds, g, S, E); }
        GSYNC();
    }
}

extern "C" void kernel_launch(void* const* d_in, const int* in_sizes, int n_in, void* d_out, int out_size, void* d_ws, size_t ws_size, hipStream_t stream) {
    static int grid = 0;
    if (grid == 0) {
        if (n_in != 22 || out_size != M * DM || ws_size < WS_CTL + CTL_BYTES) { fprintf(stderr, "kernel_launch: unexpected shapes (n_in %d out %d ws %zu)\n", n_in, out_size, ws_size); grid = -1; return; }
        int dev = 0, cus = 0, per_cu = 0;
        hipGetDevice(&dev); hipDeviceGetAttribute(&cus, hipDeviceAttributeMultiprocessorCount, dev);
        hipFuncSetAttribute((const void*)fwd_megakernel, hipFuncAttributeMaxDynamicSharedMemorySize, LDS_BYTES);
        hipOccupancyMaxActiveBlocksPerMultiprocessor(&per_cu, (const void*)fwd_megakernel, NTHR, LDS_BYTES);
        if (per_cu < 1) { fprintf(stderr, "kernel_launch: occupancy query says %d blocks/CU\n", per_cu); per_cu = 1; }
        (void)hipGetLastError();
        grid = cus;
    }
    if (grid < 0) return;
    if (hipMemsetAsync((char*)d_ws + WS_CTL, 0, CTL_BYTES, stream) != hipSuccess) { fprintf(stderr, "kernel_launch: memset failed\n"); return; }
    Args a{};
    for (int i = 0; i < 22; ++i) a.in[i] = (const float*)d_in[i];
    a.out = (float*)d_out; a.ws = (unsigned char*)d_ws;
    void* args[] = {&a};
    hipError_t e = hipLaunchCooperativeKernel((const void*)fwd_megakernel, dim3(grid), dim3(NTHR), args, LDS_BYTES, stream);
    if (e != hipSuccess) fprintf(stderr, "cooperative launch failed: %s (grid %d)\n", hipGetErrorString(e), grid);
}
```

```cpp
#include <hip/hip_runtime.h>
#include <hip/hip_cooperative_groups.h>
#include <cstdio>
#include <cstdint>
namespace cg = cooperative_groups;
namespace pg8 {
#define PG8_LAS __attribute__((address_space(3)))
typedef unsigned short bf16_t;
typedef short bf16x8 __attribute__((ext_vector_type(8)));
typedef float f32x4 __attribute__((ext_vector_type(4)));
typedef unsigned u32x4 __attribute__((ext_vector_type(4)));
constexpr int BM = 256, BK = 64, HALF = 128, HTB = HALF * BK * 2  , STAGE_BYTES = 8 * HTB, NXCD = 8, WGM = 8;

__host__ __device__ __forceinline__ int lds_byte(int r, int c) { const int st = (r >> 4) * 2 + (c >> 5), rr = r & 15, cc = c & 31, ob = rr * 64 + cc * 2; return st * 1024 + (ob ^ (((ob >> 9) & 1) << 5)); }
__host__ __device__ __forceinline__ void stage_rc(int b, int& R, int& C) { const int st = b / 1024, sb = b % 1024, swz = sb ^ (((sb >> 9) & 1) << 5); R = (st >> 1) * 16 + swz / 64; C = (st & 1) * 32 + (swz % 64) / 2; }
__host__ __device__ __forceinline__ int perm32(int rho) { const int n = rho >> 4, i = rho & 15; return 8 * (i >> 2) + 4 * n + (i & 3); }

struct Unit { int pm, pn; };
struct Gemm { const bf16_t* A; const bf16_t* Bt; int M, N, K; };

struct StaticOrder {
    int nM, nN, nwg, G, c;
    __host__ __device__ void init(int M, int N, int G_, int c_) { nM = M / BM; nN = N / BM; nwg = nM * nN; G = G_; c = c_; }
    __host__ __device__ bool next(int i, Unit& u) const {
        const long L = (long)i * G + c; if (L >= nwg) return false;
        int wgid = (int)L; { const int q = nwg / NXCD, r = nwg % NXCD, xcd = wgid % NXCD, off = wgid / NXCD; wgid = (xcd < r ? xcd * (q + 1) : r * (q + 1) + (xcd - r) * q) + off; }
        const int nig = WGM * nN, gid = wgid / nig, fm = gid * WGM, gsz = (nM - fm) < WGM ? (nM - fm) : WGM;
        u.pm = fm + ((wgid % nig) % gsz); u.pn = (wgid % nig) / gsz; return true;
    }
    __device__ __forceinline__ void a_ready(const Unit&) const {}
    __device__ __forceinline__ void done(const Unit&) const {}
};

__device__ __forceinline__ unsigned cvt_pk_bf16(float lo, float hi) { unsigned r; asm volatile("v_cvt_pk_bf16_f32 %0, %1, %2" : "=v"(r) : "v"(lo), "v"(hi)); return r; }
typedef float f32x2 __attribute__((ext_vector_type(2)));
typedef unsigned u32x2 __attribute__((ext_vector_type(2)));
__device__ __forceinline__ float bflo(unsigned w) { return __uint_as_float(w << 16); }
__device__ __forceinline__ float bfhi(unsigned w) { return __uint_as_float(w & 0xffff0000u); }
template <int ACT> struct EpiStore {
    static constexpr bool PERM = true, AFTER_DRAIN = false;
    bf16_t* O; int ldc;
    __device__ __forceinline__ void operator()(const f32x4 (&acc)[2][2][4][2], const Unit& u, int wr, int wc, int fr, int fq) const {
        const int row0 = u.pm * BM + wr * 64 + fr, col0 = u.pn * BM + wc * 32 + 8 * fq;
#pragma unroll
        for (int ai = 0; ai < 2; ++ai)
#pragma unroll
            for (int m = 0; m < 4; ++m) { const unsigned off = ((unsigned)(row0 + ai * HALF + m * 16) * (unsigned)ldc + (unsigned)col0) * 2u;
#pragma unroll
                for (int bj = 0; bj < 2; ++bj) { f32x4 v0 = acc[ai][bj][m][0], v1 = acc[ai][bj][m][1];
                    if (ACT == 1) {
#pragma unroll
                        for (int e = 0; e < 4; ++e) { float a = fmaxf(v0[e], 0.f), b = fmaxf(v1[e], 0.f); v0[e] = a * a; v1[e] = b * b; } }
                    u32x4 w; w.x = cvt_pk_bf16(v0[0], v0[1]); w.y = cvt_pk_bf16(v0[2], v0[3]); w.z = cvt_pk_bf16(v1[0], v1[1]); w.w = cvt_pk_bf16(v1[2], v1[3]);
                    *(u32x4*)((char*)O + off + (unsigned)(bj * HALF) * 2u) = w; } }
    }
};
template <int HAS_IN> struct EpiGate {
    static constexpr bool PERM = true, AFTER_DRAIN = false;
    const bf16_t* gate; int ldg; const bf16_t* Tin; bf16_t* Tout;
    __device__ __forceinline__ void operator()(const f32x4 (&acc)[2][2][4][2], const Unit& u, int wr, int wc, int fr, int fq) const {
        const int row0 = u.pm * BM + wr * 64 + fr, col0 = u.pn * BM + wc * 32 + 8 * fq;
#pragma unroll
        for (int ai = 0; ai < 2; ++ai)
#pragma unroll
            for (int mp = 0; mp < 2; ++mp) {
                u32x4 gw[2][2], tw[2][2];
#pragma unroll
                for (int mm = 0; mm < 2; ++mm)
#pragma unroll
                    for (int bj = 0; bj < 2; ++bj) { const unsigned row = (unsigned)(row0 + ai * HALF + (2 * mp + mm) * 16);
                        gw[mm][bj] = *(const u32x4*)((const char*)gate + (row * (unsigned)ldg + (unsigned)(col0 + bj * HALF)) * 2u);
                        if (HAS_IN) tw[mm][bj] = *(const u32x4*)((const char*)Tin + (row * 1024u + (unsigned)(col0 + bj * HALF)) * 2u); else tw[mm][bj] = (u32x4){0u, 0u, 0u, 0u}; }
                asm volatile("" ::: "memory");
#pragma unroll
                for (int mm = 0; mm < 2; ++mm)
#pragma unroll
                    for (int bj = 0; bj < 2; ++bj) { const int m = 2 * mp + mm; const unsigned row = (unsigned)(row0 + ai * HALF + m * 16);
                        const f32x4 v0 = acc[ai][bj][m][0], v1 = acc[ai][bj][m][1]; const u32x4 g4 = gw[mm][bj], t4 = tw[mm][bj];
                        const float gg[8] = {bflo(g4.x), bfhi(g4.x), bflo(g4.y), bfhi(g4.y), bflo(g4.z), bfhi(g4.z), bflo(g4.w), bfhi(g4.w)};
                        const float ti[8] = {bflo(t4.x), bfhi(t4.x), bflo(t4.y), bfhi(t4.y), bflo(t4.z), bfhi(t4.z), bflo(t4.w), bfhi(t4.w)};
                        float o[8];
#pragma unroll
                        for (int e = 0; e < 8; ++e) { const float s = __builtin_amdgcn_rcpf(1.0f + __builtin_amdgcn_exp2f(-1.4426950408889634f * gg[e])); o[e] = ti[e] + s * (e < 4 ? v0[e & 3] : v1[e & 3]); }
                        u32x4 w; w.x = cvt_pk_bf16(o[0], o[1]); w.y = cvt_pk_bf16(o[2], o[3]); w.z = cvt_pk_bf16(o[4], o[5]); w.w = cvt_pk_bf16(o[6], o[7]);
                        *(u32x4*)((char*)Tout + (row * 1024u + (unsigned)(col0 + bj * HALF)) * 2u) = w; }
                asm volatile("" ::: "memory"); }
    }
};
struct EpiResid {
    static constexpr bool PERM = false, AFTER_DRAIN = false;
    const float* base; float* out;
    __device__ __forceinline__ void operator()(const f32x4 (&acc)[2][2][4][2], const Unit& u, int wr, int wc, int fr, int fq) const {
        const int row0 = u.pm * BM + wr * 64 + fr, col0 = u.pn * BM + wc * 32 + 4 * fq;
        f32x4 bs[2][2][2][2];
#define ER_LOAD(c) do { _Pragma("unroll") for (int mm = 0; mm < 2; ++mm) _Pragma("unroll") for (int bj = 0; bj < 2; ++bj) _Pragma("unroll") for (int n = 0; n < 2; ++n) \
            bs[(c) & 1][mm][bj][n] = *(const f32x4*)((const char*)base + ((unsigned)(row0 + ((c) >> 1) * HALF + (2 * ((c) & 1) + mm) * 16) * 1024u + (unsigned)(col0 + bj * HALF + n * 16)) * 4u); } while (0)
        ER_LOAD(0);
#pragma unroll
        for (int c = 0; c < 4; ++c) {
            if (c + 1 < 4) ER_LOAD(c + 1);
            const int ai = c >> 1, mp = c & 1;
#pragma unroll
            for (int mm = 0; mm < 2; ++mm)
#pragma unroll
                for (int bj = 0; bj < 2; ++bj)
#pragma unroll
                    for (int n = 0; n < 2; ++n) *(f32x4*)((char*)out + ((unsigned)(row0 + ai * HALF + (2 * mp + mm) * 16) * 1024u + (unsigned)(col0 + bj * HALF + n * 16)) * 4u) = bs[c & 1][mm][bj][n] + acc[ai][bj][2 * mp + mm][n];
        }
#undef ER_LOAD
    }
};

template <class Epi, class Sched, bool ALIGN_EPI = false, bool SP2 = false>
__device__ __forceinline__ void gemm_phase(PG8_LAS unsigned char* lds, const Gemm g, const Sched& S, const Epi& E) {
    int tid_ = threadIdx.x; asm volatile("" : "+v"(tid_));
    const int tid = tid_, wid = __builtin_amdgcn_readfirstlane(tid >> 6), lane = tid & 63, wr = wid >> 2, wc = wid & 3, fr = lane & 15, fq = lane >> 4;
    const int K = g.K, nt = K / BK;
    unsigned voffA[2], voffB[2];
#pragma unroll
    for (int i = 0; i < 2; ++i) { int R, C; stage_rc(tid * 16 + i * 8192, R, C); const int Rb = Epi::PERM ? ((R & ~31) + perm32(R & 31)) : R;
        voffA[i] = (unsigned)(R * K + C) * 2u; voffB[i] = (unsigned)(Rb * K + C) * 2u; }
    const size_t kstep = (size_t)(BK * 2);
    const size_t hstep = (size_t)HALF * K * 2;
    const size_t tstep = 2 * hstep;
    const unsigned ldsw = (unsigned)wid * 1024u;
    const int aoff = lds_byte(wr * 64 + fr, fq * 8), boff = lds_byte(wc * 32 + fr, fq * 8);
#define PG8_SA(b, h) (((b) * 2 + (h)) * HTB)
#define PG8_SB(b, h) ((4 + (b) * 2 + (h)) * HTB)
#define PG8_STAGE(bufoff, gbase, voff) do { _Pragma("unroll") for (int _i = 0; _i < 2; ++_i) \
        __builtin_amdgcn_global_load_lds((const unsigned*)((const char*)(gbase) + (voff)[_i]), (PG8_LAS unsigned*)(lds + (bufoff) + ldsw + _i * 8192), 16, 0, 0); } while (0)
#define PG8_LDA(dst, b, h) do { _Pragma("unroll") for (int m = 0; m < 4; ++m) _Pragma("unroll") for (int k = 0; k < 2; ++k) dst[m][k] = *(const PG8_LAS bf16x8*)(lds + PG8_SA(b, h) + aoff + m * 2048 + k * 1024); } while (0)
#define PG8_LDB(dst, b, h) do { _Pragma("unroll") for (int n = 0; n < 2; ++n) _Pragma("unroll") for (int k = 0; k < 2; ++k) dst[n][k] = *(const PG8_LAS bf16x8*)(lds + PG8_SB(b, h) + boff + n * 2048 + k * 1024); } while (0)
#define PG8_MMA(ai, bj, At, Bt) do { __builtin_amdgcn_s_setprio(1); _Pragma("unroll") for (int m = 0; m < 4; ++m) _Pragma("unroll") for (int n = 0; n < 2; ++n) _Pragma("unroll") for (int k = 0; k < 2; ++k) \
        acc[ai][bj][m][n] = __builtin_amdgcn_mfma_f32_16x16x32_bf16(Bt[n][k], At[m][k], acc[ai][bj][m][n], 0, 0, 0); __builtin_amdgcn_s_setprio(0); } while (0)
#define PG8_WAIT_V(n) asm volatile("s_waitcnt vmcnt(" #n ")" ::: "memory")
#define PG8_WAIT_L(n) asm volatile("s_waitcnt lgkmcnt(" #n ")" ::: "memory")
#define PG8_BAR __builtin_amdgcn_s_barrier()
#define PG8_SCHED __builtin_amdgcn_sched_barrier(0)
    Unit cur, nxt; int ui = 0;
    if (!S.next(0, cur)) return;
    f32x4 acc[2][2][4][2];
#pragma unroll
    for (int a = 0; a < 2; ++a)
#pragma unroll
        for (int b = 0; b < 2; ++b)
#pragma unroll
            for (int m = 0; m < 4; ++m)
#pragma unroll
                for (int n = 0; n < 2; ++n) acc[a][b][m][n] = (f32x4){0.f, 0.f, 0.f, 0.f};
    bf16x8 At[4][2], B0[2][2], B1[2][2];
    const char* cA = (const char*)g.A + (size_t)cur.pm * tstep; const char* cB = (const char*)g.Bt + (size_t)cur.pn * tstep;
    S.a_ready(cur);
    if constexpr (SP2) {
        PG8_STAGE(PG8_SB(0, 0), cB, voffB); PG8_STAGE(PG8_SB(0, 1), cB + hstep, voffB); PG8_STAGE(PG8_SA(0, 0), cA, voffA); PG8_STAGE(PG8_SA(0, 1), cA + hstep, voffA);
        if (wr == 1) PG8_BAR;
        PG8_WAIT_V(2); PG8_BAR;
        PG8_STAGE(PG8_SB(1, 0), cB + kstep, voffB); PG8_STAGE(PG8_SA(1, 0), cA + kstep, voffA); PG8_STAGE(PG8_SB(1, 1), cB + hstep + kstep, voffB);
        PG8_WAIT_V(6); PG8_BAR;
    } else {
        PG8_STAGE(PG8_SB(0, 0), cB, voffB); PG8_STAGE(PG8_SA(0, 0), cA, voffA); PG8_STAGE(PG8_SB(0, 1), cB + hstep, voffB); PG8_STAGE(PG8_SA(0, 1), cA + hstep, voffA);
        if (wr == 1) PG8_BAR;
        PG8_WAIT_V(4); PG8_BAR;
        PG8_STAGE(PG8_SB(1, 0), cB + kstep, voffB); PG8_STAGE(PG8_SA(1, 0), cA + kstep, voffA); PG8_STAGE(PG8_SB(1, 1), cB + hstep + kstep, voffB);
        PG8_WAIT_V(6); PG8_BAR;
    }
    for (;;) {
        const bool has_next = S.next(ui + 1, nxt);
        const char* nA = has_next ? (const char*)g.A + (size_t)nxt.pm * tstep : cA; const char* nB = has_next ? (const char*)g.Bt + (size_t)nxt.pn * tstep : cB;
        for (int t = 0; t < nt; t += 2) {
            const bool last = (t == nt - 2);
            const char* a1 = cA + (size_t)(t + 1) * kstep;
            const char* a2 = last ? nA : cA + (size_t)(t + 2) * kstep; const char* b2 = last ? nB : cB + (size_t)(t + 2) * kstep;
            const char* a3 = a2 + kstep; const char* b3 = b2 + kstep;
            if (last && has_next) S.a_ready(nxt);
            if constexpr (SP2) {
            PG8_LDB(B0, 0, 0); PG8_LDB(B1, 0, 1); PG8_SCHED; PG8_LDA(At, 0, 0); PG8_STAGE(PG8_SA(1, 1), a1 + hstep, voffA);
            PG8_WAIT_V(8); PG8_WAIT_L(0); PG8_BAR; PG8_MMA(0, 0, At, B0); PG8_MMA(0, 1, At, B1); PG8_BAR; PG8_SCHED;
            PG8_LDA(At, 0, 1); PG8_STAGE(PG8_SB(0, 0), b2, voffB); PG8_STAGE(PG8_SB(0, 1), b2 + hstep, voffB); PG8_STAGE(PG8_SA(0, 0), a2, voffA);
            PG8_WAIT_V(8); PG8_WAIT_L(0); PG8_BAR; PG8_MMA(1, 0, At, B0); PG8_MMA(1, 1, At, B1); PG8_BAR; PG8_SCHED;
            PG8_LDB(B0, 1, 0); PG8_LDB(B1, 1, 1); PG8_SCHED; PG8_LDA(At, 1, 0); PG8_STAGE(PG8_SA(0, 1), a2 + hstep, voffA);
            PG8_WAIT_V(8); PG8_WAIT_L(0); PG8_BAR; PG8_MMA(0, 0, At, B0); PG8_MMA(0, 1, At, B1); PG8_BAR; PG8_SCHED;
            PG8_LDA(At, 1, 1); PG8_STAGE(PG8_SB(1, 0), b3, voffB); PG8_STAGE(PG8_SB(1, 1), b3 + hstep, voffB); PG8_STAGE(PG8_SA(1, 0), a3, voffA);
            PG8_WAIT_V(8); PG8_WAIT_L(0); PG8_BAR; PG8_MMA(1, 0, At, B0); PG8_MMA(1, 1, At, B1); PG8_BAR; PG8_SCHED;
            } else {
            PG8_LDB(B0, 0, 0); PG8_SCHED; PG8_LDA(At, 0, 0); PG8_STAGE(PG8_SA(1, 1), a1 + hstep, voffA);
            PG8_WAIT_L(8); PG8_BAR; PG8_WAIT_L(0); PG8_MMA(0, 0, At, B0); PG8_BAR; PG8_SCHED;
            PG8_LDB(B1, 0, 1); PG8_STAGE(PG8_SB(0, 0), b2, voffB);
            PG8_BAR; PG8_WAIT_L(0); PG8_MMA(0, 1, At, B1); PG8_BAR;
            PG8_LDA(At, 0, 1); PG8_STAGE(PG8_SA(0, 0), a2, voffA);
            PG8_BAR; PG8_WAIT_L(0); PG8_MMA(1, 0, At, B0); PG8_BAR; PG8_SCHED;
            PG8_STAGE(PG8_SB(0, 1), b2 + hstep, voffB);
            PG8_WAIT_V(6); PG8_BAR; PG8_MMA(1, 1, At, B1); PG8_BAR;
            PG8_LDB(B0, 1, 0); PG8_SCHED; PG8_LDA(At, 1, 0); PG8_STAGE(PG8_SA(0, 1), a2 + hstep, voffA);
            PG8_WAIT_L(8); PG8_BAR; PG8_WAIT_L(0); PG8_MMA(0, 0, At, B0); PG8_BAR; PG8_SCHED;
            PG8_LDB(B1, 1, 1); PG8_STAGE(PG8_SB(1, 0), b3, voffB);
            PG8_BAR; PG8_WAIT_L(0); PG8_MMA(0, 1, At, B1); PG8_BAR;
            PG8_LDA(At, 1, 1); PG8_STAGE(PG8_SA(1, 0), a3, voffA);
            PG8_BAR; PG8_WAIT_L(0); PG8_MMA(1, 0, At, B0); PG8_BAR; PG8_SCHED;
            PG8_STAGE(PG8_SB(1, 1), b3 + hstep, voffB);
            PG8_WAIT_V(6); PG8_BAR; PG8_MMA(1, 1, At, B1); PG8_BAR;
            }
        }
        if constexpr (ALIGN_EPI) { if (wr == 0) PG8_BAR; }
        if constexpr (!Epi::AFTER_DRAIN) { E(acc, cur, wr, wc, fr, fq); S.done(cur); }
        if (!has_next) break;
#pragma unroll
        for (int a = 0; a < 2; ++a)
#pragma unroll
            for (int b = 0; b < 2; ++b)
#pragma unroll
                for (int m = 0; m < 4; ++m)
#pragma unroll
                    for (int n = 0; n < 2; ++n) acc[a][b][m][n] = (f32x4){0.f, 0.f, 0.f, 0.f};
        cur = nxt; cA = nA; cB = nB; ++ui;
        if constexpr (ALIGN_EPI) { if (wr == 1) PG8_BAR; }
    }
    PG8_WAIT_V(0);
    if constexpr (!ALIGN_EPI) { if (wr == 0) PG8_BAR; }
    PG8_BAR;
    if constexpr (Epi::AFTER_DRAIN) { E.fused(acc, cur, wr, wc, fr, fq, lds, wid, lane); S.done(cur); }
#undef PG8_SA
#undef PG8_SB
#undef PG8_STAGE
#undef PG8_LDA
#undef PG8_LDB
#undef PG8_MMA
#undef PG8_WAIT_V
#undef PG8_WAIT_L
#undef PG8_BAR
#undef PG8_SCHED
}
}

#define LAS __attribute__((address_space(3)))
typedef unsigned short bf16;
typedef short bf16x8 __attribute__((ext_vector_type(8)));
typedef float f32x4 __attribute__((ext_vector_type(4)));
typedef float f32x16 __attribute__((ext_vector_type(16)));
typedef unsigned u32x4 __attribute__((ext_vector_type(4)));
typedef unsigned u32x2 __attribute__((ext_vector_type(2)));
constexpr int NWAVES = 8, NTHR = 512;
constexpr int SEQ = 2048, NBATCH = 8, M = NBATCH * SEQ, DM = 1024, NIN = 7296, NINP = 7424, DFF = 4096, DEPTH = 4;
constexpr int C_AQ = 0, C_AK = 384, C_AV = 768, C_BQ = 1152, C_BK = 1664, C_BV = 2176, C_CQ = 2688, C_CK = 2944, C_CV = 3200, C_CG = 3712, C_GATE = 4224;
constexpr float NORM_EPS = 1e-6f, LOG2E = 1.4426950408889634f;
constexpr size_t MiB = 1u << 20;
constexpr size_t WS_WIN = 0, WS_WBRA = 16 * MiB, WS_WBRB = 17 * MiB, WS_WBRC = 18 * MiB, WS_WO = 19 * MiB, WS_W1 = 21 * MiB, WS_W2 = 29 * MiB;
constexpr size_t WS_ROPE = 37 * MiB, WS_LA = 38 * MiB, WS_ACT = 40 * MiB, WS_YA = 72 * MiB, WS_YB = 84 * MiB, WS_YC = 100 * MiB, WS_PROJ = 116 * MiB;
constexpr size_t WS_H = WS_PROJ, WS_VTB = 348 * MiB, WS_VTC = 364 * MiB  , WS_T1 = 348 * MiB, WS_T2 = 380 * MiB, WS_END = 412 * MiB;
static_assert(WS_PROJ + (size_t)M * NINP * 2 <= WS_T1, "ws map");
constexpr int LDS_BYTES = 147456, MISC_OFF = 147456 - 256;
constexpr size_t WS_CTL = WS_END, CTL_BYTES = 16384;

__device__ __forceinline__ unsigned pk2(float lo, float hi) { return pg8::cvt_pk_bf16(lo, hi); }
__device__ __forceinline__ float bflo(unsigned w) { return __uint_as_float(w << 16); }
__device__ __forceinline__ float bfhi(unsigned w) { return __uint_as_float(w & 0xffff0000u); }
__device__ __forceinline__ float shx(float v, int mask, int lane) { return __int_as_float(__builtin_amdgcn_ds_bpermute((lane ^ mask) << 2, __float_as_int(v))); }
__device__ __forceinline__ float wave_sum(float v, int lane) {
#pragma unroll
    for (int o = 1; o < 64; o <<= 1) v += shx(v, o, lane);
    return v;
}
__device__ __forceinline__ float wave_max(float v, int lane) {
#pragma unroll
    for (int o = 1; o < 64; o <<= 1) v = fmaxf(v, shx(v, o, lane));
    return v;
}
#define MFMA32(a, b, c) __builtin_amdgcn_mfma_f32_32x32x16_bf16((a), (b), (c), 0, 0, 0)
__device__ __forceinline__ bf16x8 pack8(float a0, float a1, float a2, float a3, float a4, float a5, float a6, float a7) {
    u32x4 p;
    asm volatile("v_cvt_pk_bf16_f32 %0, %4, %5\n\tv_cvt_pk_bf16_f32 %1, %6, %7\n\tv_cvt_pk_bf16_f32 %2, %8, %9\n\tv_cvt_pk_bf16_f32 %3, %10, %11\n\ts_nop 1"
                 : "=&v"(p[0]), "=&v"(p[1]), "=&v"(p[2]), "=&v"(p[3])
                 : "v"(a0), "v"(a1), "v"(a2), "v"(a3), "v"(a4), "v"(a5), "v"(a6), "v"(a7));
    return __builtin_bit_cast(bf16x8, p);
}
__device__ __forceinline__ int kpos(int key) { return (key & ~12) | ((key & 4) << 1) | ((key & 8) >> 1); }

__device__ __forceinline__ void transpose_item(const float* W, int K, int N, bf16* WT, LAS float* scr, int item, int lane) {
    const int nblk = N / 32, kb = item / nblk, nb = item % nblk, k0 = 64 * kb, n0 = 32 * nb;
#pragma unroll 8
    for (int i = 0; i < 32; ++i) { const int kk = 2 * i + (lane >> 5); scr[kk * 33 + (lane & 31)] = W[(size_t)(k0 + kk) * N + n0 + (lane & 31)]; }
    asm volatile("s_waitcnt lgkmcnt(0)" ::: "memory");
    const int c = lane & 7;
#pragma unroll
    for (int j = 0; j < 4; ++j) { const int n = (lane >> 3) + 8 * j; const LAS float* s = scr + (8 * c) * 33 + n;
        u32x4 o; o.x = pk2(s[0 * 33], s[1 * 33]); o.y = pk2(s[2 * 33], s[3 * 33]); o.z = pk2(s[4 * 33], s[5 * 33]); o.w = pk2(s[6 * 33], s[7 * 33]);
        *(u32x4*)(WT + (size_t)(n0 + n) * K + k0 + 8 * c) = o; }
    asm volatile("s_waitcnt lgkmcnt(0)" ::: "memory");
}
__device__ __forceinline__ void rms_rows_to_bf16(const float* x, const float* g, bf16* o, int gw, int NGW, int lane) {
    const f32x4* gr = (const f32x4*)g + lane;
    f32x4 gg[4];
#pragma unroll
    for (int j = 0; j < 4; ++j) gg[j] = gr[64 * j];
    for (int m0 = gw * 4; m0 < M; m0 += NGW * 4) {
        f32x4 v[4][4];
#pragma unroll
        for (int q = 0; q < 4; ++q)
#pragma unroll
            for (int j = 0; j < 4; ++j) v[q][j] = ((const f32x4*)(x + (size_t)(m0 + q) * DM) + lane)[64 * j];
#pragma unroll
        for (int q = 0; q < 4; ++q) { float s = 0.f;
#pragma unroll
            for (int j = 0; j < 4; ++j) s += (v[q][j].x * v[q][j].x + v[q][j].y * v[q][j].y) + (v[q][j].z * v[q][j].z + v[q][j].w * v[q][j].w);
            const float rstd = 1.0f / sqrtf(wave_sum(s, lane) * (1.f / DM) + NORM_EPS);
            unsigned long long* o8 = (unsigned long long*)(o + (size_t)(m0 + q) * DM) + lane;
#pragma unroll
            for (int j = 0; j < 4; ++j)
                o8[64 * j] = (unsigned long long)pk2(v[q][j].x * rstd * gg[j].x, v[q][j].y * rstd * gg[j].y) | ((unsigned long long)pk2(v[q][j].z * rstd * gg[j].z, v[q][j].w * rstd * gg[j].w) << 32); }
    }
}

struct Args { const float* in[22]; float* out; unsigned char* ws; };
__device__ __forceinline__ int otid() { int t = threadIdx.x; asm volatile("" : "+v"(t)); return t; }

__device__ __forceinline__ void phase_prep(const Args& a, int l, LAS unsigned char* lds, int gw, int NGW, int wave, int lane, const float* xsrc) {
    unsigned char* ws = a.ws;
    LAS float* scr = (LAS float*)(lds + wave * 16384);
    const float* w_in = a.in[2] + (size_t)l * DM * NIN;
    const float* w_bra = a.in[15] + (size_t)l * 384 * DM;
    const float* w_brb = a.in[16] + (size_t)l * 512 * DM;
    const float* w_brc = a.in[17] + (size_t)l * 512 * DM;
    const float* w_o = a.in[18] + (size_t)l * DM * DM;
    const float* w_1 = a.in[20] + (size_t)l * DM * DFF;
    const float* w_2 = a.in[21] + (size_t)l * DFF * DM;
    constexpr int I_IN = (DM / 64) * (NIN / 32), I_A = (384 / 64) * (DM / 32), I_B = (512 / 64) * (DM / 32), I_O = (DM / 64) * (DM / 32), I_1 = (DM / 64) * (DFF / 32), I_2 = (DFF / 64) * (DM / 32);
    constexpr int NITEMS = I_IN + I_A + 2 * I_B + I_O + I_1 + I_2;
    for (int it = gw; it < NITEMS; it += NGW) {
        int r = it;
        if (r < I_IN) { transpose_item(w_in, DM, NIN, (bf16*)(ws + WS_WIN), scr, r, lane); continue; } r -= I_IN;
        if (r < I_A) { transpose_item(w_bra, 384, DM, (bf16*)(ws + WS_WBRA), scr, r, lane); continue; } r -= I_A;
        if (r < I_B) { transpose_item(w_brb, 512, DM, (bf16*)(ws + WS_WBRB), scr, r, lane); continue; } r -= I_B;
        if (r < I_B) { transpose_item(w_brc, 512, DM, (bf16*)(ws + WS_WBRC), scr, r, lane); continue; } r -= I_B;
        if (r < I_O) { transpose_item(w_o, DM, DM, (bf16*)(ws + WS_WO), scr, r, lane); continue; } r -= I_O;
        if (r < I_1) { transpose_item(w_1, DM, DFF, (bf16*)(ws + WS_W1), scr, r, lane); continue; } r -= I_1;
        transpose_item(w_2, DFF, DM, (bf16*)(ws + WS_W2), scr, r, lane);
    }
    { u32x4* z = (u32x4*)((bf16*)(ws + WS_WIN) + (size_t)NIN * DM); unsigned z0 = 0u; asm volatile("" : "+v"(z0)); const u32x4 zz = {z0, z0, z0, z0};
      for (int i = gw * 64 + lane; i < (NINP - NIN) * DM / 8; i += NGW * 64) z[i] = zz; }
    const float* g1 = a.in[1] + (size_t)l * DM;
    bf16* act = (bf16*)(ws + WS_ACT);
    rms_rows_to_bf16(xsrc, g1, act, gw, NGW, lane);
    if (l == 0) {
        float* rp = (float*)(ws + WS_ROPE);
        for (int e = gw * 64 + lane; e < SEQ * 40; e += NGW * 64) {
            const int s = e / 40, i = e % 40;
            float inv; if (i < 8) inv = 1.0f / exp2f((float)(2 * i) * (1.0f / 16.0f) * 18.931568569324174f);
            else inv = 1.0f / exp2f((float)(2 * (i - 8)) * (1.0f / 64.0f) * 13.287712379549449f);
            const float ang = (float)s * inv;
            const double rev = (double)ang * 0.15915494309189535; const float fr = (float)(rev - floor(rev));
            const float cs = __builtin_amdgcn_cosf(fr), sn = __builtin_amdgcn_sinf(fr);
            if (i < 8) { rp[s * 8 + i] = cs; rp[SEQ * 8 + s * 8 + i] = sn; }
            else { rp[SEQ * 16 + s * 32 + (i - 8)] = cs; rp[SEQ * 16 + SEQ * 32 + s * 32 + (i - 8)] = sn; }
        }
    }
}

__device__ __forceinline__ void pp_decode(const Args& a, int l, int hv, int& col, const float*& g, int& full, float& sc) {
    const float qs = 0.125f * LOG2E;
    g = a.in[3]; full = 0; sc = 1.f;
    if (hv < 6) { col = C_AQ + 64 * hv; g = a.in[3] + l * 64; sc = qs; }
    else if (hv < 12) { col = C_AK + 64 * (hv - 6); g = a.in[4] + l * 64; }
    else if (hv < 20) { col = C_BQ + 64 * (hv - 12); g = a.in[5] + l * 64; sc = qs; }
    else if (hv < 28) { col = C_BK + 64 * (hv - 20); g = a.in[6] + l * 64; }
    else if (hv < 32) { col = C_CQ + 64 * (hv - 28); full = 1; }
    else { col = C_CK + 64 * (hv - 32); full = 1; sc = 0.125f; }
}
__device__ __forceinline__ void pp_compute(const u32x4 w0, const u32x4 w1, u32x4& o0, u32x4& o1, const float* g, int full, float sc, int s, int q4, int lane,
                                           const float* cosP, const float* sinP, const float* cosR, const float* sinR) {
    float v[16] = {bflo(w0.x), bfhi(w0.x), bflo(w0.y), bfhi(w0.y), bflo(w0.z), bfhi(w0.z), bflo(w0.w), bfhi(w0.w),
                   bflo(w1.x), bfhi(w1.x), bflo(w1.y), bfhi(w1.y), bflo(w1.z), bfhi(w1.z), bflo(w1.w), bfhi(w1.w)};
    if (!full) {
        float ss = 0.f;
#pragma unroll
        for (int i = 0; i < 16; ++i) ss += v[i] * v[i];
        ss += shx(ss, 1, lane); ss += shx(ss, 2, lane);
        const float r = 1.0f / sqrtf(ss * (1.f / 64.f) + NORM_EPS);
        const f32x4* gp = (const f32x4*)(g + q4 * 16);
#pragma unroll
        for (int c = 0; c < 4; ++c) { const f32x4 gg = gp[c]; v[4 * c] *= r * gg[0]; v[4 * c + 1] *= r * gg[1]; v[4 * c + 2] *= r * gg[2]; v[4 * c + 3] *= r * gg[3]; }
        if (q4 == 0) {
            const f32x4 c0 = *(const f32x4*)(cosP + s * 8), c1 = *(const f32x4*)(cosP + s * 8 + 4), s0 = *(const f32x4*)(sinP + s * 8), s1 = *(const f32x4*)(sinP + s * 8 + 4);
#pragma unroll
            for (int i = 0; i < 8; ++i) { const float c = i < 4 ? c0[i & 3] : c1[i & 3], sn = i < 4 ? s0[i & 3] : s1[i & 3], t1 = v[i], t2 = v[8 + i]; v[i] = t1 * c - t2 * sn; v[8 + i] = t2 * c + t1 * sn; }
        }
    } else {
        const int ib = (q4 & 1) * 16;
        const float sg = (q4 < 2) ? -1.0f : 1.0f;
#pragma unroll
        for (int c = 0; c < 4; ++c) { const f32x4 cc = *(const f32x4*)(cosR + s * 32 + ib + 4 * c), sn = *(const f32x4*)(sinR + s * 32 + ib + 4 * c);
#pragma unroll
            for (int j = 0; j < 4; ++j) { const float pv = shx(v[4 * c + j], 2, lane); v[4 * c + j] = v[4 * c + j] * cc[j] + sg * pv * sn[j]; } }
    }
    o0.x = pk2(v[0] * sc, v[1] * sc); o0.y = pk2(v[2] * sc, v[3] * sc); o0.z = pk2(v[4] * sc, v[5] * sc); o0.w = pk2(v[6] * sc, v[7] * sc);
    o1.x = pk2(v[8] * sc, v[9] * sc); o1.y = pk2(v[10] * sc, v[11] * sc); o1.z = pk2(v[12] * sc, v[13] * sc); o1.w = pk2(v[14] * sc, v[15] * sc);
}
__device__ __forceinline__ void phase_postproj(const Args& a, int l, int gtid, int NT, int lane) {
    bf16* proj = (bf16*)(a.ws + WS_PROJ);
    const float* rp = (const float*)(a.ws + WS_ROPE);
    const float* cosP = rp; const float* sinP = rp + SEQ * 8; const float* cosR = rp + SEQ * 16; const float* sinR = rp + SEQ * 16 + SEQ * 32;
    const int q4 = lane & 3, NQ = NT >> 2;
    for (int e0 = gtid >> 2; e0 < M * 36; e0 += 2 * NQ) {
        const int e1 = e0 + NQ; const bool has1 = e1 < M * 36;
        const int t0 = e0 / 36, hv0 = e0 % 36, t1 = has1 ? e1 / 36 : t0, hv1 = has1 ? e1 % 36 : hv0;
        int col0, full0, col1, full1; const float *g0, *g1; float sc0, sc1;
        pp_decode(a, l, hv0, col0, g0, full0, sc0); pp_decode(a, l, hv1, col1, g1, full1, sc1);
        u32x4* p0 = (u32x4*)(proj + (size_t)t0 * NINP + col0 + q4 * 16); u32x4* p1 = (u32x4*)(proj + (size_t)t1 * NINP + col1 + q4 * 16);
        const u32x4 a0 = p0[0], a1 = p0[1], b0 = p1[0], b1 = p1[1];
        u32x4 o0, o1;
        pp_compute(a0, a1, o0, o1, g0, full0, sc0, t0 & (SEQ - 1), q4, lane, cosP, sinP, cosR, sinR);
        p0[0] = o0; p0[1] = o1;
        if (has1) { pp_compute(b0, b1, o0, o1, g1, full1, sc1, t1 & (SEQ - 1), q4, lane, cosP, sinP, cosR, sinR); p1[0] = o0; p1[1] = o1; }
    }
}

__device__ __forceinline__ void vt_item(const bf16* proj, bf16* vt, int vcol0, int item, LAS unsigned char* scr, int lane) {
    const int kt = item & 31, h = (item >> 5) & 3, b = item >> 7;
    const bf16* src = proj + ((size_t)b * SEQ + kt * 64) * NINP + vcol0 + h * 128;
#pragma unroll 4
    for (int i = 0; i < 16; ++i) { const int row = 4 * i + (lane >> 4), ch = lane & 15;
        const u32x4 w = *(const u32x4*)(src + (size_t)row * NINP + ch * 8);
        *(LAS u32x4*)(scr + row * 272 + ch * 16) = w; }
    asm volatile("s_waitcnt lgkmcnt(0)" ::: "memory");
    const int c = lane & 7;
    bf16* dst = vt + ((size_t)(b * 4 + h) * 128) * SEQ + kt * 64 + c * 8;
#pragma unroll 4
    for (int i = 0; i < 16; ++i) { const int dv = 8 * i + (lane >> 3);
        unsigned short e[8];
#pragma unroll
        for (int j = 0; j < 8; ++j) e[j] = *(const LAS unsigned short*)(scr + kpos(8 * c + j) * 272 + dv * 2);
        u32x4 o; o.x = e[0] | ((unsigned)e[1] << 16); o.y = e[2] | ((unsigned)e[3] << 16); o.z = e[4] | ((unsigned)e[5] << 16); o.w = e[6] | ((unsigned)e[7] << 16);
        *(u32x4*)(dst + (size_t)dv * SEQ) = o; }
    asm volatile("s_waitcnt lgkmcnt(0)" ::: "memory");
}

__device__ __forceinline__ void attn_a_item(const Args& a, int item, LAS unsigned char* wlds, int lane, float M2) {
    const bf16* proj = (const bf16*)(a.ws + WS_PROJ);
    bf16* ya = (bf16*)(a.ws + WS_YA); float* lA = (float*)(a.ws + WS_LA);
    const int r = lane & 31, hh = lane >> 5;
    const int g = item >> 10; int rem = item & 1023;
    const int qhalf = rem & 1; rem >>= 1;
    const int dsh = 2 * g, dil = 1 << dsh, nbs = 5 - dsh, L = SEQ >> dsh;
    const int n = rem & ((1 << nbs) - 1); rem >>= nbs;
    const int rsd = rem & (dil - 1); rem >>= dsh;
    const int hg = rem & 1; const int b = rem >> 1;
    const int head = 2 * g + hg;
    const int iq = 64 * n + 32 * qhalf + r;
    const size_t tq = (size_t)b * SEQ + (size_t)dil * iq + rsd;
    bf16x8 qf[4];
#pragma unroll
    for (int kk = 0; kk < 4; ++kk) qf[kk] = *(const bf16x8*)(proj + tq * NINP + C_AQ + head * 64 + 16 * kk + 8 * hh);
    f32x16 O0, O1;
#pragma unroll
    for (int i = 0; i < 16; ++i) { O0[i] = 0.f; O1[i] = 0.f; }
    float lsum = 0.f;
    const int j0 = 64 * n + 32 * qhalf - 64;
    const int lkey = lane >> 3, lch = lane & 7;
    u32x4 kb_[2][4], vb_[2][4];
    {
#pragma unroll
      for (int i = 0; i < 4; ++i) { int jr = j0 + lkey + 8 * i; jr = jr < 0 ? 0 : (jr >= L ? L - 1 : jr); const size_t tk = (size_t)b * SEQ + (size_t)dil * jr + rsd;
        kb_[0][i] = *(const u32x4*)(proj + tk * NINP + C_AK + head * 64 + lch * 8); vb_[0][i] = *(const u32x4*)(proj + tk * NINP + C_AV + head * 64 + lch * 8); } }
    LAS unsigned char* kl = wlds + 5120;
#pragma unroll
    for (int sb = 0; sb < 5; ++sb) {
        const int jb = j0 + 32 * sb;
        if (sb + 1 < 5) {
#pragma unroll
            for (int i = 0; i < 4; ++i) { int jr = jb + 32 + lkey + 8 * i; jr = jr < 0 ? 0 : (jr >= L ? L - 1 : jr); const size_t tk = (size_t)b * SEQ + (size_t)dil * jr + rsd;
                kb_[(sb + 1) & 1][i] = *(const u32x4*)(proj + tk * NINP + C_AK + head * 64 + lch * 8); vb_[(sb + 1) & 1][i] = *(const u32x4*)(proj + tk * NINP + C_AV + head * 64 + lch * 8); } }
        if (jb < 0 || jb >= L) continue;
#pragma unroll
        for (int i = 0; i < 4; ++i) { const int key = lkey + 8 * i;
            *(LAS u32x4*)(kl + key * 144 + lch * 16) = kb_[sb & 1][i];
            const u32x4 vv = vb_[sb & 1][i]; const unsigned ww[4] = {vv.x, vv.y, vv.z, vv.w};
            LAS bf16* w = (LAS bf16*)(wlds + (lch * 8) * 80 + kpos(key) * 2);
#pragma unroll
            for (int j = 0; j < 4; ++j) { w[(2 * j) * 40] = (bf16)(ww[j] & 0xffffu); w[(2 * j + 1) * 40] = (bf16)(ww[j] >> 16); } }
        asm volatile("s_waitcnt lgkmcnt(0)" ::: "memory");
        f32x16 acc;
#pragma unroll
        for (int i = 0; i < 16; ++i) acc[i] = -M2;
#pragma unroll
        for (int kk = 0; kk < 4; ++kk) { const bf16x8 kf = *(const LAS bf16x8*)(kl + r * 144 + (16 * kk + 8 * hh) * 2); acc = MFMA32(kf, qf[kk], acc); }
        float p[16];
#pragma unroll
        for (int i = 0; i < 16; ++i) { const int j = jb + (i & 3) + 8 * (i >> 2) + 4 * hh; const int d = iq - j;
            const float e = __builtin_amdgcn_exp2f(acc[i]); p[i] = (d <= 64 && d >= -64) ? e : 0.f; lsum += p[i]; }
        const bf16x8 pf0 = pack8(p[0], p[1], p[2], p[3], p[4], p[5], p[6], p[7]);
        const bf16x8 pf1 = pack8(p[8], p[9], p[10], p[11], p[12], p[13], p[14], p[15]);
        const bf16x8 v00 = *(const LAS bf16x8*)(wlds + r * 80 + (8 * hh) * 2);
        const bf16x8 v01 = *(const LAS bf16x8*)(wlds + r * 80 + (16 + 8 * hh) * 2);
        const bf16x8 v10 = *(const LAS bf16x8*)(wlds + (32 + r) * 80 + (8 * hh) * 2);
        const bf16x8 v11 = *(const LAS bf16x8*)(wlds + (32 + r) * 80 + (16 + 8 * hh) * 2);
        O0 = MFMA32(v00, pf0, O0); O0 = MFMA32(v01, pf1, O0);
        O1 = MFMA32(v10, pf0, O1); O1 = MFMA32(v11, pf1, O1);
        asm volatile("s_waitcnt lgkmcnt(0)" ::: "memory");
    }
    const float l = lsum + shx(lsum, 32, lane);
    bf16* op = ya + tq * 384 + head * 64 + 4 * hh;
#pragma unroll
    for (int q = 0; q < 4; ++q) {
        u32x2 w0; w0.x = pk2(O0[4 * q], O0[4 * q + 1]); w0.y = pk2(O0[4 * q + 2], O0[4 * q + 3]); *(u32x2*)(op + 8 * q) = w0;
        u32x2 w1; w1.x = pk2(O1[4 * q], O1[4 * q + 1]); w1.y = pk2(O1[4 * q + 2], O1[4 * q + 3]); *(u32x2*)(op + 32 + 8 * q) = w1;
    }
    if (hh == 0) lA[tq * 6 + head] = l;
}

constexpr int AT_KOFF = 9216, AT_VT = 18432, AT_STAGE = 36864;
constexpr size_t WS_RST = 380 * MiB;
__device__ __forceinline__ void ret_state_item(const Args& a, int l, int item, LAS unsigned char* lds) {
    const bf16* proj = (const bf16*)(a.ws + WS_PROJ);
    const int tid = otid(), wid = __builtin_amdgcn_readfirstlane(tid >> 6), lane = tid & 63, r = lane & 31, hh = lane >> 5;
    const int j = item & 7, h = (item >> 3) & 3, b = item >> 5;
    const float lgf2 = -__expf(a.in[12][l * 4 + h]) * LOG2E, lgb2 = -__expf(a.in[13][l * 4 + h]) * LOG2E;
    const int dir = wid >> 2, db = (wid >> 1) & 1, dvp = wid & 1;
    const bf16* kg = proj + ((size_t)b * SEQ + j * 256 + (tid >> 3)) * NINP + C_CK + h * 64 + (tid & 7) * 8;
    const bf16* vg = (const bf16*)(a.ws + WS_VTC) + ((size_t)(b * 4 + h) * 128 + (tid >> 3)) * SEQ + j * 256 + (tid & 7) * 8;
    f32x16 acc0, acc1;
#pragma unroll
    for (int i = 0; i < 16; ++i) { acc0[i] = 0.f; acc1[i] = 0.f; }
    for (int t = 0; t < 4; ++t) {
        const u32x4 kw = *(const u32x4*)(kg + (size_t)t * 64 * NINP);
        const u32x4 v0 = *(const u32x4*)(vg + t * 64), v1 = *(const u32x4*)(vg + t * 64 + 64 * SEQ);
        const int key = tid >> 3, ch = tid & 7, pos = t * 64 + key;
        const float wf = __builtin_amdgcn_exp2f(lgf2 * (float)(256 - pos)), wb = __builtin_amdgcn_exp2f(lgb2 * (float)pos);
        const float kv[8] = {bflo(kw.x), bfhi(kw.x), bflo(kw.y), bfhi(kw.y), bflo(kw.z), bfhi(kw.z), bflo(kw.w), bfhi(kw.w)};
        LAS bf16* ktf = (LAS bf16*)(lds + (ch * 8) * 144 + kpos(key) * 2);
        LAS bf16* ktb = (LAS bf16*)(lds + 9216 + (ch * 8) * 144 + kpos(key) * 2);
#pragma unroll
        for (int e = 0; e < 8; e += 2) { const unsigned pf = pk2(kv[e] * wf, kv[e + 1] * wf), pb = pk2(kv[e] * wb, kv[e + 1] * wb);
            ktf[e * 72] = (bf16)(pf & 0xffffu); ktf[(e + 1) * 72] = (bf16)(pf >> 16); ktb[e * 72] = (bf16)(pb & 0xffffu); ktb[(e + 1) * 72] = (bf16)(pb >> 16); }
        *(LAS u32x4*)(lds + AT_VT + (tid >> 3) * 144 + (tid & 7) * 16) = v0;
        *(LAS u32x4*)(lds + AT_VT + ((tid >> 3) + 64) * 144 + (tid & 7) * 16) = v1;
        __syncthreads();
        LAS unsigned char* abase = lds + dir * 9216 + (32 * db + r) * 144 + (8 * hh) * 2;
        LAS unsigned char* bbase = lds + AT_VT + (64 * dvp + r) * 144 + (8 * hh) * 2;
#pragma unroll
        for (int ks = 0; ks < 4; ++ks) { const bf16x8 af = *(const LAS bf16x8*)(abase + 32 * ks);
            const bf16x8 b0 = *(const LAS bf16x8*)(bbase + 32 * ks), b1 = *(const LAS bf16x8*)(bbase + 32 * 144 + 32 * ks);
            acc0 = MFMA32(af, b0, acc0); acc1 = MFMA32(af, b1, acc1); }
        __syncthreads();
    }
    float* F = (float*)(a.ws + WS_RST) + ((size_t)(dir * 256 + item) * 64 + 32 * db + 4 * hh) * 128 + 64 * dvp + r;
#pragma unroll
    for (int i = 0; i < 16; ++i) { const int drow = (i & 3) + 8 * (i >> 2); F[drow * 128] = acc0[i]; F[drow * 128 + 32] = acc1[i]; }
}

template <int MODE>
__device__ __forceinline__ void attn_dense_unit(const Args& a, int l, int unit, LAS unsigned char* lds, float M2, float lam, float oscale) {
    const bf16* proj = (const bf16*)(a.ws + WS_PROJ);
    const int tid = otid(), wid = __builtin_amdgcn_readfirstlane(tid >> 6), lane = tid & 63, r = lane & 31, hh = lane >> 5;
    constexpr int QROWS = MODE == 0 ? 128 : 256;
    const int g = MODE == 0 ? (wid >> 1) : wid, m = MODE == 0 ? (wid & 1) : 0;
    const int qb = MODE == 0 ? (unit & 15) : (unit & 7), h = MODE == 0 ? ((unit >> 4) & 3) : ((unit >> 3) & 3), b = MODE == 0 ? (unit >> 6) : (unit >> 5);
    const int qcol = MODE == 0 ? C_BQ + (h * 2 + m) * 64 : C_CQ + h * 64;
    const int kcol = MODE == 0 ? C_BK + h * 128 : C_CK + h * 64;
    const size_t rowbase = (size_t)b * SEQ;
    const int nq = qb * QROWS + g * 32 + r;
    bf16x8 qf[4];
#pragma unroll
    for (int kk = 0; kk < 4; ++kk) qf[kk] = *(const bf16x8*)(proj + (rowbase + nq) * NINP + qcol + 16 * kk + 8 * hh);
    float lgf2 = 0.f, lgb2n = 0.f;
    float c1f[4] = {0.f, 0.f, 0.f, 0.f}, c2f[4] = {0.f, 0.f, 0.f, 0.f}, c1b[4] = {0.f, 0.f, 0.f, 0.f}, c2b[4] = {0.f, 0.f, 0.f, 0.f};
    if (MODE == 1) { lgf2 = -__expf(a.in[12][l * 4 + h]) * LOG2E; lgb2n = __expf(a.in[13][l * 4 + h]) * LOG2E;
#pragma unroll
        for (int q = 0; q < 4; ++q) { c1f[q] = __builtin_amdgcn_exp2f(lgf2 * (float)(3 - q)); c2f[q] = __builtin_amdgcn_exp2f(lgf2 * (float)(28 - 4 * hh - 8 * q));
                                      c1b[q] = __builtin_amdgcn_exp2f(-lgb2n * (float)q); c2b[q] = __builtin_amdgcn_exp2f(-lgb2n * (float)(4 * hh + 8 * q)); } }
    f32x16 O[4];
#pragma unroll
    for (int d = 0; d < 4; ++d)
#pragma unroll
        for (int i = 0; i < 16; ++i) O[d][i] = 0.f;
    float lsum = 0.f;
    if constexpr (MODE == 1) {
        const float* Fb_ = (const float*)(a.ws + WS_RST) + (size_t)((b * 4 + h) * 8) * 8192;
        const float cf = __builtin_amdgcn_exp2f(lgf2 * 256.0f), cb = __builtin_amdgcn_exp2f(-lgb2n * 256.0f);
#pragma unroll
        for (int e = 0; e < 4; ++e) { const int idx = tid + 512 * e, d = idx >> 5, dv4 = (idx & 31) * 4;
            f32x4 sf = {0.f, 0.f, 0.f, 0.f}, sb = {0.f, 0.f, 0.f, 0.f}; float w = 1.0f;
            for (int j = qb - 1; j >= 0; --j) { const f32x4 v = *(const f32x4*)(Fb_ + (size_t)j * 8192 + d * 128 + dv4); sf += v * w; w *= cf; }
            w = 1.0f;
            for (int j = qb + 1; j < 8; ++j) { const f32x4 v = *(const f32x4*)(Fb_ + (size_t)(256 + j) * 8192 + d * 128 + dv4); sb += v * w; w *= cb; }
#pragma unroll
            for (int q = 0; q < 4; ++q) { *(LAS bf16*)(lds + 73728 + (dv4 + q) * 144 + d * 2) = (bf16)(pk2(sf[q], 0.f) & 0xffffu); *(LAS bf16*)(lds + 92160 + (dv4 + q) * 144 + d * 2) = (bf16)(pk2(sb[q], 0.f) & 0xffffu); } }
        __syncthreads();
        const float wqf = __builtin_amdgcn_exp2f(lgf2 * (float)(g * 32 + r)), wqb = __builtin_amdgcn_exp2f(-lgb2n * (float)(256 - (g * 32 + r)));
#pragma unroll
        for (int d = 0; d < 4; ++d) { f32x16 of = O[d], ob = O[d];
#pragma unroll
            for (int kk = 0; kk < 4; ++kk) { const bf16x8 af = *(const LAS bf16x8*)(lds + 73728 + (32 * d + r) * 144 + (16 * kk + 8 * hh) * 2);
                const bf16x8 ab = *(const LAS bf16x8*)(lds + 92160 + (32 * d + r) * 144 + (16 * kk + 8 * hh) * 2);
                of = MFMA32(af, qf[kk], of); ob = MFMA32(ab, qf[kk], ob); }
#pragma unroll
            for (int i = 0; i < 16; ++i) O[d][i] = of[i] * wqf + ob[i] * wqb; }
    }
    const int lk_key = tid >> 3, lk_ch = tid & 7;
    const bf16* kg = proj + (rowbase + lk_key) * NINP + kcol + lk_ch * 8;
    const bf16* vg = (const bf16*)(a.ws + (MODE == 0 ? WS_VTB : WS_VTC)) + ((size_t)(b * 4 + h) * 128 + (tid >> 3)) * SEQ + (tid & 7) * 8;
    u32x4 kr0, kr1, vr0, vr1;
    constexpr int NTALL = SEQ / 64, NT = MODE == 0 ? NTALL : 4;
    const int kt0 = ((QROWS / 64) * qb) & (NTALL - 1);
    { const size_t o = (size_t)kt0 * 64 * NINP;
      kr0 = *(const u32x4*)(kg + o); if (MODE == 0) kr1 = *(const u32x4*)(kg + o + 64);
      vr0 = *(const u32x4*)(vg + kt0 * 64); vr1 = *(const u32x4*)(vg + kt0 * 64 + 64 * SEQ); }
    for (int it = 0; it < NT; ++it) {
        const int kt = (it + kt0) & (NTALL - 1);
        LAS unsigned char* st = lds + (it & 1) * AT_STAGE;
        *(LAS u32x4*)(st + lk_key * 144 + lk_ch * 16) = kr0;
        if (MODE == 0) *(LAS u32x4*)(st + AT_KOFF + lk_key * 144 + lk_ch * 16) = kr1;
        *(LAS u32x4*)(st + AT_VT + lk_key * 144 + lk_ch * 16) = vr0;
        *(LAS u32x4*)(st + AT_VT + (lk_key + 64) * 144 + lk_ch * 16) = vr1;
        __syncthreads();
        if (it + 1 < NT) {
            const int kn = (kt + 1) & (NTALL - 1);
            const size_t o = (size_t)kn * 64 * NINP;
            kr0 = *(const u32x4*)(kg + o); if (MODE == 0) kr1 = *(const u32x4*)(kg + o + 64);
            vr0 = *(const u32x4*)(vg + kn * 64); vr1 = *(const u32x4*)(vg + kn * 64 + 64 * SEQ);
        }
#define SCORE_TO_P(acc, kb, p) do { \
            if (MODE == 0) { _Pragma("unroll") for (int i = 0; i < 16; ++i) { p[i] = __builtin_amdgcn_exp2f(acc[i]); lsum += p[i]; } } \
            else { const int mk0 = kt * 64 + 32 * (kb), q0w = qb * QROWS + g * 32; \
                if (mk0 + 31 < q0w) { const float A_ = __builtin_amdgcn_exp2f(lgf2 * (float)(nq - mk0 - 31)); float c2_[4]; \
                    _Pragma("unroll") for (int bq = 0; bq < 4; ++bq) c2_[bq] = A_ * c2f[bq]; \
                    _Pragma("unroll") for (int i = 0; i < 16; ++i) p[i] = acc[i] * (c2_[i >> 2] * c1f[i & 3]); } \
                else if (mk0 > q0w + 31) { const float A_ = __builtin_amdgcn_exp2f(-lgb2n * (float)(mk0 - nq)); float c2_[4]; \
                    _Pragma("unroll") for (int bq = 0; bq < 4; ++bq) c2_[bq] = A_ * c2b[bq]; \
                    _Pragma("unroll") for (int i = 0; i < 16; ++i) p[i] = acc[i] * (c2_[i >> 2] * c1b[i & 3]); } \
                else { const int dbase_ = nq - (mk0 + 4 * hh); \
                    _Pragma("unroll") for (int i = 0; i < 16; ++i) { const int d_ = dbase_ - ((i & 3) + 8 * (i >> 2)); const float df_ = (float)d_; \
                        const float e_ = df_ * (d_ > 0 ? lgf2 : lgb2n); float D_ = __builtin_amdgcn_exp2f(e_); D_ = (d_ == 0) ? 2.0f : D_; p[i] = acc[i] * D_; } } } } while (0)
        {
            LAS unsigned char* kbase = st + (MODE == 0 ? m * AT_KOFF : 0) + r * 144 + (8 * hh) * 2;
            LAS unsigned char* vbase = st + AT_VT + r * 144 + (8 * hh) * 2;
            bf16x8 kf0[4], kf1[4], vf[8];
#pragma unroll
            for (int kk = 0; kk < 4; ++kk) kf0[kk] = *(const LAS bf16x8*)(kbase + 32 * kk);
#pragma unroll
            for (int kk = 0; kk < 4; ++kk) kf1[kk] = *(const LAS bf16x8*)(kbase + 32 * 144 + 32 * kk);
#pragma unroll
            for (int dvb = 0; dvb < 4; ++dvb) { vf[2 * dvb] = *(const LAS bf16x8*)(vbase + dvb * 32 * 144); vf[2 * dvb + 1] = *(const LAS bf16x8*)(vbase + dvb * 32 * 144 + 32); }
            __builtin_amdgcn_sched_barrier(0);
            f32x16 acc0, acc1;
#pragma unroll
            for (int i = 0; i < 16; ++i) { acc0[i] = MODE == 0 ? -M2 : 0.f; acc1[i] = MODE == 0 ? -M2 : 0.f; }
#pragma unroll
            for (int kk = 0; kk < 4; ++kk) acc0 = MFMA32(kf0[kk], qf[kk], acc0);
#pragma unroll
            for (int kk = 0; kk < 4; ++kk) acc1 = MFMA32(kf1[kk], qf[kk], acc1);
            __builtin_amdgcn_sched_barrier(0);
            float p[16];
            SCORE_TO_P(acc0, 0, p);
            const bf16x8 pf00 = pack8(p[0], p[1], p[2], p[3], p[4], p[5], p[6], p[7]);
            const bf16x8 pf01 = pack8(p[8], p[9], p[10], p[11], p[12], p[13], p[14], p[15]);
            __builtin_amdgcn_sched_barrier(0);
#pragma unroll
            for (int dvb = 0; dvb < 4; ++dvb) O[dvb] = MFMA32(vf[2 * dvb], pf00, O[dvb]);
#pragma unroll
            for (int dvb = 0; dvb < 4; ++dvb) O[dvb] = MFMA32(vf[2 * dvb + 1], pf01, O[dvb]);
#pragma unroll
            for (int dvb = 0; dvb < 4; ++dvb) { vf[2 * dvb] = *(const LAS bf16x8*)(vbase + 64 + dvb * 32 * 144); vf[2 * dvb + 1] = *(const LAS bf16x8*)(vbase + 64 + dvb * 32 * 144 + 32); }
            SCORE_TO_P(acc1, 1, p);
            const bf16x8 pf10 = pack8(p[0], p[1], p[2], p[3], p[4], p[5], p[6], p[7]);
            const bf16x8 pf11 = pack8(p[8], p[9], p[10], p[11], p[12], p[13], p[14], p[15]);
            __builtin_amdgcn_sched_barrier(0);
#pragma unroll
            for (int dvb = 0; dvb < 4; ++dvb) O[dvb] = MFMA32(vf[2 * dvb], pf10, O[dvb]);
#pragma unroll
            for (int dvb = 0; dvb < 4; ++dvb) O[dvb] = MFMA32(vf[2 * dvb + 1], pf11, O[dvb]);
        }
#undef SCORE_TO_P
    }
    __syncthreads();
    if (MODE == 0) { const float linv = 1.0f / (lsum + shx(lsum, 32, lane));
#pragma unroll
        for (int d = 0; d < 4; ++d)
#pragma unroll
            for (int i = 0; i < 16; ++i) O[d][i] *= linv; }
    LAS float* ex = (LAS float*)(lds + g * 16384) + lane;
    if (MODE == 0 && m == 1) {
#pragma unroll
        for (int d = 0; d < 4; ++d)
#pragma unroll
            for (int i = 0; i < 16; ++i) ex[(d * 16 + i) * 64] = O[d][i];
    }
    __syncthreads();
    if (m == 0) {
        float ss = 0.f;
#pragma unroll
        for (int d = 0; d < 4; ++d)
#pragma unroll
            for (int i = 0; i < 16; ++i) { float o = O[d][i]; if (MODE == 0) { o -= lam * ex[(d * 16 + i) * 64]; O[d][i] = o; } ss += o * o; }
        ss += shx(ss, 32, lane);
        const float rr = (1.0f / sqrtf(ss * (1.f / 128.f) + NORM_EPS)) * oscale;
        const float* gout = MODE == 0 ? a.in[11] + l * 128 : a.in[14] + l * 128;
        const size_t trow = rowbase + nq;
        bf16* yo = (bf16*)(a.ws + (MODE == 0 ? WS_YB : WS_YC)) + trow * 512 + h * 128 + 4 * hh;
        const bf16* cg = proj + trow * NINP + C_CG + h * 128 + 4 * hh;
#pragma unroll
        for (int d = 0; d < 4; ++d)
#pragma unroll
            for (int q = 0; q < 4; ++q) {
                const int dv = 32 * d + 8 * q;
                const f32x4 gg = *(const f32x4*)(gout + dv + 4 * hh);
                float y0 = O[d][4 * q] * rr * gg.x, y1 = O[d][4 * q + 1] * rr * gg.y, y2 = O[d][4 * q + 2] * rr * gg.z, y3 = O[d][4 * q + 3] * rr * gg.w;
                if (MODE == 1) { const u32x2 cw = *(const u32x2*)(cg + dv);
                    const float c0 = bflo(cw.x), c1 = bfhi(cw.x), c2 = bflo(cw.y), c3 = bfhi(cw.y);
                    y0 *= c0 / (1.0f + __expf(-c0)); y1 *= c1 / (1.0f + __expf(-c1)); y2 *= c2 / (1.0f + __expf(-c2)); y3 *= c3 / (1.0f + __expf(-c3)); }
                u32x2 w; w.x = pk2(y0, y1); w.y = pk2(y2, y3); *(u32x2*)(yo + dv) = w;
            }
    }
    __syncthreads();
}

#ifndef PHM
#define PHM 0xFFFF
#endif
#ifndef DBL
#define DBL 0
#endif
#define REP(k) for (int rep_ = 0; rep_ < (((DBL >> (k)) & 1) ? 2 : 1); ++rep_)
#define PH(k) if constexpr ((PHM >> (k)) & 1)
#define XB_TMO      128
#define XB_XCNT(j)  (256  + 64 * (j))
#define XB_XSUB(j)  (1280 + 64 * (j))
#define XB_XGEN(j)  (2304 + 64 * (j))
#define XB_TOP      3328
#define XB_TOPGEN   3392
#define XCD_BAR_WORDS 3456
#define XB_SPIN_CAP (1u << 18)

__device__ __forceinline__ unsigned xb_ld(unsigned* p)              { return __hip_atomic_load(p, __ATOMIC_RELAXED, __HIP_MEMORY_SCOPE_AGENT); }
__device__ __forceinline__ unsigned xb_add(unsigned* p, unsigned v) { return __hip_atomic_fetch_add(p, v, __ATOMIC_RELAXED, __HIP_MEMORY_SCOPE_AGENT); }
__device__ __forceinline__ unsigned xb_xcc_id() { return (unsigned)__builtin_amdgcn_s_getreg((3 << 11) | 20) & 0xFu; }
#define XB_SPIN(cond, bar) do { unsigned _sp = 0; while (cond) { __builtin_amdgcn_s_sleep(1); \
    if ((++_sp & 255u) == 0u) { if (xb_ld(&(bar)[XB_TMO])) break; if (_sp > XB_SPIN_CAP) { atomicAdd(&(bar)[XB_TMO], 1u); break; } } } } while (0)

struct XcdBarrier {
    unsigned* bar; unsigned x;
    volatile LAS unsigned* st;
};

__device__ __forceinline__ XcdBarrier xcd_barrier_post(unsigned* bar, volatile LAS unsigned* st) {
    XcdBarrier b; b.bar = bar; b.x = xb_xcc_id(); b.st = st;
    if (threadIdx.x == 0) (void)xb_add(&bar[XB_XCNT(b.x)], 1u);
    return b;
}
__device__ __forceinline__ void xcd_barrier_complete(unsigned* bar, unsigned x, unsigned& nloc, unsigned& nx) {
    const unsigned G = gridDim.x * gridDim.y * gridDim.z;
    unsigned sum, cnt, mine, sp = 0u;
    for (;;) {
        sum = 0u; cnt = 0u; mine = 0u;
#pragma unroll
        for (unsigned j = 0; j < 16; ++j) { const unsigned c = xb_ld(&bar[XB_XCNT(j)]); sum += c; cnt += (c > 0u) ? 1u : 0u; mine = (j == x) ? c : mine; }
        if (sum == G) break;
        __builtin_amdgcn_s_sleep(1);
        if ((++sp & 255u) == 0u) { if (xb_ld(&bar[XB_TMO])) break; if (sp > XB_SPIN_CAP) { atomicAdd(&bar[XB_TMO], 1u); break; } }
    }
    nloc = mine > 0u ? mine : 1u; nx = cnt > 0u ? cnt : 1u;
}

__device__ __forceinline__ void xcd_barrier(const XcdBarrier& b) {
    asm volatile("s_waitcnt vmcnt(0)" ::: "memory");
    __syncthreads();
    if (threadIdx.x == 0) {
        unsigned* bar = b.bar;
        __builtin_amdgcn_s_waitcnt(0);
        unsigned nloc = b.st[0], nx = b.st[1];
        if (nloc == 0u) { xcd_barrier_complete(bar, b.x, nloc, nx); b.st[0] = nloc; b.st[1] = nx; }
        const unsigned old = xb_add(&bar[XB_XSUB(b.x)], 1u);
        const unsigned gen = old / nloc;
        if (old + 1u == (gen + 1u) * nloc) {
            __builtin_amdgcn_fence(__ATOMIC_RELEASE, "agent");
            asm volatile("s_waitcnt vmcnt(0)" ::: "memory");
            const unsigned og = xb_add(&bar[XB_TOP], 1u);
            const unsigned tg = og / nx;
            if (og + 1u == (tg + 1u) * nx) xb_add(&bar[XB_TOPGEN], 1u);
            else XB_SPIN(xb_ld(&bar[XB_TOPGEN]) == tg, bar);
            __builtin_amdgcn_fence(__ATOMIC_ACQUIRE, "agent");
            xb_add(&bar[XB_XGEN(b.x)], 1u);
            asm volatile("s_waitcnt vmcnt(0)" ::: "memory");
        } else {
            XB_SPIN(xb_ld(&bar[XB_XGEN(b.x)]) == gen, bar);
            __builtin_amdgcn_fence(__ATOMIC_ACQUIRE, "agent");
            asm volatile("s_waitcnt vmcnt(0)" ::: "memory");
        }
    }
    __syncthreads();
}

typedef __attribute__((address_space(4))) const Args* CArgsP;
__device__ __forceinline__ Args load_args() {
    Args r{};
#if defined(__HIP_DEVICE_COMPILE__)
    CArgsP p = (CArgsP)__builtin_amdgcn_kernarg_segment_ptr(); asm volatile("" : "+s"(p));
#pragma unroll
    for (int i = 0; i < 22; ++i) r.in[i] = p->in[i];
    r.out = p->out; r.ws = p->ws;
#endif
    return r;
}
#define TIDS() const int tid = otid(), lane = tid & 63, wave = __builtin_amdgcn_readfirstlane(tid >> 6), gw = bx * NWAVES + wave, gtid = bx * NTHR + tid; (void)lane; (void)gw; (void)gtid
__global__ void __launch_bounds__(NTHR, 2) fwd_megakernel(Args a_unused) {
    extern __shared__ __attribute__((aligned(16))) unsigned char lds_raw[];
    LAS unsigned char* lds = (LAS unsigned char*)lds_raw;
    cg::grid_group grid = cg::this_grid();
    const int G = gridDim.x, bx = blockIdx.x;
    const int NGW = G * NWAVES, NT = G * NTHR;
    if (threadIdx.x < 2) ((volatile LAS unsigned*)(lds + MISC_OFF))[threadIdx.x] = 0u;
    __syncthreads();
    { const Args a = load_args(); (void)xcd_barrier_post((unsigned*)(a.ws + WS_CTL), (volatile LAS unsigned*)(lds + MISC_OFF)); }
#define GSYNC() do { const Args a_ = load_args(); XcdBarrier b_; b_.bar = (unsigned*)(a_.ws + WS_CTL); b_.x = xb_xcc_id(); b_.st = (volatile LAS unsigned*)(lds + MISC_OFF); xcd_barrier(b_); } while (0)

    for (int l = 0; l < DEPTH; ++l) {
        PH(0) REP(0) { const Args a = load_args(); TIDS(); phase_prep(a, l, lds, gw, NGW, wave, lane, (l == 0) ? a.in[0] : a.out); }
        { const Args a_ = load_args(); if (a_.ws == nullptr) grid.sync(); }
        GSYNC();
        if constexpr ((DBL >> 8) & 1) { for (int i_ = 0; i_ < 10; ++i_) GSYNC(); }
        PH(1) REP(1) { const Args a = load_args(); unsigned char* ws = a.ws;
          pg8::Gemm g{(const bf16*)(ws + WS_ACT), (const bf16*)(ws + WS_WIN), M, NINP, DM}; pg8::StaticOrder S; S.init(M, NINP, G, bx);
          pg8::EpiStore<0> E{(bf16*)(ws + WS_PROJ), NINP};
          pg8::gemm_phase<pg8::EpiStore<0>, pg8::StaticOrder, true, true>(lds, g, S, E); }
        GSYNC();
        PH(2) { const Args a = load_args(); TIDS(); phase_postproj(a, l, gtid, NT, lane);
                for (int it = gw; it < 2048; it += NGW) { const int c = it >> 10;
                    vt_item((const bf16*)(a.ws + WS_PROJ), (bf16*)(a.ws + (c ? WS_VTC : WS_VTB)), c ? C_CV : C_BV, it & 1023, lds + wave * 17408, lane); } }
        GSYNC();
        {
            const Args a = load_args(); TIDS();
            PH(5) { if (G == 256) { if (bx >= 128) for (int it = bx - 128; it < 256; it += 128) ret_state_item(a, l, it, lds); }
                    else for (int it = bx; it < 256; it += G) ret_state_item(a, l, it, lds); }
            PH(3) {
            const float gqa = wave_max(fabsf(a.in[3][l * 64 + lane]), lane), gka = wave_max(fabsf(a.in[4][l * 64 + lane]), lane);
            const float M2a = 8.0f * LOG2E * gqa * gka;
            REP(2) for (int it = gw; it < 3072; it += NGW) attn_a_item(a, it, lds + wave * 16384, lane, M2a);
            }
            __syncthreads();
            PH(4) {
            const float gqb = wave_max(fabsf(a.in[5][l * 64 + lane]), lane), gkb = wave_max(fabsf(a.in[6][l * 64 + lane]), lane);
            const float M2b = 8.0f * LOG2E * gqb * gkb;
            const float lam_init = 0.8f - 0.6f * expf(-0.3f * (float)l);
            const float s1 = wave_sum(a.in[7][l * 64 + lane] * a.in[8][l * 64 + lane], lane), s2 = wave_sum(a.in[9][l * 64 + lane] * a.in[10][l * 64 + lane], lane);
            const float lam = expf(s1) - expf(s2) + lam_init;
            REP(3) for (int u0 = bx; u0 < 512; u0 += G) { const int v = u0 & 255, u = (((v & 7) * 2 + (v >> 7)) + 16 * (u0 >> 8)) * 16 + ((v >> 3) & 15); attn_dense_unit<0>(a, l, u, lds, M2b, lam, 1.0f - lam_init); }
            }
        }
        GSYNC();
        {
            const Args a = load_args(); TIDS();
            PH(5) REP(4) for (int u0 = bx; u0 < 256; u0 += G) { const int u = ((u0 & 7) * 4 + (u0 >> 6)) * 8 + ((u0 >> 3) & 7); attn_dense_unit<1>(a, l, u, lds, 0.f, 0.f, 1.0f); }
            const float* lA = (const float*)(a.ws + WS_LA); bf16* ya = (bf16*)(a.ws + WS_YA);
            for (int e0 = gtid; e0 < M * 48; e0 += 3 * NT) {
                u32x4 w[3]; float lt[3]; u32x4* pp[3];
#pragma unroll
                for (int q = 0; q < 3; ++q) { int e = e0 + q * NT; e = e < M * 48 ? e : e0; const int t = e / 48, ch = e % 48, hg = (ch >> 3) & 1;
                    lt[q] = lA[t * 6 + hg] + lA[t * 6 + 2 + hg] + lA[t * 6 + 4 + hg]; pp[q] = (u32x4*)(ya + (size_t)t * 384 + ch * 8); w[q] = *pp[q]; }
#pragma unroll
                for (int q = 0; q < 3; ++q) { const float li = 1.0f / lt[q]; u32x4 v = w[q];
                    v.x = pk2(bflo(v.x) * li, bfhi(v.x) * li); v.y = pk2(bflo(v.y) * li, bfhi(v.y) * li);
                    v.z = pk2(bflo(v.z) * li, bfhi(v.z) * li); v.w = pk2(bflo(v.w) * li, bfhi(v.w) * li); *pp[q] = v; }
            }
        }
        GSYNC();
        PH(6) {
          { const Args a = load_args(); unsigned char* ws = a.ws; pg8::StaticOrder S; S.init(M, DM, G, bx);
            pg8::Gemm g{(const bf16*)(ws + WS_YA), (const bf16*)(ws + WS_WBRA), M, DM, 384}; pg8::EpiGate<0> E{(const bf16*)(ws + WS_PROJ) + C_GATE, NINP, nullptr, (bf16*)(ws + WS_T1)};
            pg8::gemm_phase<pg8::EpiGate<0>, pg8::StaticOrder, true, true>(lds, g, S, E); }
          { const Args a = load_args(); unsigned char* ws = a.ws; pg8::StaticOrder S; S.init(M, DM, G, bx);
            pg8::Gemm g{(const bf16*)(ws + WS_YB), (const bf16*)(ws + WS_WBRB), M, DM, 512}; pg8::EpiGate<1> E{(const bf16*)(ws + WS_PROJ) + C_GATE + 1024, NINP, (const bf16*)(ws + WS_T1), (bf16*)(ws + WS_T2)};
            pg8::gemm_phase<pg8::EpiGate<1>, pg8::StaticOrder, true, true>(lds, g, S, E); }
          { const Args a = load_args(); unsigned char* ws = a.ws; pg8::StaticOrder S; S.init(M, DM, G, bx);
            pg8::Gemm g{(const bf16*)(ws + WS_YC), (const bf16*)(ws + WS_WBRC), M, DM, 512}; pg8::EpiGate<1> E{(const bf16*)(ws + WS_PROJ) + C_GATE + 2048, NINP, (const bf16*)(ws + WS_T2), (bf16*)(ws + WS_ACT)};
            pg8::gemm_phase<pg8::EpiGate<1>, pg8::StaticOrder, true, true>(lds, g, S, E); } }
        GSYNC();
        PH(7) { const Args a = load_args(); unsigned char* ws = a.ws;
          pg8::Gemm g{(const bf16*)(ws + WS_ACT), (const bf16*)(ws + WS_WO), M, DM, DM}; pg8::StaticOrder S; S.init(M, DM, G, bx);
          pg8::EpiResid E{(l == 0) ? a.in[0] : a.out, a.out};
          pg8::gemm_phase<pg8::EpiResid, pg8::StaticOrder, true, true>(lds, g, S, E); }
        GSYNC();
        { const Args a = load_args(); TIDS(); const float* g2 = a.in[19] + (size_t)l * DM; bf16* act = (bf16*)(a.ws + WS_ACT);
          rms_rows_to_bf16(a.out, g2, act, gw, NGW, lane); }
        GSYNC();
        PH(8) { const Args a = load_args(); unsigned char* ws = a.ws;
          pg8::Gemm g{(const bf16*)(ws + WS_ACT), (const bf16*)(ws + WS_W1), M, DFF, DM}; pg8::StaticOrder S; S.init(M, DFF, G, bx);
          pg8::EpiStore<1> E{(bf16*)(ws + WS_H), DFF};
          pg8::gemm_phase<pg8::EpiStore<1>, pg8::StaticOrder, true, true>(lds, g, S, E); }
        GSYNC();
        PH(9) { const Args a = load_args(); unsigned char* ws = a.ws;
          pg8::Gemm g{(const bf16*)(ws + WS_H), (const bf16*)(ws + WS_W2), M, DM, DFF}; pg8::StaticOrder S; S.init(M, DM, G, bx);
          pg8::EpiResid E{a.out, a.out};
          pg8::gemm_phase<pg8::EpiResid, pg8::StaticOrder, true, true>(lds, g, S, E); }
        GSYNC();
    }
}

extern "C" void kernel_launch(void* const* d_in, const int* in_sizes, int n_in, void* d_out, int out_size, void* d_ws, size_t ws_size, hipStream_t stream) {
    static int grid = 0;
    if (grid == 0) {
        if (n_in != 22 || out_size != M * DM || ws_size < WS_CTL + CTL_BYTES) { fprintf(stderr, "kernel_launch: unexpected shapes (n_in %d out %d ws %zu)\n", n_in, out_size, ws_size); grid = -1; return; }
        int dev = 0, cus = 0, per_cu = 0;
        hipGetDevice(&dev); hipDeviceGetAttribute(&cus, hipDeviceAttributeMultiprocessorCount, dev);
        hipFuncSetAttribute((const void*)fwd_megakernel, hipFuncAttributeMaxDynamicSharedMemorySize, LDS_BYTES);
        hipOccupancyMaxActiveBlocksPerMultiprocessor(&per_cu, (const void*)fwd_megakernel, NTHR, LDS_BYTES);
        if (per_cu < 1) { fprintf(stderr, "kernel_launch: occupancy query says %d blocks/CU\n", per_cu); per_cu = 1; }
        (void)hipGetLastError();
        grid = cus;
    }
    if (grid < 0) return;
    if (hipMemsetAsync((char*)d_ws + WS_CTL, 0, CTL_BYTES, stream) != hipSuccess) { fprintf(stderr, "kernel_launch: memset failed\n"); return; }
    Args a{};
    for (int i = 0; i < 22; ++i) a.in[i] = (const float*)d_in[i];
    a.out = (float*)d_out; a.ws = (unsigned char*)d_ws;
    void* args[] = {&a};
    hipError_t e = hipLaunchCooperativeKernel((const void*)fwd_megakernel, dim3(grid), dim3(NTHR), args, LDS_BYTES, stream);
    if (e != hipSuccess) fprintf(stderr, "cooperative launch failed: %s (grid %d)\n", hipGetErrorString(e), grid);
}
```

```cpp
#include <hip/hip_runtime.h>
#include <hip/hip_cooperative_groups.h>
#include <cstdio>
#include <cstdint>
namespace cg = cooperative_groups;
namespace pg8 {
#define PG8_LAS __attribute__((address_space(3)))
typedef unsigned short bf16_t;
typedef short bf16x8 __attribute__((ext_vector_type(8)));
typedef float f32x4 __attribute__((ext_vector_type(4)));
typedef unsigned u32x4 __attribute__((ext_vector_type(4)));
constexpr int BM = 256, BK = 64, HALF = 128, HTB = HALF * BK * 2  , STAGE_BYTES = 8 * HTB, NXCD = 8, WGM = 4;

__host__ __device__ __forceinline__ int lds_byte(int r, int c) { const int st = (r >> 4) * 2 + (c >> 5), rr = r & 15, cc = c & 31, ob = rr * 64 + cc * 2; return st * 1024 + (ob ^ (((ob >> 9) & 1) << 5)); }
__host__ __device__ __forceinline__ void stage_rc(int b, int& R, int& C) { const int st = b / 1024, sb = b % 1024, swz = sb ^ (((sb >> 9) & 1) << 5); R = (st >> 1) * 16 + swz / 64; C = (st & 1) * 32 + (swz % 64) / 2; }
__host__ __device__ __forceinline__ int perm32(int rho) { const int n = rho >> 4, i = rho & 15; return 8 * (i >> 2) + 4 * n + (i & 3); }

struct Unit { int pm, pn; };
struct Gemm { const bf16_t* A; const bf16_t* Bt; int M, N, K; };

struct StaticOrder {
    int nM, nN, nwg, G, c;
    __host__ __device__ void init(int M, int N, int G_, int c_) { nM = M / BM; nN = N / BM; nwg = nM * nN; G = G_; c = c_; }
    __host__ __device__ bool next(int i, Unit& u) const {
        const long L = (long)i * G + c; if (L >= nwg) return false;
        int wgid = (int)L; { const int q = nwg / NXCD, r = nwg % NXCD, xcd = wgid % NXCD, off = wgid / NXCD; wgid = (xcd < r ? xcd * (q + 1) : r * (q + 1) + (xcd - r) * q) + off; }
        const int nig = WGM * nN, gid = wgid / nig, fm = gid * WGM, gsz = (nM - fm) < WGM ? (nM - fm) : WGM;
        u.pm = fm + ((wgid % nig) % gsz); u.pn = (wgid % nig) / gsz; return true;
    }
    __device__ __forceinline__ void a_ready(const Unit&) const {}
    __device__ __forceinline__ void done(const Unit&) const {}
};

__device__ __forceinline__ unsigned cvt_pk_bf16(float lo, float hi) { unsigned r; asm volatile("v_cvt_pk_bf16_f32 %0, %1, %2" : "=v"(r) : "v"(lo), "v"(hi)); return r; }
typedef float f32x2 __attribute__((ext_vector_type(2)));
typedef unsigned u32x2 __attribute__((ext_vector_type(2)));
__device__ __forceinline__ float bflo(unsigned w) { return __uint_as_float(w << 16); }
__device__ __forceinline__ float bfhi(unsigned w) { return __uint_as_float(w & 0xffff0000u); }
template <int ACT> struct EpiStore {
    static constexpr bool PERM = true, AFTER_DRAIN = false;
    bf16_t* O; int ldc;
    __device__ __forceinline__ void operator()(const f32x4 (&acc)[2][2][4][2], const Unit& u, int wr, int wc, int fr, int fq) const {
        const int row0 = u.pm * BM + wr * 64 + fr, col0 = u.pn * BM + wc * 32 + 8 * fq;
#pragma unroll
        for (int ai = 0; ai < 2; ++ai)
#pragma unroll
            for (int m = 0; m < 4; ++m) { const unsigned off = ((unsigned)(row0 + ai * HALF + m * 16) * (unsigned)ldc + (unsigned)col0) * 2u;
#pragma unroll
                for (int bj = 0; bj < 2; ++bj) { f32x4 v0 = acc[ai][bj][m][0], v1 = acc[ai][bj][m][1];
                    if (ACT == 1) {
#pragma unroll
                        for (int e = 0; e < 4; ++e) { float a = fmaxf(v0[e], 0.f), b = fmaxf(v1[e], 0.f); v0[e] = a * a; v1[e] = b * b; } }
                    u32x4 w; w.x = cvt_pk_bf16(v0[0], v0[1]); w.y = cvt_pk_bf16(v0[2], v0[3]); w.z = cvt_pk_bf16(v1[0], v1[1]); w.w = cvt_pk_bf16(v1[2], v1[3]);
                    *(u32x4*)((char*)O + off + (unsigned)(bj * HALF) * 2u) = w; } }
    }
};
template <int HAS_IN> struct EpiGate {
    static constexpr bool PERM = true, AFTER_DRAIN = false;
    const bf16_t* gate; int ldg; const bf16_t* Tin; bf16_t* Tout;
    __device__ __forceinline__ void operator()(const f32x4 (&acc)[2][2][4][2], const Unit& u, int wr, int wc, int fr, int fq) const {
        const int row0 = u.pm * BM + wr * 64 + fr, col0 = u.pn * BM + wc * 32 + 8 * fq;
#pragma unroll
        for (int ai = 0; ai < 2; ++ai)
#pragma unroll
            for (int mp = 0; mp < 2; ++mp) {
                u32x4 gw[2][2], tw[2][2];
#pragma unroll
                for (int mm = 0; mm < 2; ++mm)
#pragma unroll
                    for (int bj = 0; bj < 2; ++bj) { const unsigned row = (unsigned)(row0 + ai * HALF + (2 * mp + mm) * 16);
                        gw[mm][bj] = *(const u32x4*)((const char*)gate + (row * (unsigned)ldg + (unsigned)(col0 + bj * HALF)) * 2u);
                        if (HAS_IN) tw[mm][bj] = *(const u32x4*)((const char*)Tin + (row * 1024u + (unsigned)(col0 + bj * HALF)) * 2u); else tw[mm][bj] = (u32x4){0u, 0u, 0u, 0u}; }
                asm volatile("" ::: "memory");
#pragma unroll
                for (int mm = 0; mm < 2; ++mm)
#pragma unroll
                    for (int bj = 0; bj < 2; ++bj) { const int m = 2 * mp + mm; const unsigned row = (unsigned)(row0 + ai * HALF + m * 16);
                        const f32x4 v0 = acc[ai][bj][m][0], v1 = acc[ai][bj][m][1]; const u32x4 g4 = gw[mm][bj], t4 = tw[mm][bj];
                        const float gg[8] = {bflo(g4.x), bfhi(g4.x), bflo(g4.y), bfhi(g4.y), bflo(g4.z), bfhi(g4.z), bflo(g4.w), bfhi(g4.w)};
                        const float ti[8] = {bflo(t4.x), bfhi(t4.x), bflo(t4.y), bfhi(t4.y), bflo(t4.z), bfhi(t4.z), bflo(t4.w), bfhi(t4.w)};
                        float o[8];
#pragma unroll
                        for (int e = 0; e < 8; ++e) { const float s = __builtin_amdgcn_rcpf(1.0f + __builtin_amdgcn_exp2f(-1.4426950408889634f * gg[e])); o[e] = ti[e] + s * (e < 4 ? v0[e & 3] : v1[e & 3]); }
                        u32x4 w; w.x = cvt_pk_bf16(o[0], o[1]); w.y = cvt_pk_bf16(o[2], o[3]); w.z = cvt_pk_bf16(o[4], o[5]); w.w = cvt_pk_bf16(o[6], o[7]);
                        *(u32x4*)((char*)Tout + (row * 1024u + (unsigned)(col0 + bj * HALF)) * 2u) = w; }
                asm volatile("" ::: "memory"); }
    }
};
struct EpiResid {
    static constexpr bool PERM = false, AFTER_DRAIN = false;
    const float* base; float* out;
    __device__ __forceinline__ void operator()(const f32x4 (&acc)[2][2][4][2], const Unit& u, int wr, int wc, int fr, int fq) const {
        const int row0 = u.pm * BM + wr * 64 + fr, col0 = u.pn * BM + wc * 32 + 4 * fq;
        f32x4 bs[2][2][2][2];
#define ER_LOAD(c) do { _Pragma("unroll") for (int mm = 0; mm < 2; ++mm) _Pragma("unroll") for (int bj = 0; bj < 2; ++bj) _Pragma("unroll") for (int n = 0; n < 2; ++n) \
            bs[(c) & 1][mm][bj][n] = *(const f32x4*)((const char*)base + ((unsigned)(row0 + ((c) >> 1) * HALF + (2 * ((c) & 1) + mm) * 16) * 1024u + (unsigned)(col0 + bj * HALF + n * 16)) * 4u); } while (0)
        ER_LOAD(0);
#pragma unroll
        for (int c = 0; c < 4; ++c) {
            if (c + 1 < 4) ER_LOAD(c + 1);
            const int ai = c >> 1, mp = c & 1;
#pragma unroll
            for (int mm = 0; mm < 2; ++mm)
#pragma unroll
                for (int bj = 0; bj < 2; ++bj)
#pragma unroll
                    for (int n = 0; n < 2; ++n) *(f32x4*)((char*)out + ((unsigned)(row0 + ai * HALF + (2 * mp + mm) * 16) * 1024u + (unsigned)(col0 + bj * HALF + n * 16)) * 4u) = bs[c & 1][mm][bj][n] + acc[ai][bj][2 * mp + mm][n];
        }
#undef ER_LOAD
    }
};

template <class Epi, class Sched, bool ALIGN_EPI = false, bool SP2 = false>
__device__ __forceinline__ void gemm_phase(PG8_LAS unsigned char* lds, const Gemm g, const Sched& S, const Epi& E) {
    int tid_ = threadIdx.x; asm volatile("" : "+v"(tid_));
    const int tid = tid_, wid = __builtin_amdgcn_readfirstlane(tid >> 6), lane = tid & 63, wr = wid >> 2, wc = wid & 3, fr = lane & 15, fq = lane >> 4;
    const int K = g.K, nt = K / BK;
    unsigned voffA[2], voffB[2];
#pragma unroll
    for (int i = 0; i < 2; ++i) { int R, C; stage_rc(tid * 16 + i * 8192, R, C); const int Rb = Epi::PERM ? ((R & ~31) + perm32(R & 31)) : R;
        voffA[i] = (unsigned)(R * K + C) * 2u; voffB[i] = (unsigned)(Rb * K + C) * 2u; }
    const size_t kstep = (size_t)(BK * 2);
    const size_t hstep = (size_t)HALF * K * 2;
    const size_t tstep = 2 * hstep;
    const unsigned ldsw = (unsigned)wid * 1024u;
    const int aoff = lds_byte(wr * 64 + fr, fq * 8), boff = lds_byte(wc * 32 + fr, fq * 8);
#define PG8_SA(b, h) (((b) * 2 + (h)) * HTB)
#define PG8_SB(b, h) ((4 + (b) * 2 + (h)) * HTB)
#define PG8_STAGE(bufoff, gbase, voff) do { _Pragma("unroll") for (int _i = 0; _i < 2; ++_i) \
        __builtin_amdgcn_global_load_lds((const unsigned*)((const char*)(gbase) + (voff)[_i]), (PG8_LAS unsigned*)(lds + (bufoff) + ldsw + _i * 8192), 16, 0, 0); } while (0)
#define PG8_LDA(dst, b, h) do { _Pragma("unroll") for (int m = 0; m < 4; ++m) _Pragma("unroll") for (int k = 0; k < 2; ++k) dst[m][k] = *(const PG8_LAS bf16x8*)(lds + PG8_SA(b, h) + aoff + m * 2048 + k * 1024); } while (0)
#define PG8_LDB(dst, b, h) do { _Pragma("unroll") for (int n = 0; n < 2; ++n) _Pragma("unroll") for (int k = 0; k < 2; ++k) dst[n][k] = *(const PG8_LAS bf16x8*)(lds + PG8_SB(b, h) + boff + n * 2048 + k * 1024); } while (0)
#define PG8_MMA(ai, bj, At, Bt) do { __builtin_amdgcn_s_setprio(1); _Pragma("unroll") for (int m = 0; m < 4; ++m) _Pragma("unroll") for (int n = 0; n < 2; ++n) _Pragma("unroll") for (int k = 0; k < 2; ++k) \
        acc[ai][bj][m][n] = __builtin_amdgcn_mfma_f32_16x16x32_bf16(Bt[n][k], At[m][k], acc[ai][bj][m][n], 0, 0, 0); __builtin_amdgcn_s_setprio(0); } while (0)
#define PG8_WAIT_V(n) asm volatile("s_waitcnt vmcnt(" #n ")" ::: "memory")
#define PG8_WAIT_L(n) asm volatile("s_waitcnt lgkmcnt(" #n ")" ::: "memory")
#define PG8_BAR __builtin_amdgcn_s_barrier()
#define PG8_SCHED __builtin_amdgcn_sched_barrier(0)
    Unit cur, nxt; int ui = 0;
    if (!S.next(0, cur)) return;
    f32x4 acc[2][2][4][2];
#pragma unroll
    for (int a = 0; a < 2; ++a)
#pragma unroll
        for (int b = 0; b < 2; ++b)
#pragma unroll
            for (int m = 0; m < 4; ++m)
#pragma unroll
                for (int n = 0; n < 2; ++n) acc[a][b][m][n] = (f32x4){0.f, 0.f, 0.f, 0.f};
    bf16x8 At[4][2], B0[2][2], B1[2][2];
    const char* cA = (const char*)g.A + (size_t)cur.pm * tstep; const char* cB = (const char*)g.Bt + (size_t)cur.pn * tstep;
    S.a_ready(cur);
    if constexpr (SP2) {
        PG8_STAGE(PG8_SB(0, 0), cB, voffB); PG8_STAGE(PG8_SB(0, 1), cB + hstep, voffB); PG8_STAGE(PG8_SA(0, 0), cA, voffA); PG8_STAGE(PG8_SA(0, 1), cA + hstep, voffA);
        if (wr == 1) PG8_BAR;
        PG8_WAIT_V(2); PG8_BAR;
        PG8_STAGE(PG8_SB(1, 0), cB + kstep, voffB); PG8_STAGE(PG8_SA(1, 0), cA + kstep, voffA); PG8_STAGE(PG8_SB(1, 1), cB + hstep + kstep, voffB);
        PG8_WAIT_V(6); PG8_BAR;
    } else {
        PG8_STAGE(PG8_SB(0, 0), cB, voffB); PG8_STAGE(PG8_SA(0, 0), cA, voffA); PG8_STAGE(PG8_SB(0, 1), cB + hstep, voffB); PG8_STAGE(PG8_SA(0, 1), cA + hstep, voffA);
        if (wr == 1) PG8_BAR;
        PG8_WAIT_V(4); PG8_BAR;
        PG8_STAGE(PG8_SB(1, 0), cB + kstep, voffB); PG8_STAGE(PG8_SA(1, 0), cA + kstep, voffA); PG8_STAGE(PG8_SB(1, 1), cB + hstep + kstep, voffB);
        PG8_WAIT_V(6); PG8_BAR;
    }
    for (;;) {
        const bool has_next = S.next(ui + 1, nxt);
        const char* nA = has_next ? (const char*)g.A + (size_t)nxt.pm * tstep : cA; const char* nB = has_next ? (const char*)g.Bt + (size_t)nxt.pn * tstep : cB;
        for (int t = 0; t < nt; t += 2) {
            const bool last = (t == nt - 2);
            const char* a1 = cA + (size_t)(t + 1) * kstep;
            const char* a2 = last ? nA : cA + (size_t)(t + 2) * kstep; const char* b2 = last ? nB : cB + (size_t)(t + 2) * kstep;
            const char* a3 = a2 + kstep; const char* b3 = b2 + kstep;
            if (last && has_next) S.a_ready(nxt);
            if constexpr (SP2) {
            PG8_LDB(B0, 0, 0); PG8_LDB(B1, 0, 1); PG8_SCHED; PG8_LDA(At, 0, 0); PG8_STAGE(PG8_SA(1, 1), a1 + hstep, voffA);
            PG8_WAIT_V(8); PG8_WAIT_L(0); PG8_BAR; PG8_MMA(0, 0, At, B0); PG8_MMA(0, 1, At, B1); PG8_BAR; PG8_SCHED;
            PG8_LDA(At, 0, 1); PG8_STAGE(PG8_SB(0, 0), b2, voffB); PG8_STAGE(PG8_SB(0, 1), b2 + hstep, voffB); PG8_STAGE(PG8_SA(0, 0), a2, voffA);
            PG8_WAIT_V(8); PG8_WAIT_L(0); PG8_BAR; PG8_MMA(1, 0, At, B0); PG8_MMA(1, 1, At, B1); PG8_BAR; PG8_SCHED;
            PG8_LDB(B0, 1, 0); PG8_LDB(B1, 1, 1); PG8_SCHED; PG8_LDA(At, 1, 0); PG8_STAGE(PG8_SA(0, 1), a2 + hstep, voffA);
            PG8_WAIT_V(8); PG8_WAIT_L(0); PG8_BAR; PG8_MMA(0, 0, At, B0); PG8_MMA(0, 1, At, B1); PG8_BAR; PG8_SCHED;
            PG8_LDA(At, 1, 1); PG8_STAGE(PG8_SB(1, 0), b3, voffB); PG8_STAGE(PG8_SB(1, 1), b3 + hstep, voffB); PG8_STAGE(PG8_SA(1, 0), a3, voffA);
            PG8_WAIT_V(8); PG8_WAIT_L(0); PG8_BAR; PG8_MMA(1, 0, At, B0); PG8_MMA(1, 1, At, B1); PG8_BAR; PG8_SCHED;
            } else {
            PG8_LDB(B0, 0, 0); PG8_SCHED; PG8_LDA(At, 0, 0); PG8_STAGE(PG8_SA(1, 1), a1 + hstep, voffA);
            PG8_WAIT_L(8); PG8_BAR; PG8_WAIT_L(0); PG8_MMA(0, 0, At, B0); PG8_BAR; PG8_SCHED;
            PG8_LDB(B1, 0, 1); PG8_STAGE(PG8_SB(0, 0), b2, voffB);
            PG8_BAR; PG8_WAIT_L(0); PG8_MMA(0, 1, At, B1); PG8_BAR;
            PG8_LDA(At, 0, 1); PG8_STAGE(PG8_SA(0, 0), a2, voffA);
            PG8_BAR; PG8_WAIT_L(0); PG8_MMA(1, 0, At, B0); PG8_BAR; PG8_SCHED;
            PG8_STAGE(PG8_SB(0, 1), b2 + hstep, voffB);
            PG8_WAIT_V(6); PG8_BAR; PG8_MMA(1, 1, At, B1); PG8_BAR;
            PG8_LDB(B0, 1, 0); PG8_SCHED; PG8_LDA(At, 1, 0); PG8_STAGE(PG8_SA(0, 1), a2 + hstep, voffA);
            PG8_WAIT_L(8); PG8_BAR; PG8_WAIT_L(0); PG8_MMA(0, 0, At, B0); PG8_BAR; PG8_SCHED;
            PG8_LDB(B1, 1, 1); PG8_STAGE(PG8_SB(1, 0), b3, voffB);
            PG8_BAR; PG8_WAIT_L(0); PG8_MMA(0, 1, At, B1); PG8_BAR;
            PG8_LDA(At, 1, 1); PG8_STAGE(PG8_SA(1, 0), a3, voffA);
            PG8_BAR; PG8_WAIT_L(0); PG8_MMA(1, 0, At, B0); PG8_BAR; PG8_SCHED;
            PG8_STAGE(PG8_SB(1, 1), b3 + hstep, voffB);
            PG8_WAIT_V(6); PG8_BAR; PG8_MMA(1, 1, At, B1); PG8_BAR;
            }
        }
        if constexpr (ALIGN_EPI) { if (wr == 0) PG8_BAR; }
        if constexpr (!Epi::AFTER_DRAIN) { E(acc, cur, wr, wc, fr, fq); S.done(cur); }
        if (!has_next) break;
#pragma unroll
        for (int a = 0; a < 2; ++a)
#pragma unroll
            for (int b = 0; b < 2; ++b)
#pragma unroll
                for (int m = 0; m < 4; ++m)
#pragma unroll
                    for (int n = 0; n < 2; ++n) acc[a][b][m][n] = (f32x4){0.f, 0.f, 0.f, 0.f};
        cur = nxt; cA = nA; cB = nB; ++ui;
        if constexpr (ALIGN_EPI) { if (wr == 1) PG8_BAR; }
    }
    PG8_WAIT_V(0);
    if constexpr (!ALIGN_EPI) { if (wr == 0) PG8_BAR; }
    PG8_BAR;
    if constexpr (Epi::AFTER_DRAIN) { E.fused(acc, cur, wr, wc, fr, fq, lds, wid, lane); S.done(cur); }
#undef PG8_SA
#undef PG8_SB
#undef PG8_STAGE
#undef PG8_LDA
#undef PG8_LDB
#undef PG8_MMA
#undef PG8_WAIT_V
#undef PG8_WAIT_L
#undef PG8_BAR
#undef PG8_SCHED
}
}

#define LAS __attribute__((address_space(3)))
typedef unsigned short bf16;
typedef short bf16x8 __attribute__((ext_vector_type(8)));
typedef float f32x4 __attribute__((ext_vector_type(4)));
typedef float f32x16 __attribute__((ext_vector_type(16)));
typedef unsigned u32x4 __attribute__((ext_vector_type(4)));
typedef unsigned u32x2 __attribute__((ext_vector_type(2)));
constexpr int NWAVES = 8, NTHR = 512;
constexpr int SEQ = 2048, NBATCH = 8, M = NBATCH * SEQ, DM = 1024, NIN = 7296, NINP = 7424, DFF = 4096, DEPTH = 4;
constexpr int C_AQ = 0, C_AK = 384, C_AV = 768, C_BQ = 1152, C_BK = 1664, C_BV = 2176, C_CQ = 2688, C_CK = 2944, C_CV = 3200, C_CG = 3712, C_GATE = 4224;
constexpr float NORM_EPS = 1e-6f, LOG2E = 1.4426950408889634f;
constexpr size_t MiB = 1u << 20;
constexpr size_t WS_WIN = 0, WS_WBRA = 16 * MiB, WS_WBRB = 17 * MiB, WS_WBRC = 18 * MiB, WS_WO = 19 * MiB, WS_W1 = 21 * MiB, WS_W2 = 29 * MiB;
constexpr size_t WS_ROPE = 37 * MiB, WS_LA = 38 * MiB, WS_ACT = 40 * MiB, WS_YA = 72 * MiB, WS_YB = 84 * MiB, WS_YC = 100 * MiB, WS_PROJ = 116 * MiB;
constexpr size_t WS_H = WS_PROJ, WS_VTB = 348 * MiB, WS_VTC = 364 * MiB  , WS_T1 = 348 * MiB, WS_T2 = 380 * MiB, WS_END = 412 * MiB;
static_assert(WS_PROJ + (size_t)M * NINP * 2 <= WS_T1, "ws map");
constexpr int LDS_BYTES = 147456, MISC_OFF = 147456 - 256;
constexpr size_t WS_CTL = WS_END, CTL_BYTES = 16384;

__device__ __forceinline__ unsigned pk2(float lo, float hi) { return pg8::cvt_pk_bf16(lo, hi); }
__device__ __forceinline__ float bflo(unsigned w) { return __uint_as_float(w << 16); }
__device__ __forceinline__ float bfhi(unsigned w) { return __uint_as_float(w & 0xffff0000u); }
__device__ __forceinline__ float shx(float v, int mask, int lane) { return __int_as_float(__builtin_amdgcn_ds_bpermute((lane ^ mask) << 2, __float_as_int(v))); }
__device__ __forceinline__ float wave_sum(float v, int lane) {
#pragma unroll
    for (int o = 1; o < 64; o <<= 1) v += shx(v, o, lane);
    return v;
}
__device__ __forceinline__ float wave_max(float v, int lane) {
#pragma unroll
    for (int o = 1; o < 64; o <<= 1) v = fmaxf(v, shx(v, o, lane));
    return v;
}
#define MFMA32(a, b, c) __builtin_amdgcn_mfma_f32_32x32x16_bf16((a), (b), (c), 0, 0, 0)
__device__ __forceinline__ bf16x8 pack8(float a0, float a1, float a2, float a3, float a4, float a5, float a6, float a7) {
    u32x4 p;
    asm volatile("v_cvt_pk_bf16_f32 %0, %4, %5\n\tv_cvt_pk_bf16_f32 %1, %6, %7\n\tv_cvt_pk_bf16_f32 %2, %8, %9\n\tv_cvt_pk_bf16_f32 %3, %10, %11\n\ts_nop 1"
                 : "=&v"(p[0]), "=&v"(p[1]), "=&v"(p[2]), "=&v"(p[3])
                 : "v"(a0), "v"(a1), "v"(a2), "v"(a3), "v"(a4), "v"(a5), "v"(a6), "v"(a7));
    return __builtin_bit_cast(bf16x8, p);
}
__device__ __forceinline__ int kpos(int key) { return (key & ~12) | ((key & 4) << 1) | ((key & 8) >> 1); }

__device__ __forceinline__ void transpose_item(const float* W, int K, int N, bf16* WT, LAS float* scr, int item, int lane) {
    const int nblk = N / 32, kb = item / nblk, nb = item % nblk, k0 = 64 * kb, n0 = 32 * nb;
#pragma unroll 8
    for (int i = 0; i < 32; ++i) { const int kk = 2 * i + (lane >> 5); scr[kk * 33 + (lane & 31)] = W[(size_t)(k0 + kk) * N + n0 + (lane & 31)]; }
    asm volatile("s_waitcnt lgkmcnt(0)" ::: "memory");
    const int c = lane & 7;
#pragma unroll
    for (int j = 0; j < 4; ++j) { const int n = (lane >> 3) + 8 * j; const LAS float* s = scr + (8 * c) * 33 + n;
        u32x4 o; o.x = pk2(s[0 * 33], s[1 * 33]); o.y = pk2(s[2 * 33], s[3 * 33]); o.z = pk2(s[4 * 33], s[5 * 33]); o.w = pk2(s[6 * 33], s[7 * 33]);
        *(u32x4*)(WT + (size_t)(n0 + n) * K + k0 + 8 * c) = o; }
    asm volatile("s_waitcnt lgkmcnt(0)" ::: "memory");
}
__device__ __forceinline__ void rms_rows_to_bf16(const float* x, const float* g, bf16* o, int gw, int NGW, int lane) {
    const f32x4* gr = (const f32x4*)g + lane;
    f32x4 gg[4];
#pragma unroll
    for (int j = 0; j < 4; ++j) gg[j] = gr[64 * j];
    for (int m0 = gw * 4; m0 < M; m0 += NGW * 4) {
        f32x4 v[4][4];
#pragma unroll
        for (int q = 0; q < 4; ++q)
#pragma unroll
            for (int j = 0; j < 4; ++j) v[q][j] = ((const f32x4*)(x + (size_t)(m0 + q) * DM) + lane)[64 * j];
#pragma unroll
        for (int q = 0; q < 4; ++q) { float s = 0.f;
#pragma unroll
            for (int j = 0; j < 4; ++j) s += (v[q][j].x * v[q][j].x + v[q][j].y * v[q][j].y) + (v[q][j].z * v[q][j].z + v[q][j].w * v[q][j].w);
            const float rstd = 1.0f / sqrtf(wave_sum(s, lane) * (1.f / DM) + NORM_EPS);
            unsigned long long* o8 = (unsigned long long*)(o + (size_t)(m0 + q) * DM) + lane;
#pragma unroll
            for (int j = 0; j < 4; ++j)
                o8[64 * j] = (unsigned long long)pk2(v[q][j].x * rstd * gg[j].x, v[q][j].y * rstd * gg[j].y) | ((unsigned long long)pk2(v[q][j].z * rstd * gg[j].z, v[q][j].w * rstd * gg[j].w) << 32); }
    }
}

struct Args { const float* in[22]; float* out; unsigned char* ws; };
__device__ __forceinline__ int otid() { int t = threadIdx.x; asm volatile("" : "+v"(t)); return t; }

__device__ __forceinline__ void phase_prep(const Args& a, int l, LAS unsigned char* lds, int gw, int NGW, int wave, int lane, const float* xsrc) {
    unsigned char* ws = a.ws;
    LAS float* scr = (LAS float*)(lds + wave * 16384);
    const float* w_in = a.in[2] + (size_t)l * DM * NIN;
    const float* w_bra = a.in[15] + (size_t)l * 384 * DM;
    const float* w_brb = a.in[16] + (size_t)l * 512 * DM;
    const float* w_brc = a.in[17] + (size_t)l * 512 * DM;
    const float* w_o = a.in[18] + (size_t)l * DM * DM;
    const float* w_1 = a.in[20] + (size_t)l * DM * DFF;
    const float* w_2 = a.in[21] + (size_t)l * DFF * DM;
    constexpr int I_IN = (DM / 64) * (NIN / 32), I_A = (384 / 64) * (DM / 32), I_B = (512 / 64) * (DM / 32), I_O = (DM / 64) * (DM / 32), I_1 = (DM / 64) * (DFF / 32), I_2 = (DFF / 64) * (DM / 32);
    constexpr int NITEMS = I_IN + I_A + 2 * I_B + I_O + I_1 + I_2;
    for (int it = gw; it < NITEMS; it += NGW) {
        int r = it;
        if (r < I_IN) { transpose_item(w_in, DM, NIN, (bf16*)(ws + WS_WIN), scr, r, lane); continue; } r -= I_IN;
        if (r < I_A) { transpose_item(w_bra, 384, DM, (bf16*)(ws + WS_WBRA), scr, r, lane); continue; } r -= I_A;
        if (r < I_B) { transpose_item(w_brb, 512, DM, (bf16*)(ws + WS_WBRB), scr, r, lane); continue; } r -= I_B;
        if (r < I_B) { transpose_item(w_brc, 512, DM, (bf16*)(ws + WS_WBRC), scr, r, lane); continue; } r -= I_B;
        if (r < I_O) { transpose_item(w_o, DM, DM, (bf16*)(ws + WS_WO), scr, r, lane); continue; } r -= I_O;
        if (r < I_1) { transpose_item(w_1, DM, DFF, (bf16*)(ws + WS_W1), scr, r, lane); continue; } r -= I_1;
        transpose_item(w_2, DFF, DM, (bf16*)(ws + WS_W2), scr, r, lane);
    }
    { u32x4* z = (u32x4*)((bf16*)(ws + WS_WIN) + (size_t)NIN * DM); unsigned z0 = 0u; asm volatile("" : "+v"(z0)); const u32x4 zz = {z0, z0, z0, z0};
      for (int i = gw * 64 + lane; i < (NINP - NIN) * DM / 8; i += NGW * 64) z[i] = zz; }
    const float* g1 = a.in[1] + (size_t)l * DM;
    bf16* act = (bf16*)(ws + WS_ACT);
    rms_rows_to_bf16(xsrc, g1, act, gw, NGW, lane);
    if (l == 0) {
        float* rp = (float*)(ws + WS_ROPE);
        for (int e = gw * 64 + lane; e < SEQ * 40; e += NGW * 64) {
            const int s = e / 40, i = e % 40;
            float inv; if (i < 8) inv = 1.0f / exp2f((float)(2 * i) * (1.0f / 16.0f) * 18.931568569324174f);
            else inv = 1.0f / exp2f((float)(2 * (i - 8)) * (1.0f / 64.0f) * 13.287712379549449f);
            const float ang = (float)s * inv;
            const double rev = (double)ang * 0.15915494309189535; const float fr = (float)(rev - floor(rev));
            const float cs = __builtin_amdgcn_cosf(fr), sn = __builtin_amdgcn_sinf(fr);
            if (i < 8) { rp[s * 8 + i] = cs; rp[SEQ * 8 + s * 8 + i] = sn; }
            else { rp[SEQ * 16 + s * 32 + (i - 8)] = cs; rp[SEQ * 16 + SEQ * 32 + s * 32 + (i - 8)] = sn; }
        }
    }
}

__device__ __forceinline__ void pp_decode(const Args& a, int l, int hv, int& col, const float*& g, int& full, float& sc) {
    const float qs = 0.125f * LOG2E;
    g = a.in[3]; full = 0; sc = 1.f;
    if (hv < 6) { col = C_AQ + 64 * hv; g = a.in[3] + l * 64; sc = qs; }
    else if (hv < 12) { col = C_AK + 64 * (hv - 6); g = a.in[4] + l * 64; }
    else if (hv < 20) { col = C_BQ + 64 * (hv - 12); g = a.in[5] + l * 64; sc = qs; }
    else if (hv < 28) { col = C_BK + 64 * (hv - 20); g = a.in[6] + l * 64; }
    else if (hv < 32) { col = C_CQ + 64 * (hv - 28); full = 1; }
    else { col = C_CK + 64 * (hv - 32); full = 1; sc = 0.125f; }
}
__device__ __forceinline__ void pp_compute(const u32x4 w0, const u32x4 w1, u32x4& o0, u32x4& o1, const float* g, int full, float sc, int s, int q4, int lane,
                                           const float* cosP, const float* sinP, const float* cosR, const float* sinR) {
    float v[16] = {bflo(w0.x), bfhi(w0.x), bflo(w0.y), bfhi(w0.y), bflo(w0.z), bfhi(w0.z), bflo(w0.w), bfhi(w0.w),
                   bflo(w1.x), bfhi(w1.x), bflo(w1.y), bfhi(w1.y), bflo(w1.z), bfhi(w1.z), bflo(w1.w), bfhi(w1.w)};
    if (!full) {
        float ss = 0.f;
#pragma unroll
        for (int i = 0; i < 16; ++i) ss += v[i] * v[i];
        ss += shx(ss, 1, lane); ss += shx(ss, 2, lane);
        const float r = 1.0f / sqrtf(ss * (1.f / 64.f) + NORM_EPS);
        const f32x4* gp = (const f32x4*)(g + q4 * 16);
#pragma unroll
        for (int c = 0; c < 4; ++c) { const f32x4 gg = gp[c]; v[4 * c] *= r * gg[0]; v[4 * c + 1] *= r * gg[1]; v[4 * c + 2] *= r * gg[2]; v[4 * c + 3] *= r * gg[3]; }
        if (q4 == 0) {
            const f32x4 c0 = *(const f32x4*)(cosP + s * 8), c1 = *(const f32x4*)(cosP + s * 8 + 4), s0 = *(const f32x4*)(sinP + s * 8), s1 = *(const f32x4*)(sinP + s * 8 + 4);
#pragma unroll
            for (int i = 0; i < 8; ++i) { const float c = i < 4 ? c0[i & 3] : c1[i & 3], sn = i < 4 ? s0[i & 3] : s1[i & 3], t1 = v[i], t2 = v[8 + i]; v[i] = t1 * c - t2 * sn; v[8 + i] = t2 * c + t1 * sn; }
        }
    } else {
        const int ib = (q4 & 1) * 16;
        const float sg = (q4 < 2) ? -1.0f : 1.0f;
#pragma unroll
        for (int c = 0; c < 4; ++c) { const f32x4 cc = *(const f32x4*)(cosR + s * 32 + ib + 4 * c), sn = *(const f32x4*)(sinR + s * 32 + ib + 4 * c);
#pragma unroll
            for (int j = 0; j < 4; ++j) { const float pv = shx(v[4 * c + j], 2, lane); v[4 * c + j] = v[4 * c + j] * cc[j] + sg * pv * sn[j]; } }
    }
    o0.x = pk2(v[0] * sc, v[1] * sc); o0.y = pk2(v[2] * sc, v[3] * sc); o0.z = pk2(v[4] * sc, v[5] * sc); o0.w = pk2(v[6] * sc, v[7] * sc);
    o1.x = pk2(v[8] * sc, v[9] * sc); o1.y = pk2(v[10] * sc, v[11] * sc); o1.z = pk2(v[12] * sc, v[13] * sc); o1.w = pk2(v[14] * sc, v[15] * sc);
}
__device__ __forceinline__ void phase_postproj(const Args& a, int l, int gtid, int NT, int lane) {
    bf16* proj = (bf16*)(a.ws + WS_PROJ);
    const float* rp = (const float*)(a.ws + WS_ROPE);
    const float* cosP = rp; const float* sinP = rp + SEQ * 8; const float* cosR = rp + SEQ * 16; const float* sinR = rp + SEQ * 16 + SEQ * 32;
    const int q4 = lane & 3, NQ = NT >> 2;
    for (int e0 = gtid >> 2; e0 < M * 36; e0 += 2 * NQ) {
        const int e1 = e0 + NQ; const bool has1 = e1 < M * 36;
        const int t0 = e0 / 36, hv0 = e0 % 36, t1 = has1 ? e1 / 36 : t0, hv1 = has1 ? e1 % 36 : hv0;
        int col0, full0, col1, full1; const float *g0, *g1; float sc0, sc1;
        pp_decode(a, l, hv0, col0, g0, full0, sc0); pp_decode(a, l, hv1, col1, g1, full1, sc1);
        u32x4* p0 = (u32x4*)(proj + (size_t)t0 * NINP + col0 + q4 * 16); u32x4* p1 = (u32x4*)(proj + (size_t)t1 * NINP + col1 + q4 * 16);
        const u32x4 a0 = p0[0], a1 = p0[1], b0 = p1[0], b1 = p1[1];
        u32x4 o0, o1;
        pp_compute(a0, a1, o0, o1, g0, full0, sc0, t0 & (SEQ - 1), q4, lane, cosP, sinP, cosR, sinR);
        p0[0] = o0; p0[1] = o1;
        if (has1) { pp_compute(b0, b1, o0, o1, g1, full1, sc1, t1 & (SEQ - 1), q4, lane, cosP, sinP, cosR, sinR); p1[0] = o0; p1[1] = o1; }
    }
}

__device__ __forceinline__ void vt_item(const bf16* proj, bf16* vt, int vcol0, int item, LAS unsigned char* scr, int lane) {
    const int kt = item & 31, h = (item >> 5) & 3, b = item >> 7;
    const bf16* src = proj + ((size_t)b * SEQ + kt * 64) * NINP + vcol0 + h * 128;
#pragma unroll 4
    for (int i = 0; i < 16; ++i) { const int row = 4 * i + (lane >> 4), ch = lane & 15;
        const u32x4 w = *(const u32x4*)(src + (size_t)row * NINP + ch * 8);
        *(LAS u32x4*)(scr + row * 272 + ch * 16) = w; }
    asm volatile("s_waitcnt lgkmcnt(0)" ::: "memory");
    const int c = lane & 7;
    bf16* dst = vt + ((size_t)(b * 4 + h) * 128) * SEQ + kt * 64 + c * 8;
#pragma unroll 4
    for (int i = 0; i < 16; ++i) { const int dv = 8 * i + (lane >> 3);
        unsigned short e[8];
#pragma unroll
        for (int j = 0; j < 8; ++j) e[j] = *(const LAS unsigned short*)(scr + kpos(8 * c + j) * 272 + dv * 2);
        u32x4 o; o.x = e[0] | ((unsigned)e[1] << 16); o.y = e[2] | ((unsigned)e[3] << 16); o.z = e[4] | ((unsigned)e[5] << 16); o.w = e[6] | ((unsigned)e[7] << 16);
        *(u32x4*)(dst + (size_t)dv * SEQ) = o; }
    asm volatile("s_waitcnt lgkmcnt(0)" ::: "memory");
}

__device__ __forceinline__ void attn_a_item(const Args& a, int item, LAS unsigned char* wlds, int lane, float M2) {
    const bf16* proj = (const bf16*)(a.ws + WS_PROJ);
    bf16* ya = (bf16*)(a.ws + WS_YA); float* lA = (float*)(a.ws + WS_LA);
    const int r = lane & 31, hh = lane >> 5;
    const int g = item >> 10; int rem = item & 1023;
    const int qhalf = rem & 1; rem >>= 1;
    const int dsh = 2 * g, dil = 1 << dsh, nbs = 5 - dsh, L = SEQ >> dsh;
    const int n = rem & ((1 << nbs) - 1); rem >>= nbs;
    const int rsd = rem & (dil - 1); rem >>= dsh;
    const int hg = rem & 1; const int b = rem >> 1;
    const int head = 2 * g + hg;
    const int iq = 64 * n + 32 * qhalf + r;
    const size_t tq = (size_t)b * SEQ + (size_t)dil * iq + rsd;
    bf16x8 qf[4];
#pragma unroll
    for (int kk = 0; kk < 4; ++kk) qf[kk] = *(const bf16x8*)(proj + tq * NINP + C_AQ + head * 64 + 16 * kk + 8 * hh);
    f32x16 O0, O1;
#pragma unroll
    for (int i = 0; i < 16; ++i) { O0[i] = 0.f; O1[i] = 0.f; }
    float lsum = 0.f;
    const int j0 = 64 * n + 32 * qhalf - 64;
    const int lkey = lane >> 3, lch = lane & 7;
    u32x4 kb_[2][4], vb_[2][4];
    {
#pragma unroll
      for (int i = 0; i < 4; ++i) { int jr = j0 + lkey + 8 * i; jr = jr < 0 ? 0 : (jr >= L ? L - 1 : jr); const size_t tk = (size_t)b * SEQ + (size_t)dil * jr + rsd;
        kb_[0][i] = *(const u32x4*)(proj + tk * NINP + C_AK + head * 64 + lch * 8); vb_[0][i] = *(const u32x4*)(proj + tk * NINP + C_AV + head * 64 + lch * 8); } }
    LAS unsigned char* kl = wlds + 5120;
#pragma unroll
    for (int sb = 0; sb < 5; ++sb) {
        const int jb = j0 + 32 * sb;
        if (sb + 1 < 5) {
#pragma unroll
            for (int i = 0; i < 4; ++i) { int jr = jb + 32 + lkey + 8 * i; jr = jr < 0 ? 0 : (jr >= L ? L - 1 : jr); const size_t tk = (size_t)b * SEQ + (size_t)dil * jr + rsd;
                kb_[(sb + 1) & 1][i] = *(const u32x4*)(proj + tk * NINP + C_AK + head * 64 + lch * 8); vb_[(sb + 1) & 1][i] = *(const u32x4*)(proj + tk * NINP + C_AV + head * 64 + lch * 8); } }
        if (jb < 0 || jb >= L) continue;
#pragma unroll
        for (int i = 0; i < 4; ++i) { const int key = lkey + 8 * i;
            *(LAS u32x4*)(kl + key * 144 + lch * 16) = kb_[sb & 1][i];
            const u32x4 vv = vb_[sb & 1][i]; const unsigned ww[4] = {vv.x, vv.y, vv.z, vv.w};
            LAS bf16* w = (LAS bf16*)(wlds + (lch * 8) * 80 + kpos(key) * 2);
#pragma unroll
            for (int j = 0; j < 4; ++j) { w[(2 * j) * 40] = (bf16)(ww[j] & 0xffffu); w[(2 * j + 1) * 40] = (bf16)(ww[j] >> 16); } }
        asm volatile("s_waitcnt lgkmcnt(0)" ::: "memory");
        f32x16 acc;
#pragma unroll
        for (int i = 0; i < 16; ++i) acc[i] = -M2;
#pragma unroll
        for (int kk = 0; kk < 4; ++kk) { const bf16x8 kf = *(const LAS bf16x8*)(kl + r * 144 + (16 * kk + 8 * hh) * 2); acc = MFMA32(kf, qf[kk], acc); }
        float p[16];
#pragma unroll
        for (int i = 0; i < 16; ++i) { const int j = jb + (i & 3) + 8 * (i >> 2) + 4 * hh; const int d = iq - j;
            const float e = __builtin_amdgcn_exp2f(acc[i]); p[i] = (d <= 64 && d >= -64) ? e : 0.f; lsum += p[i]; }
        const bf16x8 pf0 = pack8(p[0], p[1], p[2], p[3], p[4], p[5], p[6], p[7]);
        const bf16x8 pf1 = pack8(p[8], p[9], p[10], p[11], p[12], p[13], p[14], p[15]);
        const bf16x8 v00 = *(const LAS bf16x8*)(wlds + r * 80 + (8 * hh) * 2);
        const bf16x8 v01 = *(const LAS bf16x8*)(wlds + r * 80 + (16 + 8 * hh) * 2);
        const bf16x8 v10 = *(const LAS bf16x8*)(wlds + (32 + r) * 80 + (8 * hh) * 2);
        const bf16x8 v11 = *(const LAS bf16x8*)(wlds + (32 + r) * 80 + (16 + 8 * hh) * 2);
        O0 = MFMA32(v00, pf0, O0); O0 = MFMA32(v01, pf1, O0);
        O1 = MFMA32(v10, pf0, O1); O1 = MFMA32(v11, pf1, O1);
        asm volatile("s_waitcnt lgkmcnt(0)" ::: "memory");
    }
    const float l = lsum + shx(lsum, 32, lane);
    bf16* op = ya + tq * 384 + head * 64 + 4 * hh;
#pragma unroll
    for (int q = 0; q < 4; ++q) {
        u32x2 w0; w0.x = pk2(O0[4 * q], O0[4 * q + 1]); w0.y = pk2(O0[4 * q + 2], O0[4 * q + 3]); *(u32x2*)(op + 8 * q) = w0;
        u32x2 w1; w1.x = pk2(O1[4 * q], O1[4 * q + 1]); w1.y = pk2(O1[4 * q + 2], O1[4 * q + 3]); *(u32x2*)(op + 32 + 8 * q) = w1;
    }
    if (hh == 0) lA[tq * 6 + head] = l;
}

constexpr int AT_KOFF = 9216, AT_VT = 18432, AT_STAGE = 36864;
constexpr size_t WS_RST = 380 * MiB;
__device__ __forceinline__ void ret_state_item(const Args& a, int l, int item, LAS unsigned char* lds) {
    const bf16* proj = (const bf16*)(a.ws + WS_PROJ);
    const int tid = otid(), wid = __builtin_amdgcn_readfirstlane(tid >> 6), lane = tid & 63, r = lane & 31, hh = lane >> 5;
    const int j = item & 7, h = (item >> 3) & 3, b = item >> 5;
    const float lgf2 = -__expf(a.in[12][l * 4 + h]) * LOG2E, lgb2 = -__expf(a.in[13][l * 4 + h]) * LOG2E;
    const int dir = wid >> 2, db = (wid >> 1) & 1, dvp = wid & 1;
    const bf16* kg = proj + ((size_t)b * SEQ + j * 256 + (tid >> 3)) * NINP + C_CK + h * 64 + (tid & 7) * 8;
    const bf16* vg = (const bf16*)(a.ws + WS_VTC) + ((size_t)(b * 4 + h) * 128 + (tid >> 3)) * SEQ + j * 256 + (tid & 7) * 8;
    f32x16 acc0, acc1;
#pragma unroll
    for (int i = 0; i < 16; ++i) { acc0[i] = 0.f; acc1[i] = 0.f; }
    for (int t = 0; t < 4; ++t) {
        const u32x4 kw = *(const u32x4*)(kg + (size_t)t * 64 * NINP);
        const u32x4 v0 = *(const u32x4*)(vg + t * 64), v1 = *(const u32x4*)(vg + t * 64 + 64 * SEQ);
        const int key = tid >> 3, ch = tid & 7, pos = t * 64 + key;
        const float wf = __builtin_amdgcn_exp2f(lgf2 * (float)(256 - pos)), wb = __builtin_amdgcn_exp2f(lgb2 * (float)pos);
        const float kv[8] = {bflo(kw.x), bfhi(kw.x), bflo(kw.y), bfhi(kw.y), bflo(kw.z), bfhi(kw.z), bflo(kw.w), bfhi(kw.w)};
        LAS bf16* ktf = (LAS bf16*)(lds + (ch * 8) * 144 + kpos(key) * 2);
        LAS bf16* ktb = (LAS bf16*)(lds + 9216 + (ch * 8) * 144 + kpos(key) * 2);
#pragma unroll
        for (int e = 0; e < 8; e += 2) { const unsigned pf = pk2(kv[e] * wf, kv[e + 1] * wf), pb = pk2(kv[e] * wb, kv[e + 1] * wb);
            ktf[e * 72] = (bf16)(pf & 0xffffu); ktf[(e + 1) * 72] = (bf16)(pf >> 16); ktb[e * 72] = (bf16)(pb & 0xffffu); ktb[(e + 1) * 72] = (bf16)(pb >> 16); }
        *(LAS u32x4*)(lds + AT_VT + (tid >> 3) * 144 + (tid & 7) * 16) = v0;
        *(LAS u32x4*)(lds + AT_VT + ((tid >> 3) + 64) * 144 + (tid & 7) * 16) = v1;
        __syncthreads();
        LAS unsigned char* abase = lds + dir * 9216 + (32 * db + r) * 144 + (8 * hh) * 2;
        LAS unsigned char* bbase = lds + AT_VT + (64 * dvp + r) * 144 + (8 * hh) * 2;
#pragma unroll
        for (int ks = 0; ks < 4; ++ks) { const bf16x8 af = *(const LAS bf16x8*)(abase + 32 * ks);
            const bf16x8 b0 = *(const LAS bf16x8*)(bbase + 32 * ks), b1 = *(const LAS bf16x8*)(bbase + 32 * 144 + 32 * ks);
            acc0 = MFMA32(af, b0, acc0); acc1 = MFMA32(af, b1, acc1); }
        __syncthreads();
    }
    float* F = (float*)(a.ws + WS_RST) + ((size_t)(dir * 256 + item) * 64 + 32 * db + 4 * hh) * 128 + 64 * dvp + r;
#pragma unroll
    for (int i = 0; i < 16; ++i) { const int drow = (i & 3) + 8 * (i >> 2); F[drow * 128] = acc0[i]; F[drow * 128 + 32] = acc1[i]; }
}

template <int MODE>
__device__ __forceinline__ void attn_dense_unit(const Args& a, int l, int unit, LAS unsigned char* lds, float M2, float lam, float oscale) {
    const bf16* proj = (const bf16*)(a.ws + WS_PROJ);
    const int tid = otid(), wid = __builtin_amdgcn_readfirstlane(tid >> 6), lane = tid & 63, r = lane & 31, hh = lane >> 5;
    constexpr int QROWS = MODE == 0 ? 128 : 256;
    const int g = MODE == 0 ? (wid >> 1) : wid, m = MODE == 0 ? (wid & 1) : 0;
    const int qb = MODE == 0 ? (unit & 15) : (unit & 7), h = MODE == 0 ? ((unit >> 4) & 3) : ((unit >> 3) & 3), b = MODE == 0 ? (unit >> 6) : (unit >> 5);
    const int qcol = MODE == 0 ? C_BQ + (h * 2 + m) * 64 : C_CQ + h * 64;
    const int kcol = MODE == 0 ? C_BK + h * 128 : C_CK + h * 64;
    const size_t rowbase = (size_t)b * SEQ;
    const int nq = qb * QROWS + g * 32 + r;
    bf16x8 qf[4];
#pragma unroll
    for (int kk = 0; kk < 4; ++kk) qf[kk] = *(const bf16x8*)(proj + (rowbase + nq) * NINP + qcol + 16 * kk + 8 * hh);
    float lgf2 = 0.f, lgb2n = 0.f;
    float c1f[4] = {0.f, 0.f, 0.f, 0.f}, c2f[4] = {0.f, 0.f, 0.f, 0.f}, c1b[4] = {0.f, 0.f, 0.f, 0.f}, c2b[4] = {0.f, 0.f, 0.f, 0.f};
    if (MODE == 1) { lgf2 = -__expf(a.in[12][l * 4 + h]) * LOG2E; lgb2n = __expf(a.in[13][l * 4 + h]) * LOG2E;
#pragma unroll
        for (int q = 0; q < 4; ++q) { c1f[q] = __builtin_amdgcn_exp2f(lgf2 * (float)(3 - q)); c2f[q] = __builtin_amdgcn_exp2f(lgf2 * (float)(28 - 4 * hh - 8 * q));
                                      c1b[q] = __builtin_amdgcn_exp2f(-lgb2n * (float)q); c2b[q] = __builtin_amdgcn_exp2f(-lgb2n * (float)(4 * hh + 8 * q)); } }
    f32x16 O[4];
#pragma unroll
    for (int d = 0; d < 4; ++d)
#pragma unroll
        for (int i = 0; i < 16; ++i) O[d][i] = 0.f;
    float lsum = 0.f;
    if constexpr (MODE == 1) {
        const float* Fb_ = (const float*)(a.ws + WS_RST) + (size_t)((b * 4 + h) * 8) * 8192;
        const float cf = __builtin_amdgcn_exp2f(lgf2 * 256.0f), cb = __builtin_amdgcn_exp2f(-lgb2n * 256.0f);
#pragma unroll
        for (int e = 0; e < 4; ++e) { const int idx = tid + 512 * e, d = idx >> 5, dv4 = (idx & 31) * 4;
            f32x4 sf = {0.f, 0.f, 0.f, 0.f}, sb = {0.f, 0.f, 0.f, 0.f}; float w = 1.0f;
            for (int j = qb - 1; j >= 0; --j) { const f32x4 v = *(const f32x4*)(Fb_ + (size_t)j * 8192 + d * 128 + dv4); sf += v * w; w *= cf; }
            w = 1.0f;
            for (int j = qb + 1; j < 8; ++j) { const f32x4 v = *(const f32x4*)(Fb_ + (size_t)(256 + j) * 8192 + d * 128 + dv4); sb += v * w; w *= cb; }
#pragma unroll
            for (int q = 0; q < 4; ++q) { *(LAS bf16*)(lds + 73728 + (dv4 + q) * 144 + d * 2) = (bf16)(pk2(sf[q], 0.f) & 0xffffu); *(LAS bf16*)(lds + 92160 + (dv4 + q) * 144 + d * 2) = (bf16)(pk2(sb[q], 0.f) & 0xffffu); } }
        __syncthreads();
        const float wqf = __builtin_amdgcn_exp2f(lgf2 * (float)(g * 32 + r)), wqb = __builtin_amdgcn_exp2f(-lgb2n * (float)(256 - (g * 32 + r)));
#pragma unroll
        for (int d = 0; d < 4; ++d) { f32x16 of = O[d], ob = O[d];
#pragma unroll
            for (int kk = 0; kk < 4; ++kk) { const bf16x8 af = *(const LAS bf16x8*)(lds + 73728 + (32 * d + r) * 144 + (16 * kk + 8 * hh) * 2);
                const bf16x8 ab = *(const LAS bf16x8*)(lds + 92160 + (32 * d + r) * 144 + (16 * kk + 8 * hh) * 2);
                of = MFMA32(af, qf[kk], of); ob = MFMA32(ab, qf[kk], ob); }
#pragma unroll
            for (int i = 0; i < 16; ++i) O[d][i] = of[i] * wqf + ob[i] * wqb; }
    }
    const int lk_key = tid >> 3, lk_ch = tid & 7;
    const bf16* kg = proj + (rowbase + lk_key) * NINP + kcol + lk_ch * 8;
    const bf16* vg = (const bf16*)(a.ws + (MODE == 0 ? WS_VTB : WS_VTC)) + ((size_t)(b * 4 + h) * 128 + (tid >> 3)) * SEQ + (tid & 7) * 8;
    u32x4 kr0, kr1, vr0, vr1;
    constexpr int NTALL = SEQ / 64, NT = MODE == 0 ? NTALL : 4;
    const int kt0 = ((QROWS / 64) * qb) & (NTALL - 1);
    { const size_t o = (size_t)kt0 * 64 * NINP;
      kr0 = *(const u32x4*)(kg + o); if (MODE == 0) kr1 = *(const u32x4*)(kg + o + 64);
      vr0 = *(const u32x4*)(vg + kt0 * 64); vr1 = *(const u32x4*)(vg + kt0 * 64 + 64 * SEQ); }
    for (int it = 0; it < NT; ++it) {
        const int kt = (it + kt0) & (NTALL - 1);
        LAS unsigned char* st = lds + (it & 1) * AT_STAGE;
        *(LAS u32x4*)(st + lk_key * 144 + lk_ch * 16) = kr0;
        if (MODE == 0) *(LAS u32x4*)(st + AT_KOFF + lk_key * 144 + lk_ch * 16) = kr1;
        *(LAS u32x4*)(st + AT_VT + lk_key * 144 + lk_ch * 16) = vr0;
        *(LAS u32x4*)(st + AT_VT + (lk_key + 64) * 144 + lk_ch * 16) = vr1;
        __syncthreads();
        if (it + 1 < NT) {
            const int kn = (kt + 1) & (NTALL - 1);
            const size_t o = (size_t)kn * 64 * NINP;
            kr0 = *(const u32x4*)(kg + o); if (MODE == 0) kr1 = *(const u32x4*)(kg + o + 64);
            vr0 = *(const u32x4*)(vg + kn * 64); vr1 = *(const u32x4*)(vg + kn * 64 + 64 * SEQ);
        }
#define SCORE_TO_P(acc, kb, p) do { \
            if (MODE == 0) { _Pragma("unroll") for (int i = 0; i < 16; ++i) { p[i] = __builtin_amdgcn_exp2f(acc[i]); lsum += p[i]; } } \
            else { const int mk0 = kt * 64 + 32 * (kb), q0w = qb * QROWS + g * 32; \
                if (mk0 + 31 < q0w) { const float A_ = __builtin_amdgcn_exp2f(lgf2 * (float)(nq - mk0 - 31)); float c2_[4]; \
                    _Pragma("unroll") for (int bq = 0; bq < 4; ++bq) c2_[bq] = A_ * c2f[bq]; \
                    _Pragma("unroll") for (int i = 0; i < 16; ++i) p[i] = acc[i] * (c2_[i >> 2] * c1f[i & 3]); } \
                else if (mk0 > q0w + 31) { const float A_ = __builtin_amdgcn_exp2f(-lgb2n * (float)(mk0 - nq)); float c2_[4]; \
                    _Pragma("unroll") for (int bq = 0; bq < 4; ++bq) c2_[bq] = A_ * c2b[bq]; \
                    _Pragma("unroll") for (int i = 0; i < 16; ++i) p[i] = acc[i] * (c2_[i >> 2] * c1b[i & 3]); } \
                else { const int dbase_ = nq - (mk0 + 4 * hh); \
                    _Pragma("unroll") for (int i = 0; i < 16; ++i) { const int d_ = dbase_ - ((i & 3) + 8 * (i >> 2)); const float df_ = (float)d_; \
                        const float e_ = df_ * (d_ > 0 ? lgf2 : lgb2n); float D_ = __builtin_amdgcn_exp2f(e_); D_ = (d_ == 0) ? 2.0f : D_; p[i] = acc[i] * D_; } } } } while (0)
        {
            LAS unsigned char* kbase = st + (MODE == 0 ? m * AT_KOFF : 0) + r * 144 + (8 * hh) * 2;
            LAS unsigned char* vbase = st + AT_VT + r * 144 + (8 * hh) * 2;
            bf16x8 kf0[4], kf1[4], vf[8];
#pragma unroll
            for (int kk = 0; kk < 4; ++kk) kf0[kk] = *(const LAS bf16x8*)(kbase + 32 * kk);
#pragma unroll
            for (int kk = 0; kk < 4; ++kk) kf1[kk] = *(const LAS bf16x8*)(kbase + 32 * 144 + 32 * kk);
#pragma unroll
            for (int dvb = 0; dvb < 4; ++dvb) { vf[2 * dvb] = *(const LAS bf16x8*)(vbase + dvb * 32 * 144); vf[2 * dvb + 1] = *(const LAS bf16x8*)(vbase + dvb * 32 * 144 + 32); }
            __builtin_amdgcn_sched_barrier(0);
            f32x16 acc0, acc1;
#pragma unroll
            for (int i = 0; i < 16; ++i) { acc0[i] = MODE == 0 ? -M2 : 0.f; acc1[i] = MODE == 0 ? -M2 : 0.f; }
#pragma unroll
            for (int kk = 0; kk < 4; ++kk) acc0 = MFMA32(kf0[kk], qf[kk], acc0);
#pragma unroll
            for (int kk = 0; kk < 4; ++kk) acc1 = MFMA32(kf1[kk], qf[kk], acc1);
            __builtin_amdgcn_sched_barrier(0);
            float p[16];
            SCORE_TO_P(acc0, 0, p);
            const bf16x8 pf00 = pack8(p[0], p[1], p[2], p[3], p[4], p[5], p[6], p[7]);
            const bf16x8 pf01 = pack8(p[8], p[9], p[10], p[11], p[12], p[13], p[14], p[15]);
            __builtin_amdgcn_sched_barrier(0);
#pragma unroll
            for (int dvb = 0; dvb < 4; ++dvb) O[dvb] = MFMA32(vf[2 * dvb], pf00, O[dvb]);
#pragma unroll
            for (int dvb = 0; dvb < 4; ++dvb) O[dvb] = MFMA32(vf[2 * dvb + 1], pf01, O[dvb]);
#pragma unroll
            for (int dvb = 0; dvb < 4; ++dvb) { vf[2 * dvb] = *(const LAS bf16x8*)(vbase + 64 + dvb * 32 * 144); vf[2 * dvb + 1] = *(const LAS bf16x8*)(vbase + 64 + dvb * 32 * 144 + 32); }
            SCORE_TO_P(acc1, 1, p);
            const bf16x8 pf10 = pack8(p[0], p[1], p[2], p[3], p[4], p[5], p[6], p[7]);
            const bf16x8 pf11 = pack8(p[8], p[9], p[10], p[11], p[12], p[13], p[14], p[15]);
            __builtin_amdgcn_sched_barrier(0);
#pragma unroll
            for (int dvb = 0; dvb < 4; ++dvb) O[dvb] = MFMA32(vf[2 * dvb], pf10, O[dvb]);
#pragma unroll
            for (int dvb = 0; dvb < 4; ++dvb) O[dvb] = MFMA32(vf[2 * dvb + 1], pf11, O[dvb]);
        }
#undef SCORE_TO_P
    }
    __syncthreads();
    if (MODE == 0) { const float linv = 1.0f / (lsum + shx(lsum, 32, lane));
#pragma unroll
        for (int d = 0; d < 4; ++d)
#pragma unroll
            for (int i = 0; i < 16; ++i) O[d][i] *= linv; }
    LAS float* ex = (LAS float*)(lds + g * 16384) + lane;
    if (MODE == 0 && m == 1) {
#pragma unroll
        for (int d = 0; d < 4; ++d)
#pragma unroll
            for (int i = 0; i < 16; ++i) ex[(d * 16 + i) * 64] = O[d][i];
    }
    __syncthreads();
    if (m == 0) {
        float ss = 0.f;
#pragma unroll
        for (int d = 0; d < 4; ++d)
#pragma unroll
            for (int i = 0; i < 16; ++i) { float o = O[d][i]; if (MODE == 0) { o -= lam * ex[(d * 16 + i) * 64]; O[d][i] = o; } ss += o * o; }
        ss += shx(ss, 32, lane);
        const float rr = (1.0f / sqrtf(ss * (1.f / 128.f) + NORM_EPS)) * oscale;
        const float* gout = MODE == 0 ? a.in[11] + l * 128 : a.in[14] + l * 128;
        const size_t trow = rowbase + nq;
        bf16* yo = (bf16*)(a.ws + (MODE == 0 ? WS_YB : WS_YC)) + trow * 512 + h * 128 + 4 * hh;
        const bf16* cg = proj + trow * NINP + C_CG + h * 128 + 4 * hh;
#pragma unroll
        for (int d = 0; d < 4; ++d)
#pragma unroll
            for (int q = 0; q < 4; ++q) {
                const int dv = 32 * d + 8 * q;
                const f32x4 gg = *(const f32x4*)(gout + dv + 4 * hh);
                float y0 = O[d][4 * q] * rr * gg.x, y1 = O[d][4 * q + 1] * rr * gg.y, y2 = O[d][4 * q + 2] * rr * gg.z, y3 = O[d][4 * q + 3] * rr * gg.w;
                if (MODE == 1) { const u32x2 cw = *(const u32x2*)(cg + dv);
                    const float c0 = bflo(cw.x), c1 = bfhi(cw.x), c2 = bflo(cw.y), c3 = bfhi(cw.y);
                    y0 *= c0 / (1.0f + __expf(-c0)); y1 *= c1 / (1.0f + __expf(-c1)); y2 *= c2 / (1.0f + __expf(-c2)); y3 *= c3 / (1.0f + __expf(-c3)); }
                u32x2 w; w.x = pk2(y0, y1); w.y = pk2(y2, y3); *(u32x2*)(yo + dv) = w;
            }
    }
    __syncthreads();
}

#ifndef PHM
#define PHM 0xFFFF
#endif
#ifndef DBL
#define DBL 0
#endif
#define REP(k) for (int rep_ = 0; rep_ < (((DBL >> (k)) & 1) ? 2 : 1); ++rep_)
#define PH(k) if constexpr ((PHM >> (k)) & 1)
#define XB_TMO      128
#define XB_XCNT(j)  (256  + 64 * (j))
#define XB_XSUB(j)  (1280 + 64 * (j))
#define XB_XGEN(j)  (2304 + 64 * (j))
#define XB_TOP      3328
#define XB_TOPGEN   3392
#define XCD_BAR_WORDS 3456
#define XB_SPIN_CAP (1u << 18)

__device__ __forceinline__ unsigned xb_ld(unsigned* p)              { return __hip_atomic_load(p, __ATOMIC_RELAXED, __HIP_MEMORY_SCOPE_AGENT); }
__device__ __forceinline__ unsigned xb_add(unsigned* p, unsigned v) { return __hip_atomic_fetch_add(p, v, __ATOMIC_RELAXED, __HIP_MEMORY_SCOPE_AGENT); }
__device__ __forceinline__ unsigned xb_xcc_id() { return (unsigned)__builtin_amdgcn_s_getreg((3 << 11) | 20) & 0xFu; }
#define XB_SPIN(cond, bar) do { unsigned _sp = 0; while (cond) { __builtin_amdgcn_s_sleep(1); \
    if ((++_sp & 255u) == 0u) { if (xb_ld(&(bar)[XB_TMO])) break; if (_sp > XB_SPIN_CAP) { atomicAdd(&(bar)[XB_TMO], 1u); break; } } } } while (0)

struct XcdBarrier {
    unsigned* bar; unsigned x;
    volatile LAS unsigned* st;
};

__device__ __forceinline__ XcdBarrier xcd_barrier_post(unsigned* bar, volatile LAS unsigned* st) {
    XcdBarrier b; b.bar = bar; b.x = xb_xcc_id(); b.st = st;
    if (threadIdx.x == 0) (void)xb_add(&bar[XB_XCNT(b.x)], 1u);
    return b;
}
__device__ __forceinline__ void xcd_barrier_complete(unsigned* bar, unsigned x, unsigned& nloc, unsigned& nx) {
    const unsigned G = gridDim.x * gridDim.y * gridDim.z;
    unsigned sum, cnt, mine, sp = 0u;
    for (;;) {
        sum = 0u; cnt = 0u; mine = 0u;
#pragma unroll
        for (unsigned j = 0; j < 16; ++j) { const unsigned c = xb_ld(&bar[XB_XCNT(j)]); sum += c; cnt += (c > 0u) ? 1u : 0u; mine = (j == x) ? c : mine; }
        if (sum == G) break;
        __builtin_amdgcn_s_sleep(1);
        if ((++sp & 255u) == 0u) { if (xb_ld(&bar[XB_TMO])) break; if (sp > XB_SPIN_CAP) { atomicAdd(&bar[XB_TMO], 1u); break; } }
    }
    nloc = mine > 0u ? mine : 1u; nx = cnt > 0u ? cnt : 1u;
}

__device__ __forceinline__ void xcd_barrier(const XcdBarrier& b) {
    asm volatile("s_waitcnt vmcnt(0)" ::: "memory");
    __syncthreads();
    if (threadIdx.x == 0) {
        unsigned* bar = b.bar;
        __builtin_amdgcn_s_waitcnt(0);
        unsigned nloc = b.st[0], nx = b.st[1];
        if (nloc == 0u) { xcd_barrier_complete(bar, b.x, nloc, nx); b.st[0] = nloc; b.st[1] = nx; }
        const unsigned old = xb_add(&bar[XB_XSUB(b.x)], 1u);
        const unsigned gen = old / nloc;
        if (old + 1u == (gen + 1u) * nloc) {
            __builtin_amdgcn_fence(__ATOMIC_RELEASE, "agent");
            asm volatile("s_waitcnt vmcnt(0)" ::: "memory");
            const unsigned og = xb_add(&bar[XB_TOP], 1u);
            const unsigned tg = og / nx;
            if (og + 1u == (tg + 1u) * nx) xb_add(&bar[XB_TOPGEN], 1u);
            else XB_SPIN(xb_ld(&bar[XB_TOPGEN]) == tg, bar);
            __builtin_amdgcn_fence(__ATOMIC_ACQUIRE, "agent");
            xb_add(&bar[XB_XGEN(b.x)], 1u);
            asm volatile("s_waitcnt vmcnt(0)" ::: "memory");
        } else {
            XB_SPIN(xb_ld(&bar[XB_XGEN(b.x)]) == gen, bar);
            __builtin_amdgcn_fence(__ATOMIC_ACQUIRE, "agent");
            asm volatile("s_waitcnt vmcnt(0)" ::: "memory");
        }
    }
    __syncthreads();
}

typedef __attribute__((address_space(4))) const Args* CArgsP;
__device__ __forceinline__ Args load_args() {
    Args r{};
#if defined(__HIP_DEVICE_COMPILE__)
    CArgsP p = (CArgsP)__builtin_amdgcn_kernarg_segment_ptr(); asm volatile("" : "+s"(p));
#pragma unroll
    for (int i = 0; i < 22; ++i) r.in[i] = p->in[i];
    r.out = p->out; r.ws = p->ws;
#endif
    return r;
}
#define TIDS() const int tid = otid(), lane = tid & 63, wave = __builtin_amdgcn_readfirstlane(tid >> 6), gw = bx * NWAVES + wave, gtid = bx * NTHR + tid; (void)lane; (void)gw; (void)gtid
__global__ void __launch_bounds__(NTHR, 2) fwd_megakernel(Args a_unused) {
    extern __shared__ __attribute__((aligned(16))) unsigned char lds_raw[];
    LAS unsigned char* lds = (LAS unsigned char*)lds_raw;
    cg::grid_group grid = cg::this_grid();
    const int G = gridDim.x, bx = blockIdx.x;
    const int NGW = G * NWAVES, NT = G * NTHR;
    if (threadIdx.x < 2) ((volatile LAS unsigned*)(lds + MISC_OFF))[threadIdx.x] = 0u;
    __syncthreads();
    { const Args a = load_args(); (void)xcd_barrier_post((unsigned*)(a.ws + WS_CTL), (volatile LAS unsigned*)(lds + MISC_OFF)); }
#define GSYNC() do { const Args a_ = load_args(); XcdBarrier b_; b_.bar = (unsigned*)(a_.ws + WS_CTL); b_.x = xb_xcc_id(); b_.st = (volatile LAS unsigned*)(lds + MISC_OFF); xcd_barrier(b_); } while (0)

    for (int l = 0; l < DEPTH; ++l) {
        PH(0) REP(0) { const Args a = load_args(); TIDS(); phase_prep(a, l, lds, gw, NGW, wave, lane, (l == 0) ? a.in[0] : a.out); }
        { const Args a_ = load_args(); if (a_.ws == nullptr) grid.sync(); }
        GSYNC();
        if constexpr ((DBL >> 8) & 1) { for (int i_ = 0; i_ < 10; ++i_) GSYNC(); }
        PH(1) REP(1) { const Args a = load_args(); unsigned char* ws = a.ws;
          pg8::Gemm g{(const bf16*)(ws + WS_ACT), (const bf16*)(ws + WS_WIN), M, NINP, DM}; pg8::StaticOrder S; S.init(M, NINP, G, bx);
          pg8::EpiStore<0> E{(bf16*)(ws + WS_PROJ), NINP};
          pg8::gemm_phase<pg8::EpiStore<0>, pg8::StaticOrder, true, true>(lds, g, S, E); }
        GSYNC();
        PH(2) { const Args a = load_args(); TIDS(); phase_postproj(a, l, gtid, NT, lane);
                for (int it = gw; it < 2048; it += NGW) { const int c = it >> 10;
                    vt_item((const bf16*)(a.ws + WS_PROJ), (bf16*)(a.ws + (c ? WS_VTC : WS_VTB)), c ? C_CV : C_BV, it & 1023, lds + wave * 17408, lane); } }
        GSYNC();
        {
            const Args a = load_args(); TIDS();
            PH(5) { if (G == 256) { if (bx >= 128) for (int it = bx - 128; it < 256; it += 128) ret_state_item(a, l, it, lds); }
                    else for (int it = bx; it < 256; it += G) ret_state_item(a, l, it, lds); }
            PH(3) {
            const float gqa = wave_max(fabsf(a.in[3][l * 64 + lane]), lane), gka = wave_max(fabsf(a.in[4][l * 64 + lane]), lane);
            const float M2a = 8.0f * LOG2E * gqa * gka;
            REP(2) for (int it = gw; it < 3072; it += NGW) attn_a_item(a, it, lds + wave * 16384, lane, M2a);
            }
            __syncthreads();
            PH(4) {
            const float gqb = wave_max(fabsf(a.in[5][l * 64 + lane]), lane), gkb = wave_max(fabsf(a.in[6][l * 64 + lane]), lane);
            const float M2b = 8.0f * LOG2E * gqb * gkb;
            const float lam_init = 0.8f - 0.6f * expf(-0.3f * (float)l);
            const float s1 = wave_sum(a.in[7][l * 64 + lane] * a.in[8][l * 64 + lane], lane), s2 = wave_sum(a.in[9][l * 64 + lane] * a.in[10][l * 64 + lane], lane);
            const float lam = expf(s1) - expf(s2) + lam_init;
            REP(3) for (int u0 = bx; u0 < 512; u0 += G) { const int v = u0 & 255, u = (((v & 7) * 2 + (v >> 7)) + 16 * (u0 >> 8)) * 16 + ((v >> 3) & 15); attn_dense_unit<0>(a, l, u, lds, M2b, lam, 1.0f - lam_init); }
            }
        }
        GSYNC();
        {
            const Args a = load_args(); TIDS();
            PH(5) REP(4) for (int u0 = bx; u0 < 256; u0 += G) { const int u = ((u0 & 7) * 4 + (u0 >> 6)) * 8 + ((u0 >> 3) & 7); attn_dense_unit<1>(a, l, u, lds, 0.f, 0.f, 1.0f); }
            const float* lA = (const float*)(a.ws + WS_LA); bf16* ya = (bf16*)(a.ws + WS_YA);
            for (int e0 = gtid; e0 < M * 48; e0 += 3 * NT) {
                u32x4 w[3]; float lt[3]; u32x4* pp[3];
#pragma unroll
                for (int q = 0; q < 3; ++q) { int e = e0 + q * NT; e = e < M * 48 ? e : e0; const int t = e / 48, ch = e % 48, hg = (ch >> 3) & 1;
                    lt[q] = lA[t * 6 + hg] + lA[t * 6 + 2 + hg] + lA[t * 6 + 4 + hg]; pp[q] = (u32x4*)(ya + (size_t)t * 384 + ch * 8); w[q] = *pp[q]; }
#pragma unroll
                for (int q = 0; q < 3; ++q) { const float li = 1.0f / lt[q]; u32x4 v = w[q];
                    v.x = pk2(bflo(v.x) * li, bfhi(v.x) * li); v.y = pk2(bflo(v.y) * li, bfhi(v.y) * li);
                    v.z = pk2(bflo(v.z) * li, bfhi(v.z) * li); v.w = pk2(bflo(v.w) * li, bfhi(v.w) * li); *pp[q] = v; }
            }
        }
        GSYNC();
        PH(6) {
          { const Args a = load_args(); unsigned char* ws = a.ws; pg8::StaticOrder S; S.init(M, DM, G, bx);
            pg8::Gemm g{(const bf16*)(ws + WS_YA), (const bf16*)(ws + WS_WBRA), M, DM, 384}; pg8::EpiGate<0> E{(const bf16*)(ws + WS_PROJ) + C_GATE, NINP, nullptr, (bf16*)(ws + WS_T1)};
            pg8::gemm_phase<pg8::EpiGate<0>, pg8::StaticOrder, true, true>(lds, g, S, E); }
          { const Args a = load_args(); unsigned char* ws = a.ws; pg8::StaticOrder S; S.init(M, DM, G, bx);
            pg8::Gemm g{(const bf16*)(ws + WS_YB), (const bf16*)(ws + WS_WBRB), M, DM, 512}; pg8::EpiGate<1> E{(const bf16*)(ws + WS_PROJ) + C_GATE + 1024, NINP, (const bf16*)(ws + WS_T1), (bf16*)(ws + WS_T2)};
            pg8::gemm_phase<pg8::EpiGate<1>, pg8::StaticOrder, true, true>(lds, g, S, E); }
          { const Args a = load_args(); unsigned char* ws = a.ws; pg8::StaticOrder S; S.init(M, DM, G, bx);
            pg8::Gemm g{(const bf16*)(ws + WS_YC), (const bf16*)(ws + WS_WBRC), M, DM, 512}; pg8::EpiGate<1> E{(const bf16*)(ws + WS_PROJ) + C_GATE + 2048, NINP, (const bf16*)(ws + WS_T2), (bf16*)(ws + WS_ACT)};
            pg8::gemm_phase<pg8::EpiGate<1>, pg8::StaticOrder, true, true>(lds, g, S, E); } }
        GSYNC();
        PH(7) { const Args a = load_args(); unsigned char* ws = a.ws;
          pg8::Gemm g{(const bf16*)(ws + WS_ACT), (const bf16*)(ws + WS_WO), M, DM, DM}; pg8::StaticOrder S; S.init(M, DM, G, bx);
          pg8::EpiResid E{(l == 0) ? a.in[0] : a.out, a.out};
          pg8::gemm_phase<pg8::EpiResid, pg8::StaticOrder, true, true>(lds, g, S, E); }
        GSYNC();
        { const Args a = load_args(); TIDS(); const float* g2 = a.in[19] + (size_t)l * DM; bf16* act = (bf16*)(a.ws + WS_ACT);
          rms_rows_to_bf16(a.out, g2, act, gw, NGW, lane); }
        GSYNC();
        PH(8) { const Args a = load_args(); unsigned char* ws = a.ws;
          pg8::Gemm g{(const bf16*)(ws + WS_ACT), (const bf16*)(ws + WS_W1), M, DFF, DM}; pg8::StaticOrder S; S.init(M, DFF, G, bx);
          pg8::EpiStore<1> E{(bf16*)(ws + WS_H), DFF};
          pg8::gemm_phase<pg8::EpiStore<1>, pg8::StaticOrder, true, true>(lds, g, S, E); }
        GSYNC();
        PH(9) { const Args a = load_args(); unsigned char* ws = a.ws;
          pg8::Gemm g{(const bf16*)(ws + WS_H), (const bf16*)(ws + WS_W2), M, DM, DFF}; pg8::StaticOrder S; S.init(M, DM, G, bx);
          pg8::EpiResid E{a.out, a.out};
          pg8::gemm_phase<pg8::EpiResid, pg8::StaticOrder, true, true>(lds, g, S, E); }
        GSYNC();
    }
}

extern "C" void kernel_launch(void* const* d_in, const int* in_sizes, int n_in, void* d_out, int out_size, void* d_ws, size_t ws_size, hipStream_t stream) {
    static int grid = 0;
    if (grid == 0) {
        if (n_in != 22 || out_size != M * DM || ws_size < WS_CTL + CTL_BYTES) { fprintf(stderr, "kernel_launch: unexpected shapes (n_in %d out %d ws %zu)\n", n_in, out_size, ws_size); grid = -1; return; }
        int dev = 0, cus = 0, per_cu = 0;
        hipGetDevice(&dev); hipDeviceGetAttribute(&cus, hipDeviceAttributeMultiprocessorCount, dev);
        hipFuncSetAttribute((const void*)fwd_megakernel, hipFuncAttributeMaxDynamicSharedMemorySize, LDS_BYTES);
        hipOccupancyMaxActiveBlocksPerMultiprocessor(&per_cu, (const void*)fwd_megakernel, NTHR, LDS_BYTES);
        if (per_cu < 1) { fprintf(stderr, "kernel_launch: occupancy query says %d blocks/CU\n", per_cu); per_cu = 1; }
        (void)hipGetLastError();
        grid = cus;
    }
    if (grid < 0) return;
    if (hipMemsetAsync((char*)d_ws + WS_CTL, 0, CTL_BYTES, stream) != hipSuccess) { fprintf(stderr, "kernel_launch: memset failed\n"); return; }
    Args a{};
    for (int i = 0; i < 22; ++i) a.in[i] = (const float*)d_in[i];
    a.out = (float*)d_out; a.ws = (unsigned char*)d_ws;
    void* args[] = {&a};
    hipError_t e = hipLaunchCooperativeKernel((const void*)fwd_megakernel, dim3(grid), dim3(NTHR), args, LDS_BYTES, stream);
    if (e != hipSuccess) fprintf(stderr, "cooperative launch failed: %s (grid %d)\n", hipGetErrorString(e), grid);
}
```

```cpp
#include <hip/hip_runtime.h>
#include <hip/hip_cooperative_groups.h>
#include <cstdio>
#include <cstdint>
namespace cg = cooperative_groups;
namespace pg8 {
#define PG8_LAS __attribute__((address_space(3)))
typedef unsigned short bf16_t;
typedef short bf16x8 __attribute__((ext_vector_type(8)));
typedef float f32x4 __attribute__((ext_vector_type(4)));
typedef unsigned u32x4 __attribute__((ext_vector_type(4)));
constexpr int BM = 256, BK = 64, HALF = 128, HTB = HALF * BK * 2  , STAGE_BYTES = 8 * HTB, NXCD = 8, WGM = 6;

__host__ __device__ __forceinline__ int lds_byte(int r, int c) { const int st = (r >> 4) * 2 + (c >> 5), rr = r & 15, cc = c & 31, ob = rr * 64 + cc * 2; return st * 1024 + (ob ^ (((ob >> 9) & 1) << 5)); }
__host__ __device__ __forceinline__ void stage_rc(int b, int& R, int& C) { const int st = b / 1024, sb = b % 1024, swz = sb ^ (((sb >> 9) & 1) << 5); R = (st >> 1) * 16 + swz / 64; C = (st & 1) * 32 + (swz % 64) / 2; }
__host__ __device__ __forceinline__ int perm32(int rho) { const int n = rho >> 4, i = rho & 15; return 8 * (i >> 2) + 4 * n + (i & 3); }

struct Unit { int pm, pn; };
struct Gemm { const bf16_t* A; const bf16_t* Bt; int M, N, K; };

struct StaticOrder {
    int nM, nN, nwg, G, c;
    __host__ __device__ void init(int M, int N, int G_, int c_) { nM = M / BM; nN = N / BM; nwg = nM * nN; G = G_; c = c_; }
    __host__ __device__ bool next(int i, Unit& u) const {
        const long L = (long)i * G + c; if (L >= nwg) return false;
        int wgid = (int)L; { const int q = nwg / NXCD, r = nwg % NXCD, xcd = wgid % NXCD, off = wgid / NXCD; wgid = (xcd < r ? xcd * (q + 1) : r * (q + 1) + (xcd - r) * q) + off; }
        const int nig = WGM * nN, gid = wgid / nig, fm = gid * WGM, gsz = (nM - fm) < WGM ? (nM - fm) : WGM;
        u.pm = fm + ((wgid % nig) % gsz); u.pn = (wgid % nig) / gsz; return true;
    }
    __device__ __forceinline__ void a_ready(const Unit&) const {}
    __device__ __forceinline__ void done(const Unit&) const {}
};

__device__ __forceinline__ unsigned cvt_pk_bf16(float lo, float hi) { unsigned r; asm volatile("v_cvt_pk_bf16_f32 %0, %1, %2" : "=v"(r) : "v"(lo), "v"(hi)); return r; }
typedef float f32x2 __attribute__((ext_vector_type(2)));
typedef unsigned u32x2 __attribute__((ext_vector_type(2)));
__device__ __forceinline__ float bflo(unsigned w) { return __uint_as_float(w << 16); }
__device__ __forceinline__ float bfhi(unsigned w) { return __uint_as_float(w & 0xffff0000u); }
template <int ACT> struct EpiStore {
    static constexpr bool PERM = true, AFTER_DRAIN = false;
    bf16_t* O; int ldc;
    __device__ __forceinline__ void operator()(const f32x4 (&acc)[2][2][4][2], const Unit& u, int wr, int wc, int fr, int fq) const {
        const int row0 = u.pm * BM + wr * 64 + fr, col0 = u.pn * BM + wc * 32 + 8 * fq;
#pragma unroll
        for (int ai = 0; ai < 2; ++ai)
#pragma unroll
            for (int m = 0; m < 4; ++m) { const unsigned off = ((unsigned)(row0 + ai * HALF + m * 16) * (unsigned)ldc + (unsigned)col0) * 2u;
#pragma unroll
                for (int bj = 0; bj < 2; ++bj) { f32x4 v0 = acc[ai][bj][m][0], v1 = acc[ai][bj][m][1];
                    if (ACT == 1) {
#pragma unroll
                        for (int e = 0; e < 4; ++e) { float a = fmaxf(v0[e], 0.f), b = fmaxf(v1[e], 0.f); v0[e] = a * a; v1[e] = b * b; } }
                    u32x4 w; w.x = cvt_pk_bf16(v0[0], v0[1]); w.y = cvt_pk_bf16(v0[2], v0[3]); w.z = cvt_pk_bf16(v1[0], v1[1]); w.w = cvt_pk_bf16(v1[2], v1[3]);
                    *(u32x4*)((char*)O + off + (unsigned)(bj * HALF) * 2u) = w; } }
    }
};
template <int HAS_IN> struct EpiGate {
    static constexpr bool PERM = true, AFTER_DRAIN = false;
    const bf16_t* gate; int ldg; const bf16_t* Tin; bf16_t* Tout;
    __device__ __forceinline__ void operator()(const f32x4 (&acc)[2][2][4][2], const Unit& u, int wr, int wc, int fr, int fq) const {
        const int row0 = u.pm * BM + wr * 64 + fr, col0 = u.pn * BM + wc * 32 + 8 * fq;
#pragma unroll
        for (int ai = 0; ai < 2; ++ai)
#pragma unroll
            for (int mp = 0; mp < 2; ++mp) {
                u32x4 gw[2][2], tw[2][2];
#pragma unroll
                for (int mm = 0; mm < 2; ++mm)
#pragma unroll
                    for (int bj = 0; bj < 2; ++bj) { const unsigned row = (unsigned)(row0 + ai * HALF + (2 * mp + mm) * 16);
                        gw[mm][bj] = *(const u32x4*)((const char*)gate + (row * (unsigned)ldg + (unsigned)(col0 + bj * HALF)) * 2u);
                        if (HAS_IN) tw[mm][bj] = *(const u32x4*)((const char*)Tin + (row * 1024u + (unsigned)(col0 + bj * HALF)) * 2u); else tw[mm][bj] = (u32x4){0u, 0u, 0u, 0u}; }
                asm volatile("" ::: "memory");
#pragma unroll
                for (int mm = 0; mm < 2; ++mm)
#pragma unroll
                    for (int bj = 0; bj < 2; ++bj) { const int m = 2 * mp + mm; const unsigned row = (unsigned)(row0 + ai * HALF + m * 16);
                        const f32x4 v0 = acc[ai][bj][m][0], v1 = acc[ai][bj][m][1]; const u32x4 g4 = gw[mm][bj], t4 = tw[mm][bj];
                        const float gg[8] = {bflo(g4.x), bfhi(g4.x), bflo(g4.y), bfhi(g4.y), bflo(g4.z), bfhi(g4.z), bflo(g4.w), bfhi(g4.w)};
                        const float ti[8] = {bflo(t4.x), bfhi(t4.x), bflo(t4.y), bfhi(t4.y), bflo(t4.z), bfhi(t4.z), bflo(t4.w), bfhi(t4.w)};
                        float o[8];
#pragma unroll
                        for (int e = 0; e < 8; ++e) { const float s = __builtin_amdgcn_rcpf(1.0f + __builtin_amdgcn_exp2f(-1.4426950408889634f * gg[e])); o[e] = ti[e] + s * (e < 4 ? v0[e & 3] : v1[e & 3]); }
                        u32x4 w; w.x = cvt_pk_bf16(o[0], o[1]); w.y = cvt_pk_bf16(o[2], o[3]); w.z = cvt_pk_bf16(o[4], o[5]); w.w = cvt_pk_bf16(o[6], o[7]);
                        *(u32x4*)((char*)Tout + (row * 1024u + (unsigned)(col0 + bj * HALF)) * 2u) = w; }
                asm volatile("" ::: "memory"); }
    }
};
struct EpiResid {
    static constexpr bool PERM = false, AFTER_DRAIN = false;
    const float* base; float* out;
    __device__ __forceinline__ void operator()(const f32x4 (&acc)[2][2][4][2], const Unit& u, int wr, int wc, int fr, int fq) const {
        const int row0 = u.pm * BM + wr * 64 + fr, col0 = u.pn * BM + wc * 32 + 4 * fq;
        f32x4 bs[2][2][2][2];
#define ER_LOAD(c) do { _Pragma("unroll") for (int mm = 0; mm < 2; ++mm) _Pragma("unroll") for (int bj = 0; bj < 2; ++bj) _Pragma("unroll") for (int n = 0; n < 2; ++n) \
            bs[(c) & 1][mm][bj][n] = *(const f32x4*)((const char*)base + ((unsigned)(row0 + ((c) >> 1) * HALF + (2 * ((c) & 1) + mm) * 16) * 1024u + (unsigned)(col0 + bj * HALF + n * 16)) * 4u); } while (0)
        ER_LOAD(0);
#pragma unroll
        for (int c = 0; c < 4; ++c) {
            if (c + 1 < 4) ER_LOAD(c + 1);
            const int ai = c >> 1, mp = c & 1;
#pragma unroll
            for (int mm = 0; mm < 2; ++mm)
#pragma unroll
                for (int bj = 0; bj < 2; ++bj)
#pragma unroll
                    for (int n = 0; n < 2; ++n) *(f32x4*)((char*)out + ((unsigned)(row0 + ai * HALF + (2 * mp + mm) * 16) * 1024u + (unsigned)(col0 + bj * HALF + n * 16)) * 4u) = bs[c & 1][mm][bj][n] + acc[ai][bj][2 * mp + mm][n];
        }
#undef ER_LOAD
    }
};

template <class Epi, class Sched, bool ALIGN_EPI = false, bool SP2 = false>
__device__ __forceinline__ void gemm_phase(PG8_LAS unsigned char* lds, const Gemm g, const Sched& S, const Epi& E) {
    int tid_ = threadIdx.x; asm volatile("" : "+v"(tid_));
    const int tid = tid_, wid = __builtin_amdgcn_readfirstlane(tid >> 6), lane = tid & 63, wr = wid >> 2, wc = wid & 3, fr = lane & 15, fq = lane >> 4;
    const int K = g.K, nt = K / BK;
    unsigned voffA[2], voffB[2];
#pragma unroll
    for (int i = 0; i < 2; ++i) { int R, C; stage_rc(tid * 16 + i * 8192, R, C); const int Rb = Epi::PERM ? ((R & ~31) + perm32(R & 31)) : R;
        voffA[i] = (unsigned)(R * K + C) * 2u; voffB[i] = (unsigned)(Rb * K + C) * 2u; }
    const size_t kstep = (size_t)(BK * 2);
    const size_t hstep = (size_t)HALF * K * 2;
    const size_t tstep = 2 * hstep;
    const unsigned ldsw = (unsigned)wid * 1024u;
    const int aoff = lds_byte(wr * 64 + fr, fq * 8), boff = lds_byte(wc * 32 + fr, fq * 8);
#define PG8_SA(b, h) (((b) * 2 + (h)) * HTB)
#define PG8_SB(b, h) ((4 + (b) * 2 + (h)) * HTB)
#define PG8_STAGE(bufoff, gbase, voff) do { _Pragma("unroll") for (int _i = 0; _i < 2; ++_i) \
        __builtin_amdgcn_global_load_lds((const unsigned*)((const char*)(gbase) + (voff)[_i]), (PG8_LAS unsigned*)(lds + (bufoff) + ldsw + _i * 8192), 16, 0, 0); } while (0)
#define PG8_LDA(dst, b, h) do { _Pragma("unroll") for (int m = 0; m < 4; ++m) _Pragma("unroll") for (int k = 0; k < 2; ++k) dst[m][k] = *(const PG8_LAS bf16x8*)(lds + PG8_SA(b, h) + aoff + m * 2048 + k * 1024); } while (0)
#define PG8_LDB(dst, b, h) do { _Pragma("unroll") for (int n = 0; n < 2; ++n) _Pragma("unroll") for (int k = 0; k < 2; ++k) dst[n][k] = *(const PG8_LAS bf16x8*)(lds + PG8_SB(b, h) + boff + n * 2048 + k * 1024); } while (0)
#define PG8_MMA(ai, bj, At, Bt) do { __builtin_amdgcn_s_setprio(1); _Pragma("unroll") for (int m = 0; m < 4; ++m) _Pragma("unroll") for (int n = 0; n < 2; ++n) _Pragma("unroll") for (int k = 0; k < 2; ++k) \
        acc[ai][bj][m][n] = __builtin_amdgcn_mfma_f32_16x16x32_bf16(Bt[n][k], At[m][k], acc[ai][bj][m][n], 0, 0, 0); __builtin_amdgcn_s_setprio(0); } while (0)
#define PG8_WAIT_V(n) asm volatile("s_waitcnt vmcnt(" #n ")" ::: "memory")
#define PG8_WAIT_L(n) asm volatile("s_waitcnt lgkmcnt(" #n ")" ::: "memory")
#define PG8_BAR __builtin_amdgcn_s_barrier()
#define PG8_SCHED __builtin_amdgcn_sched_barrier(0)
    Unit cur, nxt; int ui = 0;
    if (!S.next(0, cur)) return;
    f32x4 acc[2][2][4][2];
#pragma unroll
    for (int a = 0; a < 2; ++a)
#pragma unroll
        for (int b = 0; b < 2; ++b)
#pragma unroll
            for (int m = 0; m < 4; ++m)
#pragma unroll
                for (int n = 0; n < 2; ++n) acc[a][b][m][n] = (f32x4){0.f, 0.f, 0.f, 0.f};
    bf16x8 At[4][2], B0[2][2], B1[2][2];
    const char* cA = (const char*)g.A + (size_t)cur.pm * tstep; const char* cB = (const char*)g.Bt + (size_t)cur.pn * tstep;
    S.a_ready(cur);
    if constexpr (SP2) {
        PG8_STAGE(PG8_SB(0, 0), cB, voffB); PG8_STAGE(PG8_SB(0, 1), cB + hstep, voffB); PG8_STAGE(PG8_SA(0, 0), cA, voffA); PG8_STAGE(PG8_SA(0, 1), cA + hstep, voffA);
        if (wr == 1) PG8_BAR;
        PG8_WAIT_V(2); PG8_BAR;
        PG8_STAGE(PG8_SB(1, 0), cB + kstep, voffB); PG8_STAGE(PG8_SA(1, 0), cA + kstep, voffA); PG8_STAGE(PG8_SB(1, 1), cB + hstep + kstep, voffB);
        PG8_WAIT_V(6); PG8_BAR;
    } else {
        PG8_STAGE(PG8_SB(0, 0), cB, voffB); PG8_STAGE(PG8_SA(0, 0), cA, voffA); PG8_STAGE(PG8_SB(0, 1), cB + hstep, voffB); PG8_STAGE(PG8_SA(0, 1), cA + hstep, voffA);
        if (wr == 1) PG8_BAR;
        PG8_WAIT_V(4); PG8_BAR;
        PG8_STAGE(PG8_SB(1, 0), cB + kstep, voffB); PG8_STAGE(PG8_SA(1, 0), cA + kstep, voffA); PG8_STAGE(PG8_SB(1, 1), cB + hstep + kstep, voffB);
        PG8_WAIT_V(6); PG8_BAR;
    }
    for (;;) {
        const bool has_next = S.next(ui + 1, nxt);
        const char* nA = has_next ? (const char*)g.A + (size_t)nxt.pm * tstep : cA; const char* nB = has_next ? (const char*)g.Bt + (size_t)nxt.pn * tstep : cB;
        for (int t = 0; t < nt; t += 2) {
            const bool last = (t == nt - 2);
            const char* a1 = cA + (size_t)(t + 1) * kstep;
            const char* a2 = last ? nA : cA + (size_t)(t + 2) * kstep; const char* b2 = last ? nB : cB + (size_t)(t + 2) * kstep;
            const char* a3 = a2 + kstep; const char* b3 = b2 + kstep;
            if (last && has_next) S.a_ready(nxt);
            if constexpr (SP2) {
            PG8_LDB(B0, 0, 0); PG8_LDB(B1, 0, 1); PG8_SCHED; PG8_LDA(At, 0, 0); PG8_STAGE(PG8_SA(1, 1), a1 + hstep, voffA);
            PG8_WAIT_V(8); PG8_WAIT_L(0); PG8_BAR; PG8_MMA(0, 0, At, B0); PG8_MMA(0, 1, At, B1); PG8_BAR; PG8_SCHED;
            PG8_LDA(At, 0, 1); PG8_STAGE(PG8_SB(0, 0), b2, voffB); PG8_STAGE(PG8_SB(0, 1), b2 + hstep, voffB); PG8_STAGE(PG8_SA(0, 0), a2, voffA);
            PG8_WAIT_V(8); PG8_WAIT_L(0); PG8_BAR; PG8_MMA(1, 0, At, B0); PG8_MMA(1, 1, At, B1); PG8_BAR; PG8_SCHED;
            PG8_LDB(B0, 1, 0); PG8_LDB(B1, 1, 1); PG8_SCHED; PG8_LDA(At, 1, 0); PG8_STAGE(PG8_SA(0, 1), a2 + hstep, voffA);
            PG8_WAIT_V(8); PG8_WAIT_L(0); PG8_BAR; PG8_MMA(0, 0, At, B0); PG8_MMA(0, 1, At, B1); PG8_BAR; PG8_SCHED;
            PG8_LDA(At, 1, 1); PG8_STAGE(PG8_SB(1, 0), b3, voffB); PG8_STAGE(PG8_SB(1, 1), b3 + hstep, voffB); PG8_STAGE(PG8_SA(1, 0), a3, voffA);
            PG8_WAIT_V(8); PG8_WAIT_L(0); PG8_BAR; PG8_MMA(1, 0, At, B0); PG8_MMA(1, 1, At, B1); PG8_BAR; PG8_SCHED;
            } else {
            PG8_LDB(B0, 0, 0); PG8_SCHED; PG8_LDA(At, 0, 0); PG8_STAGE(PG8_SA(1, 1), a1 + hstep, voffA);
            PG8_WAIT_L(8); PG8_BAR; PG8_WAIT_L(0); PG8_MMA(0, 0, At, B0); PG8_BAR; PG8_SCHED;
            PG8_LDB(B1, 0, 1); PG8_STAGE(PG8_SB(0, 0), b2, voffB);
            PG8_BAR; PG8_WAIT_L(0); PG8_MMA(0, 1, At, B1); PG8_BAR;
            PG8_LDA(At, 0, 1); PG8_STAGE(PG8_SA(0, 0), a2, voffA);
            PG8_BAR; PG8_WAIT_L(0); PG8_MMA(1, 0, At, B0); PG8_BAR; PG8_SCHED;
            PG8_STAGE(PG8_SB(0, 1), b2 + hstep, voffB);
            PG8_WAIT_V(6); PG8_BAR; PG8_MMA(1, 1, At, B1); PG8_BAR;
            PG8_LDB(B0, 1, 0); PG8_SCHED; PG8_LDA(At, 1, 0); PG8_STAGE(PG8_SA(0, 1), a2 + hstep, voffA);
            PG8_WAIT_L(8); PG8_BAR; PG8_WAIT_L(0); PG8_MMA(0, 0, At, B0); PG8_BAR; PG8_SCHED;
            PG8_LDB(B1, 1, 1); PG8_STAGE(PG8_SB(1, 0), b3, voffB);
            PG8_BAR; PG8_WAIT_L(0); PG8_MMA(0, 1, At, B1); PG8_BAR;
            PG8_LDA(At, 1, 1); PG8_STAGE(PG8_SA(1, 0), a3, voffA);
            PG8_BAR; PG8_WAIT_L(0); PG8_MMA(1, 0, At, B0); PG8_BAR; PG8_SCHED;
            PG8_STAGE(PG8_SB(1, 1), b3 + hstep, voffB);
            PG8_WAIT_V(6); PG8_BAR; PG8_MMA(1, 1, At, B1); PG8_BAR;
            }
        }
        if constexpr (ALIGN_EPI) { if (wr == 0) PG8_BAR; }
        if constexpr (!Epi::AFTER_DRAIN) { E(acc, cur, wr, wc, fr, fq); S.done(cur); }
        if (!has_next) break;
#pragma unroll
        for (int a = 0; a < 2; ++a)
#pragma unroll
            for (int b = 0; b < 2; ++b)
#pragma unroll
                for (int m = 0; m < 4; ++m)
#pragma unroll
                    for (int n = 0; n < 2; ++n) acc[a][b][m][n] = (f32x4){0.f, 0.f, 0.f, 0.f};
        cur = nxt; cA = nA; cB = nB; ++ui;
        if constexpr (ALIGN_EPI) { if (wr == 1) PG8_BAR; }
    }
    PG8_WAIT_V(0);
    if constexpr (!ALIGN_EPI) { if (wr == 0) PG8_BAR; }
    PG8_BAR;
    if constexpr (Epi::AFTER_DRAIN) { E.fused(acc, cur, wr, wc, fr, fq, lds, wid, lane); S.done(cur); }
#undef PG8_SA
#undef PG8_SB
#undef PG8_STAGE
#undef PG8_LDA
#undef PG8_LDB
#undef PG8_MMA
#undef PG8_WAIT_V
#undef PG8_WAIT_L
#undef PG8_BAR
#undef PG8_SCHED
}
}

#define LAS __attribute__((address_space(3)))
typedef unsigned short bf16;
typedef short bf16x8 __attribute__((ext_vector_type(8)));
typedef float f32x4 __attribute__((ext_vector_type(4)));
typedef float f32x16 __attribute__((ext_vector_type(16)));
typedef unsigned u32x4 __attribute__((ext_vector_type(4)));
typedef unsigned u32x2 __attribute__((ext_vector_type(2)));
constexpr int NWAVES = 8, NTHR = 512;
constexpr int SEQ = 2048, NBATCH = 8, M = NBATCH * SEQ, DM = 1024, NIN = 7296, NINP = 7424, DFF = 4096, DEPTH = 4;
constexpr int C_AQ = 0, C_AK = 384, C_AV = 768, C_BQ = 1152, C_BK = 1664, C_BV = 2176, C_CQ = 2688, C_CK = 2944, C_CV = 3200, C_CG = 3712, C_GATE = 4224;
constexpr float NORM_EPS = 1e-6f, LOG2E = 1.4426950408889634f;
constexpr size_t MiB = 1u << 20;
constexpr size_t WS_WIN = 0, WS_WBRA = 16 * MiB, WS_WBRB = 17 * MiB, WS_WBRC = 18 * MiB, WS_WO = 19 * MiB, WS_W1 = 21 * MiB, WS_W2 = 29 * MiB;
constexpr size_t WS_ROPE = 37 * MiB, WS_LA = 38 * MiB, WS_ACT = 40 * MiB, WS_YA = 72 * MiB, WS_YB = 84 * MiB, WS_YC = 100 * MiB, WS_PROJ = 116 * MiB;
constexpr size_t WS_H = WS_PROJ, WS_VTB = 348 * MiB, WS_VTC = 364 * MiB  , WS_T1 = 348 * MiB, WS_T2 = 380 * MiB, WS_END = 412 * MiB;
static_assert(WS_PROJ + (size_t)M * NINP * 2 <= WS_T1, "ws map");
constexpr int LDS_BYTES = 147456, MISC_OFF = 147456 - 256;
constexpr size_t WS_CTL = WS_END, CTL_BYTES = 16384;

__device__ __forceinline__ unsigned pk2(float lo, float hi) { return pg8::cvt_pk_bf16(lo, hi); }
__device__ __forceinline__ float bflo(unsigned w) { return __uint_as_float(w << 16); }
__device__ __forceinline__ float bfhi(unsigned w) { return __uint_as_float(w & 0xffff0000u); }
__device__ __forceinline__ float shx(float v, int mask, int lane) { return __int_as_float(__builtin_amdgcn_ds_bpermute((lane ^ mask) << 2, __float_as_int(v))); }
__device__ __forceinline__ float wave_sum(float v, int lane) {
#pragma unroll
    for (int o = 1; o < 64; o <<= 1) v += shx(v, o, lane);
    return v;
}
__device__ __forceinline__ float wave_max(float v, int lane) {
#pragma unroll
    for (int o = 1; o < 64; o <<= 1) v = fmaxf(v, shx(v, o, lane));
    return v;
}
#define MFMA32(a, b, c) __builtin_amdgcn_mfma_f32_32x32x16_bf16((a), (b), (c), 0, 0, 0)
__device__ __forceinline__ bf16x8 pack8(float a0, float a1, float a2, float a3, float a4, float a5, float a6, float a7) {
    u32x4 p;
    asm volatile("v_cvt_pk_bf16_f32 %0, %4, %5\n\tv_cvt_pk_bf16_f32 %1, %6, %7\n\tv_cvt_pk_bf16_f32 %2, %8, %9\n\tv_cvt_pk_bf16_f32 %3, %10, %11\n\ts_nop 1"
                 : "=&v"(p[0]), "=&v"(p[1]), "=&v"(p[2]), "=&v"(p[3])
                 : "v"(a0), "v"(a1), "v"(a2), "v"(a3), "v"(a4), "v"(a5), "v"(a6), "v"(a7));
    return __builtin_bit_cast(bf16x8, p);
}
__device__ __forceinline__ int kpos(int key) { return (key & ~12) | ((key & 4) << 1) | ((key & 8) >> 1); }

__device__ __forceinline__ void transpose_item(const float* W, int K, int N, bf16* WT, LAS float* scr, int item, int lane) {
    const int nblk = N / 32, kb = item / nblk, nb = item % nblk, k0 = 64 * kb, n0 = 32 * nb;
#pragma unroll 8
    for (int i = 0; i < 32; ++i) { const int kk = 2 * i + (lane >> 5); scr[kk * 33 + (lane & 31)] = W[(size_t)(k0 + kk) * N + n0 + (lane & 31)]; }
    asm volatile("s_waitcnt lgkmcnt(0)" ::: "memory");
    const int c = lane & 7;
#pragma unroll
    for (int j = 0; j < 4; ++j) { const int n = (lane >> 3) + 8 * j; const LAS float* s = scr + (8 * c) * 33 + n;
        u32x4 o; o.x = pk2(s[0 * 33], s[1 * 33]); o.y = pk2(s[2 * 33], s[3 * 33]); o.z = pk2(s[4 * 33], s[5 * 33]); o.w = pk2(s[6 * 33], s[7 * 33]);
        *(u32x4*)(WT + (size_t)(n0 + n) * K + k0 + 8 * c) = o; }
    asm volatile("s_waitcnt lgkmcnt(0)" ::: "memory");
}
__device__ __forceinline__ void rms_rows_to_bf16(const float* x, const float* g, bf16* o, int gw, int NGW, int lane) {
    const f32x4* gr = (const f32x4*)g + lane;
    f32x4 gg[4];
#pragma unroll
    for (int j = 0; j < 4; ++j) gg[j] = gr[64 * j];
    for (int m0 = gw * 4; m0 < M; m0 += NGW * 4) {
        f32x4 v[4][4];
#pragma unroll
        for (int q = 0; q < 4; ++q)
#pragma unroll
            for (int j = 0; j < 4; ++j) v[q][j] = ((const f32x4*)(x + (size_t)(m0 + q) * DM) + lane)[64 * j];
#pragma unroll
        for (int q = 0; q < 4; ++q) { float s = 0.f;
#pragma unroll
            for (int j = 0; j < 4; ++j) s += (v[q][j].x * v[q][j].x + v[q][j].y * v[q][j].y) + (v[q][j].z * v[q][j].z + v[q][j].w * v[q][j].w);
            const float rstd = 1.0f / sqrtf(wave_sum(s, lane) * (1.f / DM) + NORM_EPS);
            unsigned long long* o8 = (unsigned long long*)(o + (size_t)(m0 + q) * DM) + lane;
#pragma unroll
            for (int j = 0; j < 4; ++j)
                o8[64 * j] = (unsigned long long)pk2(v[q][j].x * rstd * gg[j].x, v[q][j].y * rstd * gg[j].y) | ((unsigned long long)pk2(v[q][j].z * rstd * gg[j].z, v[q][j].w * rstd * gg[j].w) << 32); }
    }
}

struct Args { const float* in[22]; float* out; unsigned char* ws; };
__device__ __forceinline__ int otid() { int t = threadIdx.x; asm volatile("" : "+v"(t)); return t; }

__device__ __forceinline__ void phase_prep(const Args& a, int l, LAS unsigned char* lds, int gw, int NGW, int wave, int lane, const float* xsrc) {
    unsigned char* ws = a.ws;
    LAS float* scr = (LAS float*)(lds + wave * 16384);
    const float* w_in = a.in[2] + (size_t)l * DM * NIN;
    const float* w_bra = a.in[15] + (size_t)l * 384 * DM;
    const float* w_brb = a.in[16] + (size_t)l * 512 * DM;
    const float* w_brc = a.in[17] + (size_t)l * 512 * DM;
    const float* w_o = a.in[18] + (size_t)l * DM * DM;
    const float* w_1 = a.in[20] + (size_t)l * DM * DFF;
    const float* w_2 = a.in[21] + (size_t)l * DFF * DM;
    constexpr int I_IN = (DM / 64) * (NIN / 32), I_A = (384 / 64) * (DM / 32), I_B = (512 / 64) * (DM / 32), I_O = (DM / 64) * (DM / 32), I_1 = (DM / 64) * (DFF / 32), I_2 = (DFF / 64) * (DM / 32);
    constexpr int NITEMS = I_IN + I_A + 2 * I_B + I_O + I_1 + I_2;
    for (int it = gw; it < NITEMS; it += NGW) {
        int r = it;
        if (r < I_IN) { transpose_item(w_in, DM, NIN, (bf16*)(ws + WS_WIN), scr, r, lane); continue; } r -= I_IN;
        if (r < I_A) { transpose_item(w_bra, 384, DM, (bf16*)(ws + WS_WBRA), scr, r, lane); continue; } r -= I_A;
        if (r < I_B) { transpose_item(w_brb, 512, DM, (bf16*)(ws + WS_WBRB), scr, r, lane); continue; } r -= I_B;
        if (r < I_B) { transpose_item(w_brc, 512, DM, (bf16*)(ws + WS_WBRC), scr, r, lane); continue; } r -= I_B;
        if (r < I_O) { transpose_item(w_o, DM, DM, (bf16*)(ws + WS_WO), scr, r, lane); continue; } r -= I_O;
        if (r < I_1) { transpose_item(w_1, DM, DFF, (bf16*)(ws + WS_W1), scr, r, lane); continue; } r -= I_1;
        transpose_item(w_2, DFF, DM, (bf16*)(ws + WS_W2), scr, r, lane);
    }
    { u32x4* z = (u32x4*)((bf16*)(ws + WS_WIN) + (size_t)NIN * DM); unsigned z0 = 0u; asm volatile("" : "+v"(z0)); const u32x4 zz = {z0, z0, z0, z0};
      for (int i = gw * 64 + lane; i < (NINP - NIN) * DM / 8; i += NGW * 64) z[i] = zz; }
    const float* g1 = a.in[1] + (size_t)l * DM;
    bf16* act = (bf16*)(ws + WS_ACT);
    rms_rows_to_bf16(xsrc, g1, act, gw, NGW, lane);
    if (l == 0) {
        float* rp = (float*)(ws + WS_ROPE);
        for (int e = gw * 64 + lane; e < SEQ * 40; e += NGW * 64) {
            const int s = e / 40, i = e % 40;
            float inv; if (i < 8) inv = 1.0f / exp2f((float)(2 * i) * (1.0f / 16.0f) * 18.931568569324174f);
            else inv = 1.0f / exp2f((float)(2 * (i - 8)) * (1.0f / 64.0f) * 13.287712379549449f);
            const float ang = (float)s * inv;
            const double rev = (double)ang * 0.15915494309189535; const float fr = (float)(rev - floor(rev));
            const float cs = __builtin_amdgcn_cosf(fr), sn = __builtin_amdgcn_sinf(fr);
            if (i < 8) { rp[s * 8 + i] = cs; rp[SEQ * 8 + s * 8 + i] = sn; }
            else { rp[SEQ * 16 + s * 32 + (i - 8)] = cs; rp[SEQ * 16 + SEQ * 32 + s * 32 + (i - 8)] = sn; }
        }
    }
}

__device__ __forceinline__ void pp_decode(const Args& a, int l, int hv, int& col, const float*& g, int& full, float& sc) {
    const float qs = 0.125f * LOG2E;
    g = a.in[3]; full = 0; sc = 1.f;
    if (hv < 6) { col = C_AQ + 64 * hv; g = a.in[3] + l * 64; sc = qs; }
    else if (hv < 12) { col = C_AK + 64 * (hv - 6); g = a.in[4] + l * 64; }
    else if (hv < 20) { col = C_BQ + 64 * (hv - 12); g = a.in[5] + l * 64; sc = qs; }
    else if (hv < 28) { col = C_BK + 64 * (hv - 20); g = a.in[6] + l * 64; }
    else if (hv < 32) { col = C_CQ + 64 * (hv - 28); full = 1; }
    else { col = C_CK + 64 * (hv - 32); full = 1; sc = 0.125f; }
}
__device__ __forceinline__ void pp_compute(const u32x4 w0, const u32x4 w1, u32x4& o0, u32x4& o1, const float* g, int full, float sc, int s, int q4, int lane,
                                           const float* cosP, const float* sinP, const float* cosR, const float* sinR) {
    float v[16] = {bflo(w0.x), bfhi(w0.x), bflo(w0.y), bfhi(w0.y), bflo(w0.z), bfhi(w0.z), bflo(w0.w), bfhi(w0.w),
                   bflo(w1.x), bfhi(w1.x), bflo(w1.y), bfhi(w1.y), bflo(w1.z), bfhi(w1.z), bflo(w1.w), bfhi(w1.w)};
    if (!full) {
        float ss = 0.f;
#pragma unroll
        for (int i = 0; i < 16; ++i) ss += v[i] * v[i];
        ss += shx(ss, 1, lane); ss += shx(ss, 2, lane);
        const float r = 1.0f / sqrtf(ss * (1.f / 64.f) + NORM_EPS);
        const f32x4* gp = (const f32x4*)(g + q4 * 16);
#pragma unroll
        for (int c = 0; c < 4; ++c) { const f32x4 gg = gp[c]; v[4 * c] *= r * gg[0]; v[4 * c + 1] *= r * gg[1]; v[4 * c + 2] *= r * gg[2]; v[4 * c + 3] *= r * gg[3]; }
        if (q4 == 0) {
            const f32x4 c0 = *(const f32x4*)(cosP + s * 8), c1 = *(const f32x4*)(cosP + s * 8 + 4), s0 = *(const f32x4*)(sinP + s * 8), s1 = *(const f32x4*)(sinP + s * 8 + 4);
#pragma unroll
            for (int i = 0; i < 8; ++i) { const float c = i < 4 ? c0[i & 3] : c1[i & 3], sn = i < 4 ? s0[i & 3] : s1[i & 3], t1 = v[i], t2 = v[8 + i]; v[i] = t1 * c - t2 * sn; v[8 + i] = t2 * c + t1 * sn; }
        }
    } else {
        const int ib = (q4 & 1) * 16;
        const float sg = (q4 < 2) ? -1.0f : 1.0f;
#pragma unroll
        for (int c = 0; c < 4; ++c) { const f32x4 cc = *(const f32x4*)(cosR + s * 32 + ib + 4 * c), sn = *(const f32x4*)(sinR + s * 32 + ib + 4 * c);
#pragma unroll
            for (int j = 0; j < 4; ++j) { const float pv = shx(v[4 * c + j], 2, lane); v[4 * c + j] = v[4 * c + j] * cc[j] + sg * pv * sn[j]; } }
    }
    o0.x = pk2(v[0] * sc, v[1] * sc); o0.y = pk2(v[2] * sc, v[3] * sc); o0.z = pk2(v[4] * sc, v[5] * sc); o0.w = pk2(v[6] * sc, v[7] * sc);
    o1.x = pk2(v[8] * sc, v[9] * sc); o1.y = pk2(v[10] * sc, v[11] * sc); o1.z = pk2(v[12] * sc, v[13] * sc); o1.w = pk2(v[14] * sc, v[15] * sc);
}
__device__ __forceinline__ void phase_postproj(const Args& a, int l, int gtid, int NT, int lane) {
    bf16* proj = (bf16*)(a.ws + WS_PROJ);
    const float* rp = (const float*)(a.ws + WS_ROPE);
    const float* cosP = rp; const float* sinP = rp + SEQ * 8; const float* cosR = rp + SEQ * 16; const float* sinR = rp + SEQ * 16 + SEQ * 32;
    const int q4 = lane & 3, NQ = NT >> 2;
    for (int e0 = gtid >> 2; e0 < M * 36; e0 += 2 * NQ) {
        const int e1 = e0 + NQ; const bool has1 = e1 < M * 36;
        const int t0 = e0 / 36, hv0 = e0 % 36, t1 = has1 ? e1 / 36 : t0, hv1 = has1 ? e1 % 36 : hv0;
        int col0, full0, col1, full1; const float *g0, *g1; float sc0, sc1;
        pp_decode(a, l, hv0, col0, g0, full0, sc0); pp_decode(a, l, hv1, col1, g1, full1, sc1);
        u32x4* p0 = (u32x4*)(proj + (size_t)t0 * NINP + col0 + q4 * 16); u32x4* p1 = (u32x4*)(proj + (size_t)t1 * NINP + col1 + q4 * 16);
        const u32x4 a0 = p0[0], a1 = p0[1], b0 = p1[0], b1 = p1[1];
        u32x4 o0, o1;
        pp_compute(a0, a1, o0, o1, g0, full0, sc0, t0 & (SEQ - 1), q4, lane, cosP, sinP, cosR, sinR);
        p0[0] = o0; p0[1] = o1;
        if (has1) { pp_compute(b0, b1, o0, o1, g1, full1, sc1, t1 & (SEQ - 1), q4, lane, cosP, sinP, cosR, sinR); p1[0] = o0; p1[1] = o1; }
    }
}

__device__ __forceinline__ void vt_item(const bf16* proj, bf16* vt, int vcol0, int item, LAS unsigned char* scr, int lane) {
    const int kt = item & 31, h = (item >> 5) & 3, b = item >> 7;
    const bf16* src = proj + ((size_t)b * SEQ + kt * 64) * NINP + vcol0 + h * 128;
#pragma unroll 4
    for (int i = 0; i < 16; ++i) { const int row = 4 * i + (lane >> 4), ch = lane & 15;
        const u32x4 w = *(const u32x4*)(src + (size_t)row * NINP + ch * 8);
        *(LAS u32x4*)(scr + row * 272 + ch * 16) = w; }
    asm volatile("s_waitcnt lgkmcnt(0)" ::: "memory");
    const int c = lane & 7;
    bf16* dst = vt + ((size_t)(b * 4 + h) * 128) * SEQ + kt * 64 + c * 8;
#pragma unroll 4
    for (int i = 0; i < 16; ++i) { const int dv = 8 * i + (lane >> 3);
        unsigned short e[8];
#pragma unroll
        for (int j = 0; j < 8; ++j) e[j] = *(const LAS unsigned short*)(scr + kpos(8 * c + j) * 272 + dv * 2);
        u32x4 o; o.x = e[0] | ((unsigned)e[1] << 16); o.y = e[2] | ((unsigned)e[3] << 16); o.z = e[4] | ((unsigned)e[5] << 16); o.w = e[6] | ((unsigned)e[7] << 16);
        *(u32x4*)(dst + (size_t)dv * SEQ) = o; }
    asm volatile("s_waitcnt lgkmcnt(0)" ::: "memory");
}

__device__ __forceinline__ void attn_a_item(const Args& a, int item, LAS unsigned char* wlds, int lane, float M2) {
    const bf16* proj = (const bf16*)(a.ws + WS_PROJ);
    bf16* ya = (bf16*)(a.ws + WS_YA); float* lA = (float*)(a.ws + WS_LA);
    const int r = lane & 31, hh = lane >> 5;
    const int g = item >> 10; int rem = item & 1023;
    const int qhalf = rem & 1; rem >>= 1;
    const int dsh = 2 * g, dil = 1 << dsh, nbs = 5 - dsh, L = SEQ >> dsh;
    const int n = rem & ((1 << nbs) - 1); rem >>= nbs;
    const int rsd = rem & (dil - 1); rem >>= dsh;
    const int hg = rem & 1; const int b = rem >> 1;
    const int head = 2 * g + hg;
    const int iq = 64 * n + 32 * qhalf + r;
    const size_t tq = (size_t)b * SEQ + (size_t)dil * iq + rsd;
    bf16x8 qf[4];
#pragma unroll
    for (int kk = 0; kk < 4; ++kk) qf[kk] = *(const bf16x8*)(proj + tq * NINP + C_AQ + head * 64 + 16 * kk + 8 * hh);
    f32x16 O0, O1;
#pragma unroll
    for (int i = 0; i < 16; ++i) { O0[i] = 0.f; O1[i] = 0.f; }
    float lsum = 0.f;
    const int j0 = 64 * n + 32 * qhalf - 64;
    const int lkey = lane >> 3, lch = lane & 7;
    u32x4 kb_[2][4], vb_[2][4];
    {
#pragma unroll
      for (int i = 0; i < 4; ++i) { int jr = j0 + lkey + 8 * i; jr = jr < 0 ? 0 : (jr >= L ? L - 1 : jr); const size_t tk = (size_t)b * SEQ + (size_t)dil * jr + rsd;
        kb_[0][i] = *(const u32x4*)(proj + tk * NINP + C_AK + head * 64 + lch * 8); vb_[0][i] = *(const u32x4*)(proj + tk * NINP + C_AV + head * 64 + lch * 8); } }
    LAS unsigned char* kl = wlds + 5120;
#pragma unroll
    for (int sb = 0; sb < 5; ++sb) {
        const int jb = j0 + 32 * sb;
        if (sb + 1 < 5) {
#pragma unroll
            for (int i = 0; i < 4; ++i) { int jr = jb + 32 + lkey + 8 * i; jr = jr < 0 ? 0 : (jr >= L ? L - 1 : jr); const size_t tk = (size_t)b * SEQ + (size_t)dil * jr + rsd;
                kb_[(sb + 1) & 1][i] = *(const u32x4*)(proj + tk * NINP + C_AK + head * 64 + lch * 8); vb_[(sb + 1) & 1][i] = *(const u32x4*)(proj + tk * NINP + C_AV + head * 64 + lch * 8); } }
        if (jb < 0 || jb >= L) continue;
#pragma unroll
        for (int i = 0; i < 4; ++i) { const int key = lkey + 8 * i;
            *(LAS u32x4*)(kl + key * 144 + lch * 16) = kb_[sb & 1][i];
            const u32x4 vv = vb_[sb & 1][i]; const unsigned ww[4] = {vv.x, vv.y, vv.z, vv.w};
            LAS bf16* w = (LAS bf16*)(wlds + (lch * 8) * 80 + kpos(key) * 2);
#pragma unroll
            for (int j = 0; j < 4; ++j) { w[(2 * j) * 40] = (bf16)(ww[j] & 0xffffu); w[(2 * j + 1) * 40] = (bf16)(ww[j] >> 16); } }
        asm volatile("s_waitcnt lgkmcnt(0)" ::: "memory");
        f32x16 acc;
#pragma unroll
        for (int i = 0; i < 16; ++i) acc[i] = -M2;
#pragma unroll
        for (int kk = 0; kk < 4; ++kk) { const bf16x8 kf = *(const LAS bf16x8*)(kl + r * 144 + (16 * kk + 8 * hh) * 2); acc = MFMA32(kf, qf[kk], acc); }
        float p[16];
#pragma unroll
        for (int i = 0; i < 16; ++i) { const int j = jb + (i & 3) + 8 * (i >> 2) + 4 * hh; const int d = iq - j;
            const float e = __builtin_amdgcn_exp2f(acc[i]); p[i] = (d <= 64 && d >= -64) ? e : 0.f; lsum += p[i]; }
        const bf16x8 pf0 = pack8(p[0], p[1], p[2], p[3], p[4], p[5], p[6], p[7]);
        const bf16x8 pf1 = pack8(p[8], p[9], p[10], p[11], p[12], p[13], p[14], p[15]);
        const bf16x8 v00 = *(const LAS bf16x8*)(wlds + r * 80 + (8 * hh) * 2);
        const bf16x8 v01 = *(const LAS bf16x8*)(wlds + r * 80 + (16 + 8 * hh) * 2);
        const bf16x8 v10 = *(const LAS bf16x8*)(wlds + (32 + r) * 80 + (8 * hh) * 2);
        const bf16x8 v11 = *(const LAS bf16x8*)(wlds + (32 + r) * 80 + (16 + 8 * hh) * 2);
        O0 = MFMA32(v00, pf0, O0); O0 = MFMA32(v01, pf1, O0);
        O1 = MFMA32(v10, pf0, O1); O1 = MFMA32(v11, pf1, O1);
        asm volatile("s_waitcnt lgkmcnt(0)" ::: "memory");
    }
    const float l = lsum + shx(lsum, 32, lane);
    bf16* op = ya + tq * 384 + head * 64 + 4 * hh;
#pragma unroll
    for (int q = 0; q < 4; ++q) {
        u32x2 w0; w0.x = pk2(O0[4 * q], O0[4 * q + 1]); w0.y = pk2(O0[4 * q + 2], O0[4 * q + 3]); *(u32x2*)(op + 8 * q) = w0;
        u32x2 w1; w1.x = pk2(O1[4 * q], O1[4 * q + 1]); w1.y = pk2(O1[4 * q + 2], O1[4 * q + 3]); *(u32x2*)(op + 32 + 8 * q) = w1;
    }
    if (hh == 0) lA[tq * 6 + head] = l;
}

constexpr int AT_KOFF = 9216, AT_VT = 18432, AT_STAGE = 36864;
constexpr size_t WS_RST = 380 * MiB;
__device__ __forceinline__ void ret_state_item(const Args& a, int l, int item, LAS unsigned char* lds) {
    const bf16* proj = (const bf16*)(a.ws + WS_PROJ);
    const int tid = otid(), wid = __builtin_amdgcn_readfirstlane(tid >> 6), lane = tid & 63, r = lane & 31, hh = lane >> 5;
    const int j = item & 7, h = (item >> 3) & 3, b = item >> 5;
    const float lgf2 = -__expf(a.in[12][l * 4 + h]) * LOG2E, lgb2 = -__expf(a.in[13][l * 4 + h]) * LOG2E;
    const int dir = wid >> 2, db = (wid >> 1) & 1, dvp = wid & 1;
    const bf16* kg = proj + ((size_t)b * SEQ + j * 256 + (tid >> 3)) * NINP + C_CK + h * 64 + (tid & 7) * 8;
    const bf16* vg = (const bf16*)(a.ws + WS_VTC) + ((size_t)(b * 4 + h) * 128 + (tid >> 3)) * SEQ + j * 256 + (tid & 7) * 8;
    f32x16 acc0, acc1;
#pragma unroll
    for (int i = 0; i < 16; ++i) { acc0[i] = 0.f; acc1[i] = 0.f; }
    for (int t = 0; t < 4; ++t) {
        const u32x4 kw = *(const u32x4*)(kg + (size_t)t * 64 * NINP);
        const u32x4 v0 = *(const u32x4*)(vg + t * 64), v1 = *(const u32x4*)(vg + t * 64 + 64 * SEQ);
        const int key = tid >> 3, ch = tid & 7, pos = t * 64 + key;
        const float wf = __builtin_amdgcn_exp2f(lgf2 * (float)(256 - pos)), wb = __builtin_amdgcn_exp2f(lgb2 * (float)pos);
        const float kv[8] = {bflo(kw.x), bfhi(kw.x), bflo(kw.y), bfhi(kw.y), bflo(kw.z), bfhi(kw.z), bflo(kw.w), bfhi(kw.w)};
        LAS bf16* ktf = (LAS bf16*)(lds + (ch * 8) * 144 + kpos(key) * 2);
        LAS bf16* ktb = (LAS bf16*)(lds + 9216 + (ch * 8) * 144 + kpos(key) * 2);
#pragma unroll
        for (int e = 0; e < 8; e += 2) { const unsigned pf = pk2(kv[e] * wf, kv[e + 1] * wf), pb = pk2(kv[e] * wb, kv[e + 1] * wb);
            ktf[e * 72] = (bf16)(pf & 0xffffu); ktf[(e + 1) * 72] = (bf16)(pf >> 16); ktb[e * 72] = (bf16)(pb & 0xffffu); ktb[(e + 1) * 72] = (bf16)(pb >> 16); }
        *(LAS u32x4*)(lds + AT_VT + (tid >> 3) * 144 + (tid & 7) * 16) = v0;
        *(LAS u32x4*)(lds + AT_VT + ((tid >> 3) + 64) * 144 + (tid & 7) * 16) = v1;
        __syncthreads();
        LAS unsigned char* abase = lds + dir * 9216 + (32 * db + r) * 144 + (8 * hh) * 2;
        LAS unsigned char* bbase = lds + AT_VT + (64 * dvp + r) * 144 + (8 * hh) * 2;
#pragma unroll
        for (int ks = 0; ks < 4; ++ks) { const bf16x8 af = *(const LAS bf16x8*)(abase + 32 * ks);
            const bf16x8 b0 = *(const LAS bf16x8*)(bbase + 32 * ks), b1 = *(const LAS bf16x8*)(bbase + 32 * 144 + 32 * ks);
            acc0 = MFMA32(af, b0, acc0); acc1 = MFMA32(af, b1, acc1); }
        __syncthreads();
    }
    float* F = (float*)(a.ws + WS_RST) + ((size_t)(dir * 256 + item) * 64 + 32 * db + 4 * hh) * 128 + 64 * dvp + r;
#pragma unroll
    for (int i = 0; i < 16; ++i) { const int drow = (i & 3) + 8 * (i >> 2); F[drow * 128] = acc0[i]; F[drow * 128 + 32] = acc1[i]; }
}

template <int MODE>
__device__ __forceinline__ void attn_dense_unit(const Args& a, int l, int unit, LAS unsigned char* lds, float M2, float lam, float oscale) {
    const bf16* proj = (const bf16*)(a.ws + WS_PROJ);
    const int tid = otid(), wid = __builtin_amdgcn_readfirstlane(tid >> 6), lane = tid & 63, r = lane & 31, hh = lane >> 5;
    constexpr int QROWS = MODE == 0 ? 128 : 256;
    const int g = MODE == 0 ? (wid >> 1) : wid, m = MODE == 0 ? (wid & 1) : 0;
    const int qb = MODE == 0 ? (unit & 15) : (unit & 7), h = MODE == 0 ? ((unit >> 4) & 3) : ((unit >> 3) & 3), b = MODE == 0 ? (unit >> 6) : (unit >> 5);
    const int qcol = MODE == 0 ? C_BQ + (h * 2 + m) * 64 : C_CQ + h * 64;
    const int kcol = MODE == 0 ? C_BK + h * 128 : C_CK + h * 64;
    const size_t rowbase = (size_t)b * SEQ;
    const int nq = qb * QROWS + g * 32 + r;
    bf16x8 qf[4];
#pragma unroll
    for (int kk = 0; kk < 4; ++kk) qf[kk] = *(const bf16x8*)(proj + (rowbase + nq) * NINP + qcol + 16 * kk + 8 * hh);
    float lgf2 = 0.f, lgb2n = 0.f;
    float c1f[4] = {0.f, 0.f, 0.f, 0.f}, c2f[4] = {0.f, 0.f, 0.f, 0.f}, c1b[4] = {0.f, 0.f, 0.f, 0.f}, c2b[4] = {0.f, 0.f, 0.f, 0.f};
    if (MODE == 1) { lgf2 = -__expf(a.in[12][l * 4 + h]) * LOG2E; lgb2n = __expf(a.in[13][l * 4 + h]) * LOG2E;
#pragma unroll
        for (int q = 0; q < 4; ++q) { c1f[q] = __builtin_amdgcn_exp2f(lgf2 * (float)(3 - q)); c2f[q] = __builtin_amdgcn_exp2f(lgf2 * (float)(28 - 4 * hh - 8 * q));
                                      c1b[q] = __builtin_amdgcn_exp2f(-lgb2n * (float)q); c2b[q] = __builtin_amdgcn_exp2f(-lgb2n * (float)(4 * hh + 8 * q)); } }
    f32x16 O[4];
#pragma unroll
    for (int d = 0; d < 4; ++d)
#pragma unroll
        for (int i = 0; i < 16; ++i) O[d][i] = 0.f;
    float lsum = 0.f;
    if constexpr (MODE == 1) {
        const float* Fb_ = (const float*)(a.ws + WS_RST) + (size_t)((b * 4 + h) * 8) * 8192;
        const float cf = __builtin_amdgcn_exp2f(lgf2 * 256.0f), cb = __builtin_amdgcn_exp2f(-lgb2n * 256.0f);
#pragma unroll
        for (int e = 0; e < 4; ++e) { const int idx = tid + 512 * e, d = idx >> 5, dv4 = (idx & 31) * 4;
            f32x4 sf = {0.f, 0.f, 0.f, 0.f}, sb = {0.f, 0.f, 0.f, 0.f}; float w = 1.0f;
            for (int j = qb - 1; j >= 0; --j) { const f32x4 v = *(const f32x4*)(Fb_ + (size_t)j * 8192 + d * 128 + dv4); sf += v * w; w *= cf; }
            w = 1.0f;
            for (int j = qb + 1; j < 8; ++j) { const f32x4 v = *(const f32x4*)(Fb_ + (size_t)(256 + j) * 8192 + d * 128 + dv4); sb += v * w; w *= cb; }
#pragma unroll
            for (int q = 0; q < 4; ++q) { *(LAS bf16*)(lds + 73728 + (dv4 + q) * 144 + d * 2) = (bf16)(pk2(sf[q], 0.f) & 0xffffu); *(LAS bf16*)(lds + 92160 + (dv4 + q) * 144 + d * 2) = (bf16)(pk2(sb[q], 0.f) & 0xffffu); } }
        __syncthreads();
        const float wqf = __builtin_amdgcn_exp2f(lgf2 * (float)(g * 32 + r)), wqb = __builtin_amdgcn_exp2f(-lgb2n * (float)(256 - (g * 32 + r)));
#pragma unroll
        for (int d = 0; d < 4; ++d) { f32x16 of = O[d], ob = O[d];
#pragma unroll
            for (int kk = 0; kk < 4; ++kk) { const bf16x8 af = *(const LAS bf16x8*)(lds + 73728 + (32 * d + r) * 144 + (16 * kk + 8 * hh) * 2);
                const bf16x8 ab = *(const LAS bf16x8*)(lds + 92160 + (32 * d + r) * 144 + (16 * kk + 8 * hh) * 2);
                of = MFMA32(af, qf[kk], of); ob = MFMA32(ab, qf[kk], ob); }
#pragma unroll
            for (int i = 0; i < 16; ++i) O[d][i] = of[i] * wqf + ob[i] * wqb; }
    }
    const int lk_key = tid >> 3, lk_ch = tid & 7;
    const bf16* kg = proj + (rowbase + lk_key) * NINP + kcol + lk_ch * 8;
    const bf16* vg = (const bf16*)(a.ws + (MODE == 0 ? WS_VTB : WS_VTC)) + ((size_t)(b * 4 + h) * 128 + (tid >> 3)) * SEQ + (tid & 7) * 8;
    u32x4 kr0, kr1, vr0, vr1;
    constexpr int NTALL = SEQ / 64, NT = MODE == 0 ? NTALL : 4;
    const int kt0 = ((QROWS / 64) * qb) & (NTALL - 1);
    { const size_t o = (size_t)kt0 * 64 * NINP;
      kr0 = *(const u32x4*)(kg + o); if (MODE == 0) kr1 = *(const u32x4*)(kg + o + 64);
      vr0 = *(const u32x4*)(vg + kt0 * 64); vr1 = *(const u32x4*)(vg + kt0 * 64 + 64 * SEQ); }
    for (int it = 0; it < NT; ++it) {
        const int kt = (it + kt0) & (NTALL - 1);
        LAS unsigned char* st = lds + (it & 1) * AT_STAGE;
        *(LAS u32x4*)(st + lk_key * 144 + lk_ch * 16) = kr0;
        if (MODE == 0) *(LAS u32x4*)(st + AT_KOFF + lk_key * 144 + lk_ch * 16) = kr1;
        *(LAS u32x4*)(st + AT_VT + lk_key * 144 + lk_ch * 16) = vr0;
        *(LAS u32x4*)(st + AT_VT + (lk_key + 64) * 144 + lk_ch * 16) = vr1;
        __syncthreads();
        if (it + 1 < NT) {
            const int kn = (kt + 1) & (NTALL - 1);
            const size_t o = (size_t)kn * 64 * NINP;
            kr0 = *(const u32x4*)(kg + o); if (MODE == 0) kr1 = *(const u32x4*)(kg + o + 64);
            vr0 = *(const u32x4*)(vg + kn * 64); vr1 = *(const u32x4*)(vg + kn * 64 + 64 * SEQ);
        }
#define SCORE_TO_P(acc, kb, p) do { \
            if (MODE == 0) { _Pragma("unroll") for (int i = 0; i < 16; ++i) { p[i] = __builtin_amdgcn_exp2f(acc[i]); lsum += p[i]; } } \
            else { const int mk0 = kt * 64 + 32 * (kb), q0w = qb * QROWS + g * 32; \
                if (mk0 + 31 < q0w) { const float A_ = __builtin_amdgcn_exp2f(lgf2 * (float)(nq - mk0 - 31)); float c2_[4]; \
                    _Pragma("unroll") for (int bq = 0; bq < 4; ++bq) c2_[bq] = A_ * c2f[bq]; \
                    _Pragma("unroll") for (int i = 0; i < 16; ++i) p[i] = acc[i] * (c2_[i >> 2] * c1f[i & 3]); } \
                else if (mk0 > q0w + 31) { const float A_ = __builtin_amdgcn_exp2f(-lgb2n * (float)(mk0 - nq)); float c2_[4]; \
                    _Pragma("unroll") for (int bq = 0; bq < 4; ++bq) c2_[bq] = A_ * c2b[bq]; \
                    _Pragma("unroll") for (int i = 0; i < 16; ++i) p[i] = acc[i] * (c2_[i >> 2] * c1b[i & 3]); } \
                else { const int dbase_ = nq - (mk0 + 4 * hh); \
                    _Pragma("unroll") for (int i = 0; i < 16; ++i) { const int d_ = dbase_ - ((i & 3) + 8 * (i >> 2)); const float df_ = (float)d_; \
                        const float e_ = df_ * (d_ > 0 ? lgf2 : lgb2n); float D_ = __builtin_amdgcn_exp2f(e_); D_ = (d_ == 0) ? 2.0f : D_; p[i] = acc[i] * D_; } } } } while (0)
        {
            LAS unsigned char* kbase = st + (MODE == 0 ? m * AT_KOFF : 0) + r * 144 + (8 * hh) * 2;
            LAS unsigned char* vbase = st + AT_VT + r * 144 + (8 * hh) * 2;
            bf16x8 kf0[4], kf1[4], vf[8];
#pragma unroll
            for (int kk = 0; kk < 4; ++kk) kf0[kk] = *(const LAS bf16x8*)(kbase + 32 * kk);
#pragma unroll
            for (int kk = 0; kk < 4; ++kk) kf1[kk] = *(const LAS bf16x8*)(kbase + 32 * 144 + 32 * kk);
#pragma unroll
            for (int dvb = 0; dvb < 4; ++dvb) { vf[2 * dvb] = *(const LAS bf16x8*)(vbase + dvb * 32 * 144); vf[2 * dvb + 1] = *(const LAS bf16x8*)(vbase + dvb * 32 * 144 + 32); }
            __builtin_amdgcn_sched_barrier(0);
            f32x16 acc0, acc1;
#pragma unroll
            for (int i = 0; i < 16; ++i) { acc0[i] = MODE == 0 ? -M2 : 0.f; acc1[i] = MODE == 0 ? -M2 : 0.f; }
#pragma unroll
            for (int kk = 0; kk < 4; ++kk) acc0 = MFMA32(kf0[kk], qf[kk], acc0);
#pragma unroll
            for (int kk = 0; kk < 4; ++kk) acc1 = MFMA32(kf1[kk], qf[kk], acc1);
            __builtin_amdgcn_sched_barrier(0);
            float p[16];
            SCORE_TO_P(acc0, 0, p);
            const bf16x8 pf00 = pack8(p[0], p[1], p[2], p[3], p[4], p[5], p[6], p[7]);
            const bf16x8 pf01 = pack8(p[8], p[9], p[10], p[11], p[12], p[13], p[14], p[15]);
            __builtin_amdgcn_sched_barrier(0);
#pragma unroll
            for (int dvb = 0; dvb < 4; ++dvb) O[dvb] = MFMA32(vf[2 * dvb], pf00, O[dvb]);
#pragma unroll
            for (int dvb = 0; dvb < 4; ++dvb) O[dvb] = MFMA32(vf[2 * dvb + 1], pf01, O[dvb]);
#pragma unroll
            for (int dvb = 0; dvb < 4; ++dvb) { vf[2 * dvb] = *(const LAS bf16x8*)(vbase + 64 + dvb * 32 * 144); vf[2 * dvb + 1] = *(const LAS bf16x8*)(vbase + 64 + dvb * 32 * 144 + 32); }
            SCORE_TO_P(acc1, 1, p);
            const bf16x8 pf10 = pack8(p[0], p[1], p[2], p[3], p[4], p[5], p[6], p[7]);
            const bf16x8 pf11 = pack8(p[8], p[9], p[10], p[11], p[12], p[13], p[14], p[15]);
            __builtin_amdgcn_sched_barrier(0);
#pragma unroll
            for (int dvb = 0; dvb < 4; ++dvb) O[dvb] = MFMA32(vf[2 * dvb], pf10, O[dvb]);
#pragma unroll
            for (int dvb = 0; dvb < 4; ++dvb) O[dvb] = MFMA32(vf[2 * dvb + 1], pf11, O[dvb]);
        }
#undef SCORE_TO_P
    }
    __syncthreads();
    if (MODE == 0) { const float linv = 1.0f / (lsum + shx(lsum, 32, lane));
#pragma unroll
        for (int d = 0; d < 4; ++d)
#pragma unroll
            for (int i = 0; i < 16; ++i) O[d][i] *= linv; }
    LAS float* ex = (LAS float*)(lds + g * 16384) + lane;
    if (MODE == 0 && m == 1) {
#pragma unroll
        for (int d = 0; d < 4; ++d)
#pragma unroll
            for (int i = 0; i < 16; ++i) ex[(d * 16 + i) * 64] = O[d][i];
    }
    __syncthreads();
    if (m == 0) {
        float ss = 0.f;
#pragma unroll
        for (int d = 0; d < 4; ++d)
#pragma unroll
            for (int i = 0; i < 16; ++i) { float o = O[d][i]; if (MODE == 0) { o -= lam * ex[(d * 16 + i) * 64]; O[d][i] = o; } ss += o * o; }
        ss += shx(ss, 32, lane);
        const float rr = (1.0f / sqrtf(ss * (1.f / 128.f) + NORM_EPS)) * oscale;
        const float* gout = MODE == 0 ? a.in[11] + l * 128 : a.in[14] + l * 128;
        const size_t trow = rowbase + nq;
        bf16* yo = (bf16*)(a.ws + (MODE == 0 ? WS_YB : WS_YC)) + trow * 512 + h * 128 + 4 * hh;
        const bf16* cg = proj + trow * NINP + C_CG + h * 128 + 4 * hh;
#pragma unroll
        for (int d = 0; d < 4; ++d)
#pragma unroll
            for (int q = 0; q < 4; ++q) {
                const int dv = 32 * d + 8 * q;
                const f32x4 gg = *(const f32x4*)(gout + dv + 4 * hh);
                float y0 = O[d][4 * q] * rr * gg.x, y1 = O[d][4 * q + 1] * rr * gg.y, y2 = O[d][4 * q + 2] * rr * gg.z, y3 = O[d][4 * q + 3] * rr * gg.w;
                if (MODE == 1) { const u32x2 cw = *(const u32x2*)(cg + dv);
                    const float c0 = bflo(cw.x), c1 = bfhi(cw.x), c2 = bflo(cw.y), c3 = bfhi(cw.y);
                    y0 *= c0 / (1.0f + __expf(-c0)); y1 *= c1 / (1.0f + __expf(-c1)); y2 *= c2 / (1.0f + __expf(-c2)); y3 *= c3 / (1.0f + __expf(-c3)); }
                u32x2 w; w.x = pk2(y0, y1); w.y = pk2(y2, y3); *(u32x2*)(yo + dv) = w;
            }
    }
    __syncthreads();
}

#ifndef PHM
#define PHM 0xFFFF
#endif
#ifndef DBL
#define DBL 0
#endif
#define REP(k) for (int rep_ = 0; rep_ < (((DBL >> (k)) & 1) ? 2 : 1); ++rep_)
#define PH(k) if constexpr ((PHM >> (k)) & 1)
#define XB_TMO      128
#define XB_XCNT(j)  (256  + 64 * (j))
#define XB_XSUB(j)  (1280 + 64 * (j))
#define XB_XGEN(j)  (2304 + 64 * (j))
#define XB_TOP      3328
#define XB_TOPGEN   3392
#define XCD_BAR_WORDS 3456
#define XB_SPIN_CAP (1u << 18)

__device__ __forceinline__ unsigned xb_ld(unsigned* p)              { return __hip_atomic_load(p, __ATOMIC_RELAXED, __HIP_MEMORY_SCOPE_AGENT); }
__device__ __forceinline__ unsigned xb_add(unsigned* p, unsigned v) { return __hip_atomic_fetch_add(p, v, __ATOMIC_RELAXED, __HIP_MEMORY_SCOPE_AGENT); }
__device__ __forceinline__ unsigned xb_xcc_id() { return (unsigned)__builtin_amdgcn_s_getreg((3 << 11) | 20) & 0xFu; }
#define XB_SPIN(cond, bar) do { unsigned _sp = 0; while (cond) { __builtin_amdgcn_s_sleep(1); \
    if ((++_sp & 255u) == 0u) { if (xb_ld(&(bar)[XB_TMO])) break; if (_sp > XB_SPIN_CAP) { atomicAdd(&(bar)[XB_TMO], 1u); break; } } } } while (0)

struct XcdBarrier {
    unsigned* bar; unsigned x;
    volatile LAS unsigned* st;
};

__device__ __forceinline__ XcdBarrier xcd_barrier_post(unsigned* bar, volatile LAS unsigned* st) {
    XcdBarrier b; b.bar = bar; b.x = xb_xcc_id(); b.st = st;
    if (threadIdx.x == 0) (void)xb_add(&bar[XB_XCNT(b.x)], 1u);
    return b;
}
__device__ __forceinline__ void xcd_barrier_complete(unsigned* bar, unsigned x, unsigned& nloc, unsigned& nx) {
    const unsigned G = gridDim.x * gridDim.y * gridDim.z;
    unsigned sum, cnt, mine, sp = 0u;
    for (;;) {
        sum = 0u; cnt = 0u; mine = 0u;
#pragma unroll
        for (unsigned j = 0; j < 16; ++j) { const unsigned c = xb_ld(&bar[XB_XCNT(j)]); sum += c; cnt += (c > 0u) ? 1u : 0u; mine = (j == x) ? c : mine; }
        if (sum == G) break;
        __builtin_amdgcn_s_sleep(1);
        if ((++sp & 255u) == 0u) { if (xb_ld(&bar[XB_TMO])) break; if (sp > XB_SPIN_CAP) { atomicAdd(&bar[XB_TMO], 1u); break; } }
    }
    nloc = mine > 0u ? mine : 1u; nx = cnt > 0u ? cnt : 1u;
}

__device__ __forceinline__ void xcd_barrier(const XcdBarrier& b) {
    asm volatile("s_waitcnt vmcnt(0)" ::: "memory");
    __syncthreads();
    if (threadIdx.x == 0) {
        unsigned* bar = b.bar;
        __builtin_amdgcn_s_waitcnt(0);
        unsigned nloc = b.st[0], nx = b.st[1];
        if (nloc == 0u) { xcd_barrier_complete(bar, b.x, nloc, nx); b.st[0] = nloc; b.st[1] = nx; }
        const unsigned old = xb_add(&bar[XB_XSUB(b.x)], 1u);
        const unsigned gen = old / nloc;
        if (old + 1u == (gen + 1u) * nloc) {
            __builtin_amdgcn_fence(__ATOMIC_RELEASE, "agent");
            asm volatile("s_waitcnt vmcnt(0)" ::: "memory");
            const unsigned og = xb_add(&bar[XB_TOP], 1u);
            const unsigned tg = og / nx;
            if (og + 1u == (tg + 1u) * nx) xb_add(&bar[XB_TOPGEN], 1u);
            else XB_SPIN(xb_ld(&bar[XB_TOPGEN]) == tg, bar);
            __builtin_amdgcn_fence(__ATOMIC_ACQUIRE, "agent");
            xb_add(&bar[XB_XGEN(b.x)], 1u);
            asm volatile("s_waitcnt vmcnt(0)" ::: "memory");
        } else {
            XB_SPIN(xb_ld(&bar[XB_XGEN(b.x)]) == gen, bar);
            __builtin_amdgcn_fence(__ATOMIC_ACQUIRE, "agent");
            asm volatile("s_waitcnt vmcnt(0)" ::: "memory");
        }
    }
    __syncthreads();
}

typedef __attribute__((address_space(4))) const Args* CArgsP;
__device__ __forceinline__ Args load_args() {
    Args r{};
#if defined(__HIP_DEVICE_COMPILE__)
    CArgsP p = (CArgsP)__builtin_amdgcn_kernarg_segment_ptr(); asm volatile("" : "+s"(p));
#pragma unroll
    for (int i = 0; i < 22; ++i) r.in[i] = p->in[i];
    r.out = p->out; r.ws = p->ws;
#endif
    return r;
}
#define TIDS() const int tid = otid(), lane = tid & 63, wave = __builtin_amdgcn_readfirstlane(tid >> 6), gw = bx * NWAVES + wave, gtid = bx * NTHR + tid; (void)lane; (void)gw; (void)gtid
__global__ void __launch_bounds__(NTHR, 2) fwd_megakernel(Args a_unused) {
    extern __shared__ __attribute__((aligned(16))) unsigned char lds_raw[];
    LAS unsigned char* lds = (LAS unsigned char*)lds_raw;
    cg::grid_group grid = cg::this_grid();
    const int G = gridDim.x, bx = blockIdx.x;
    const int NGW = G * NWAVES, NT = G * NTHR;
    if (threadIdx.x < 2) ((volatile LAS unsigned*)(lds + MISC_OFF))[threadIdx.x] = 0u;
    __syncthreads();
    { const Args a = load_args(); (void)xcd_barrier_post((unsigned*)(a.ws + WS_CTL), (volatile LAS unsigned*)(lds + MISC_OFF)); }
#define GSYNC() do { const Args a_ = load_args(); XcdBarrier b_; b_.bar = (unsigned*)(a_.ws + WS_CTL); b_.x = xb_xcc_id(); b_.st = (volatile LAS unsigned*)(lds + MISC_OFF); xcd_barrier(b_); } while (0)

    for (int l = 0; l < DEPTH; ++l) {
        PH(0) REP(0) { const Args a = load_args(); TIDS(); phase_prep(a, l, lds, gw, NGW, wave, lane, (l == 0) ? a.in[0] : a.out); }
        { const Args a_ = load_args(); if (a_.ws == nullptr) grid.sync(); }
        GSYNC();
        if constexpr ((DBL >> 8) & 1) { for (int i_ = 0; i_ < 10; ++i_) GSYNC(); }
        PH(1) REP(1) { const Args a = load_args(); unsigned char* ws = a.ws;
          pg8::Gemm g{(const bf16*)(ws + WS_ACT), (const bf16*)(ws + WS_WIN), M, NINP, DM}; pg8::StaticOrder S; S.init(M, NINP, G, bx);
          pg8::EpiStore<0> E{(bf16*)(ws + WS_PROJ), NINP};
          pg8::gemm_phase<pg8::EpiStore<0>, pg8::StaticOrder, true, true>(lds, g, S, E); }
        GSYNC();
        PH(2) { const Args a = load_args(); TIDS(); phase_postproj(a, l, gtid, NT, lane);
                for (int it = gw; it < 2048; it += NGW) { const int c = it >> 10;
                    vt_item((const bf16*)(a.ws + WS_PROJ), (bf16*)(a.ws + (c ? WS_VTC : WS_VTB)), c ? C_CV : C_BV, it & 1023, lds + wave * 17408, lane); } }
        GSYNC();
        {
            const Args a = load_args(); TIDS();
            PH(5) { if (G == 256) { if (bx >= 128) for (int it = bx - 128; it < 256; it += 128) ret_state_item(a, l, it, lds); }
                    else for (int it = bx; it < 256; it += G) ret_state_item(a, l, it, lds); }
            PH(3) {
            const float gqa = wave_max(fabsf(a.in[3][l * 64 + lane]), lane), gka = wave_max(fabsf(a.in[4][l * 64 + lane]), lane);
            const float M2a = 8.0f * LOG2E * gqa * gka;
            REP(2) for (int it = gw; it < 3072; it += NGW) attn_a_item(a, it, lds + wave * 16384, lane, M2a);
            }
            __syncthreads();
            PH(4) {
            const float gqb = wave_max(fabsf(a.in[5][l * 64 + lane]), lane), gkb = wave_max(fabsf(a.in[6][l * 64 + lane]), lane);
            const float M2b = 8.0f * LOG2E * gqb * gkb;
            const float lam_init = 0.8f - 0.6f * expf(-0.3f * (float)l);
            const float s1 = wave_sum(a.in[7][l * 64 + lane] * a.in[8][l * 64 + lane], lane), s2 = wave_sum(a.in[9][l * 64 + lane] * a.in[10][l * 64 + lane], lane);
            const float lam = expf(s1) - expf(s2) + lam_init;
            REP(3) for (int u0 = bx; u0 < 512; u0 += G) { const int v = u0 & 255, u = (((v & 7) * 2 + (v >> 7)) + 16 * (u0 >> 8)) * 16 + ((v >> 3) & 15); attn_dense_unit<0>(a, l, u, lds, M2b, lam, 1.0f - lam_init); }
            }
        }
        GSYNC();
        {
            const Args a = load_args(); TIDS();
            PH(5) REP(4) for (int u0 = bx; u0 < 256; u0 += G) { const int u = ((u0 & 7) * 4 + (u0 >> 6)) * 8 + ((u0 >> 3) & 7); attn_dense_unit<1>(a, l, u, lds, 0.f, 0.f, 1.0f); }
            const float* lA = (const float*)(a.ws + WS_LA); bf16* ya = (bf16*)(a.ws + WS_YA);
            for (int e0 = gtid; e0 < M * 48; e0 += 3 * NT) {
                u32x4 w[3]; float lt[3]; u32x4* pp[3];
#pragma unroll
                for (int q = 0; q < 3; ++q) { int e = e0 + q * NT; e = e < M * 48 ? e : e0; const int t = e / 48, ch = e % 48, hg = (ch >> 3) & 1;
                    lt[q] = lA[t * 6 + hg] + lA[t * 6 + 2 + hg] + lA[t * 6 + 4 + hg]; pp[q] = (u32x4*)(ya + (size_t)t * 384 + ch * 8); w[q] = *pp[q]; }
#pragma unroll
                for (int q = 0; q < 3; ++q) { const float li = 1.0f / lt[q]; u32x4 v = w[q];
                    v.x = pk2(bflo(v.x) * li, bfhi(v.x) * li); v.y = pk2(bflo(v.y) * li, bfhi(v.y) * li);
                    v.z = pk2(bflo(v.z) * li, bfhi(v.z) * li); v.w = pk2(bflo(v.w) * li, bfhi(v.w) * li); *pp[q] = v; }
            }
        }
        GSYNC();
        PH(6) {
          { const Args a = load_args(); unsigned char* ws = a.ws; pg8::StaticOrder S; S.init(M, DM, G, bx);
            pg8::Gemm g{(const bf16*)(ws + WS_YA), (const bf16*)(ws + WS_WBRA), M, DM, 384}; pg8::EpiGate<0> E{(const bf16*)(ws + WS_PROJ) + C_GATE, NINP, nullptr, (bf16*)(ws + WS_T1)};
            pg8::gemm_phase<pg8::EpiGate<0>, pg8::StaticOrder, true, true>(lds, g, S, E); }
          { const Args a = load_args(); unsigned char* ws = a.ws; pg8::StaticOrder S; S.init(M, DM, G, bx);
            pg8::Gemm g{(const bf16*)(ws + WS_YB), (const bf16*)(ws + WS_WBRB), M, DM, 512}; pg8::EpiGate<1> E{(const bf16*)(ws + WS_PROJ) + C_GATE + 1024, NINP, (const bf16*)(ws + WS_T1), (bf16*)(ws + WS_T2)};
            pg8::gemm_phase<pg8::EpiGate<1>, pg8::StaticOrder, true, true>(lds, g, S, E); }
          { const Args a = load_args(); unsigned char* ws = a.ws; pg8::StaticOrder S; S.init(M, DM, G, bx);
            pg8::Gemm g{(const bf16*)(ws + WS_YC), (const bf16*)(ws + WS_WBRC), M, DM, 512}; pg8::EpiGate<1> E{(const bf16*)(ws + WS_PROJ) + C_GATE + 2048, NINP, (const bf16*)(ws + WS_T2), (bf16*)(ws + WS_ACT)};
            pg8::gemm_phase<pg8::EpiGate<1>, pg8::StaticOrder, true, true>(lds, g, S, E); } }
        GSYNC();
        PH(7) { const Args a = load_args(); unsigned char* ws = a.ws;
          pg8::Gemm g{(const bf16*)(ws + WS_ACT), (const bf16*)(ws + WS_WO), M, DM, DM}; pg8::StaticOrder S; S.init(M, DM, G, bx);
          pg8::EpiResid E{(l == 0) ? a.in[0] : a.out, a.out};
          pg8::gemm_phase<pg8::EpiResid, pg8::StaticOrder, true, true>(lds, g, S, E); }
        GSYNC();
        { const Args a = load_args(); TIDS(); const float* g2 = a.in[19] + (size_t)l * DM; bf16* act = (bf16*)(a.ws + WS_ACT);
          rms_rows_to_bf16(a.out, g2, act, gw, NGW, lane); }
        GSYNC();
        PH(8) { const Args a = load_args(); unsigned char* ws = a.ws;
          pg8::Gemm g{(const bf16*)(ws + WS_ACT), (const bf16*)(ws + WS_W1), M, DFF, DM}; pg8::StaticOrder S; S.init(M, DFF, G, bx);
          pg8::EpiStore<1> E{(bf16*)(ws + WS_H), DFF};
          pg8::gemm_phase<pg8::EpiStore<1>, pg8::StaticOrder, true, true>(lds, g, S, E); }
        GSYNC();
        PH(9) { const Args a = load_args(); unsigned char* ws = a.ws;
          pg8::Gemm g{(const bf16*)(ws + WS_H), (const bf16*)(ws + WS_W2), M, DM, DFF}; pg8::StaticOrder S; S.init(M, DM, G, bx);
          pg8::EpiResid E{a.out, a.out};
          pg8::gemm_phase<pg8::EpiResid, pg8::StaticOrder, true, true>(lds, g, S, E); }
        GSYNC();
    }
}

extern "C" void kernel_launch(void* const* d_in, const int* in_sizes, int n_in, void* d_out, int out_size, void* d_ws, size_t ws_size, hipStream_t stream) {
    static int grid = 0;
    if (grid == 0) {
        if (n_in != 22 || out_size != M * DM || ws_size < WS_CTL + CTL_BYTES) { fprintf(stderr, "kernel_launch: unexpected shapes (n_in %d out %d ws %zu)\n", n_in, out_size, ws_size); grid = -1; return; }
        int dev = 0, cus = 0, per_cu = 0;
        hipGetDevice(&dev); hipDeviceGetAttribute(&cus, hipDeviceAttributeMultiprocessorCount, dev);
        hipFuncSetAttribute((const void*)fwd_megakernel, hipFuncAttributeMaxDynamicSharedMemorySize, LDS_BYTES);
        hipOccupancyMaxActiveBlocksPerMultiprocessor(&per_cu, (const void*)fwd_megakernel, NTHR, LDS_BYTES);
        if (per_cu < 1) { fprintf(stderr, "kernel_launch: occupancy query says %d blocks/CU\n", per_cu); per_cu = 1; }
        (void)hipGetLastError();
        grid = cus;
    }
    if (grid < 0) return;
    if (hipMemsetAsync((char*)d_ws + WS_CTL, 0, CTL_BYTES, stream) != hipSuccess) { fprintf(stderr, "kernel_launch: memset failed\n"); return; }
    Args a{};
    for (int i = 0; i < 22; ++i) a.in[i] = (const float*)d_in[i];
    a.out = (float*)d_out; a.ws = (unsigned char*)d_ws;
    void* args[] = {&a};
    hipError_t e = hipLaunchCooperativeKernel((const void*)fwd_megakernel, dim3(grid), dim3(NTHR), args, LDS_BYTES, stream);
    if (e != hipSuccess) fprintf(stderr, "cooperative launch failed: %s (grid %d)\n", hipGetErrorString(e), grid);
}
```

```cpp
#include <hip/hip_runtime.h>
#include <hip/hip_cooperative_groups.h>
#include <cstdio>
#include <cstdint>
namespace cg = cooperative_groups;
namespace pg8 {
#define PG8_LAS __attribute__((address_space(3)))
typedef unsigned short bf16_t;
typedef short bf16x8 __attribute__((ext_vector_type(8)));
typedef float f32x4 __attribute__((ext_vector_type(4)));
typedef unsigned u32x4 __attribute__((ext_vector_type(4)));
constexpr int BM = 256, BK = 64, HALF = 128, HTB = HALF * BK * 2  , STAGE_BYTES = 8 * HTB, NXCD = 8, WGM = 8;

__host__ __device__ __forceinline__ int lds_byte(int r, int c) { const int st = (r >> 4) * 2 + (c >> 5), rr = r & 15, cc = c & 31, ob = rr * 64 + cc * 2; return st * 1024 + (ob ^ (((ob >> 9) & 1) << 5)); }
__host__ __device__ __forceinline__ void stage_rc(int b, int& R, int& C) { const int st = b / 1024, sb = b % 1024, swz = sb ^ (((sb >> 9) & 1) << 5); R = (st >> 1) * 16 + swz / 64; C = (st & 1) * 32 + (swz % 64) / 2; }
__host__ __device__ __forceinline__ int perm32(int rho) { const int n = rho >> 4, i = rho & 15; return 8 * (i >> 2) + 4 * n + (i & 3); }

struct Unit { int pm, pn; };
struct Gemm { const bf16_t* A; const bf16_t* Bt; int M, N, K; };

struct StaticOrder {
    int nM, nN, nwg, G, c, wgm;
    __host__ __device__ void init(int M, int N, int G_, int c_, int wgm_ = 8) { nM = M / BM; nN = N / BM; nwg = nM * nN; G = G_; c = c_; wgm = wgm_; }
    __host__ __device__ bool next(int i, Unit& u) const {
        const long L = (long)i * G + c; if (L >= nwg) return false;
        int wgid = (int)L; { const int q = nwg / NXCD, r = nwg % NXCD, xcd = wgid % NXCD, off = wgid / NXCD; wgid = (xcd < r ? xcd * (q + 1) : r * (q + 1) + (xcd - r) * q) + off; }
        const int nig = wgm * nN, gid = wgid / nig, fm = gid * wgm, gsz = (nM - fm) < wgm ? (nM - fm) : wgm;
        u.pm = fm + ((wgid % nig) % gsz); u.pn = (wgid % nig) / gsz; return true;
    }
    __device__ __forceinline__ void a_ready(const Unit&) const {}
    __device__ __forceinline__ void done(const Unit&) const {}
};

__device__ __forceinline__ unsigned cvt_pk_bf16(float lo, float hi) { unsigned r; asm volatile("v_cvt_pk_bf16_f32 %0, %1, %2" : "=v"(r) : "v"(lo), "v"(hi)); return r; }
typedef float f32x2 __attribute__((ext_vector_type(2)));
typedef unsigned u32x2 __attribute__((ext_vector_type(2)));
__device__ __forceinline__ float bflo(unsigned w) { return __uint_as_float(w << 16); }
__device__ __forceinline__ float bfhi(unsigned w) { return __uint_as_float(w & 0xffff0000u); }
template <int ACT> struct EpiStore {
    static constexpr bool PERM = true, AFTER_DRAIN = false;
    bf16_t* O; int ldc;
    __device__ __forceinline__ void operator()(const f32x4 (&acc)[2][2][4][2], const Unit& u, int wr, int wc, int fr, int fq) const {
        const int row0 = u.pm * BM + wr * 64 + fr, col0 = u.pn * BM + wc * 32 + 8 * fq;
#pragma unroll
        for (int ai = 0; ai < 2; ++ai)
#pragma unroll
            for (int m = 0; m < 4; ++m) { const unsigned off = ((unsigned)(row0 + ai * HALF + m * 16) * (unsigned)ldc + (unsigned)col0) * 2u;
#pragma unroll
                for (int bj = 0; bj < 2; ++bj) { f32x4 v0 = acc[ai][bj][m][0], v1 = acc[ai][bj][m][1];
                    if (ACT == 1) {
#pragma unroll
                        for (int e = 0; e < 4; ++e) { float a = fmaxf(v0[e], 0.f), b = fmaxf(v1[e], 0.f); v0[e] = a * a; v1[e] = b * b; } }
                    u32x4 w; w.x = cvt_pk_bf16(v0[0], v0[1]); w.y = cvt_pk_bf16(v0[2], v0[3]); w.z = cvt_pk_bf16(v1[0], v1[1]); w.w = cvt_pk_bf16(v1[2], v1[3]);
                    *(u32x4*)((char*)O + off + (unsigned)(bj * HALF) * 2u) = w; } }
    }
};
template <int HAS_IN> struct EpiGate {
    static constexpr bool PERM = true, AFTER_DRAIN = false;
    const bf16_t* gate; int ldg; const bf16_t* Tin; bf16_t* Tout;
    __device__ __forceinline__ void operator()(const f32x4 (&acc)[2][2][4][2], const Unit& u, int wr, int wc, int fr, int fq) const {
        const int row0 = u.pm * BM + wr * 64 + fr, col0 = u.pn * BM + wc * 32 + 8 * fq;
#pragma unroll
        for (int ai = 0; ai < 2; ++ai)
#pragma unroll
            for (int mp = 0; mp < 2; ++mp) {
                u32x4 gw[2][2], tw[2][2];
#pragma unroll
                for (int mm = 0; mm < 2; ++mm)
#pragma unroll
                    for (int bj = 0; bj < 2; ++bj) { const unsigned row = (unsigned)(row0 + ai * HALF + (2 * mp + mm) * 16);
                        gw[mm][bj] = *(const u32x4*)((const char*)gate + (row * (unsigned)ldg + (unsigned)(col0 + bj * HALF)) * 2u);
                        if (HAS_IN) tw[mm][bj] = *(const u32x4*)((const char*)Tin + (row * 1024u + (unsigned)(col0 + bj * HALF)) * 2u); else tw[mm][bj] = (u32x4){0u, 0u, 0u, 0u}; }
                asm volatile("" ::: "memory");
#pragma unroll
                for (int mm = 0; mm < 2; ++mm)
#pragma unroll
                    for (int bj = 0; bj < 2; ++bj) { const int m = 2 * mp + mm; const unsigned row = (unsigned)(row0 + ai * HALF + m * 16);
                        const f32x4 v0 = acc[ai][bj][m][0], v1 = acc[ai][bj][m][1]; const u32x4 g4 = gw[mm][bj], t4 = tw[mm][bj];
                        const float gg[8] = {bflo(g4.x), bfhi(g4.x), bflo(g4.y), bfhi(g4.y), bflo(g4.z), bfhi(g4.z), bflo(g4.w), bfhi(g4.w)};
                        const float ti[8] = {bflo(t4.x), bfhi(t4.x), bflo(t4.y), bfhi(t4.y), bflo(t4.z), bfhi(t4.z), bflo(t4.w), bfhi(t4.w)};
                        float o[8];
#pragma unroll
                        for (int e = 0; e < 8; ++e) { const float s = __builtin_amdgcn_rcpf(1.0f + __builtin_amdgcn_exp2f(-1.4426950408889634f * gg[e])); o[e] = ti[e] + s * (e < 4 ? v0[e & 3] : v1[e & 3]); }
                        u32x4 w; w.x = cvt_pk_bf16(o[0], o[1]); w.y = cvt_pk_bf16(o[2], o[3]); w.z = cvt_pk_bf16(o[4], o[5]); w.w = cvt_pk_bf16(o[6], o[7]);
                        *(u32x4*)((char*)Tout + (row * 1024u + (unsigned)(col0 + bj * HALF)) * 2u) = w; }
                asm volatile("" ::: "memory"); }
    }
};
struct EpiResid {
    static constexpr bool PERM = false, AFTER_DRAIN = false;
    const float* base; float* out;
    __device__ __forceinline__ void operator()(const f32x4 (&acc)[2][2][4][2], const Unit& u, int wr, int wc, int fr, int fq) const {
        const int row0 = u.pm * BM + wr * 64 + fr, col0 = u.pn * BM + wc * 32 + 4 * fq;
        f32x4 bs[2][2][2][2];
#define ER_LOAD(c) do { _Pragma("unroll") for (int mm = 0; mm < 2; ++mm) _Pragma("unroll") for (int bj = 0; bj < 2; ++bj) _Pragma("unroll") for (int n = 0; n < 2; ++n) \
            bs[(c) & 1][mm][bj][n] = *(const f32x4*)((const char*)base + ((unsigned)(row0 + ((c) >> 1) * HALF + (2 * ((c) & 1) + mm) * 16) * 1024u + (unsigned)(col0 + bj * HALF + n * 16)) * 4u); } while (0)
        ER_LOAD(0);
#pragma unroll
        for (int c = 0; c < 4; ++c) {
            if (c + 1 < 4) ER_LOAD(c + 1);
            const int ai = c >> 1, mp = c & 1;
#pragma unroll
            for (int mm = 0; mm < 2; ++mm)
#pragma unroll
                for (int bj = 0; bj < 2; ++bj)
#pragma unroll
                    for (int n = 0; n < 2; ++n) *(f32x4*)((char*)out + ((unsigned)(row0 + ai * HALF + (2 * mp + mm) * 16) * 1024u + (unsigned)(col0 + bj * HALF + n * 16)) * 4u) = bs[c & 1][mm][bj][n] + acc[ai][bj][2 * mp + mm][n];
        }
#undef ER_LOAD
    }
};

template <class Epi, class Sched, bool ALIGN_EPI = false, bool SP2 = false>
__device__ __forceinline__ void gemm_phase(PG8_LAS unsigned char* lds, const Gemm g, const Sched& S, const Epi& E) {
    int tid_ = threadIdx.x; asm volatile("" : "+v"(tid_));
    const int tid = tid_, wid = __builtin_amdgcn_readfirstlane(tid >> 6), lane = tid & 63, wr = wid >> 2, wc = wid & 3, fr = lane & 15, fq = lane >> 4;
    const int K = g.K, nt = K / BK;
    unsigned voffA[2], voffB[2];
#pragma unroll
    for (int i = 0; i < 2; ++i) { int R, C; stage_rc(tid * 16 + i * 8192, R, C); const int Rb = Epi::PERM ? ((R & ~31) + perm32(R & 31)) : R;
        voffA[i] = (unsigned)(R * K + C) * 2u; voffB[i] = (unsigned)(Rb * K + C) * 2u; }
    const size_t kstep = (size_t)(BK * 2);
    const size_t hstep = (size_t)HALF * K * 2;
    const size_t tstep = 2 * hstep;
    const unsigned ldsw = (unsigned)wid * 1024u;
    const int aoff = lds_byte(wr * 64 + fr, fq * 8), boff = lds_byte(wc * 32 + fr, fq * 8);
#define PG8_SA(b, h) (((b) * 2 + (h)) * HTB)
#define PG8_SB(b, h) ((4 + (b) * 2 + (h)) * HTB)
#define PG8_STAGE(bufoff, gbase, voff) do { _Pragma("unroll") for (int _i = 0; _i < 2; ++_i) \
        __builtin_amdgcn_global_load_lds((const unsigned*)((const char*)(gbase) + (voff)[_i]), (PG8_LAS unsigned*)(lds + (bufoff) + ldsw + _i * 8192), 16, 0, 0); } while (0)
#define PG8_LDA(dst, b, h) do { _Pragma("unroll") for (int m = 0; m < 4; ++m) _Pragma("unroll") for (int k = 0; k < 2; ++k) dst[m][k] = *(const PG8_LAS bf16x8*)(lds + PG8_SA(b, h) + aoff + m * 2048 + k * 1024); } while (0)
#define PG8_LDB(dst, b, h) do { _Pragma("unroll") for (int n = 0; n < 2; ++n) _Pragma("unroll") for (int k = 0; k < 2; ++k) dst[n][k] = *(const PG8_LAS bf16x8*)(lds + PG8_SB(b, h) + boff + n * 2048 + k * 1024); } while (0)
#define PG8_MMA(ai, bj, At, Bt) do { __builtin_amdgcn_s_setprio(1); _Pragma("unroll") for (int m = 0; m < 4; ++m) _Pragma("unroll") for (int n = 0; n < 2; ++n) _Pragma("unroll") for (int k = 0; k < 2; ++k) \
        acc[ai][bj][m][n] = __builtin_amdgcn_mfma_f32_16x16x32_bf16(Bt[n][k], At[m][k], acc[ai][bj][m][n], 0, 0, 0); __builtin_amdgcn_s_setprio(0); } while (0)
#define PG8_WAIT_V(n) asm volatile("s_waitcnt vmcnt(" #n ")" ::: "memory")
#define PG8_WAIT_L(n) asm volatile("s_waitcnt lgkmcnt(" #n ")" ::: "memory")
#define PG8_BAR __builtin_amdgcn_s_barrier()
#define PG8_SCHED __builtin_amdgcn_sched_barrier(0)
    Unit cur, nxt; int ui = 0;
    if (!S.next(0, cur)) return;
    f32x4 acc[2][2][4][2];
#pragma unroll
    for (int a = 0; a < 2; ++a)
#pragma unroll
        for (int b = 0; b < 2; ++b)
#pragma unroll
            for (int m = 0; m < 4; ++m)
#pragma unroll
                for (int n = 0; n < 2; ++n) acc[a][b][m][n] = (f32x4){0.f, 0.f, 0.f, 0.f};
    bf16x8 At[4][2], B0[2][2], B1[2][2];
    const char* cA = (const char*)g.A + (size_t)cur.pm * tstep; const char* cB = (const char*)g.Bt + (size_t)cur.pn * tstep;
    S.a_ready(cur);
    if constexpr (SP2) {
        PG8_STAGE(PG8_SB(0, 0), cB, voffB); PG8_STAGE(PG8_SB(0, 1), cB + hstep, voffB); PG8_STAGE(PG8_SA(0, 0), cA, voffA); PG8_STAGE(PG8_SA(0, 1), cA + hstep, voffA);
        if (wr == 1) PG8_BAR;
        PG8_WAIT_V(2); PG8_BAR;
        PG8_STAGE(PG8_SB(1, 0), cB + kstep, voffB); PG8_STAGE(PG8_SA(1, 0), cA + kstep, voffA); PG8_STAGE(PG8_SB(1, 1), cB + hstep + kstep, voffB);
        PG8_WAIT_V(6); PG8_BAR;
    } else {
        PG8_STAGE(PG8_SB(0, 0), cB, voffB); PG8_STAGE(PG8_SA(0, 0), cA, voffA); PG8_STAGE(PG8_SB(0, 1), cB + hstep, voffB); PG8_STAGE(PG8_SA(0, 1), cA + hstep, voffA);
        if (wr == 1) PG8_BAR;
        PG8_WAIT_V(4); PG8_BAR;
        PG8_STAGE(PG8_SB(1, 0), cB + kstep, voffB); PG8_STAGE(PG8_SA(1, 0), cA + kstep, voffA); PG8_STAGE(PG8_SB(1, 1), cB + hstep + kstep, voffB);
        PG8_WAIT_V(6); PG8_BAR;
    }
    for (;;) {
        const bool has_next = S.next(ui + 1, nxt);
        const char* nA = has_next ? (const char*)g.A + (size_t)nxt.pm * tstep : cA; const char* nB = has_next ? (const char*)g.Bt + (size_t)nxt.pn * tstep : cB;
        for (int t = 0; t < nt; t += 2) {
            const bool last = (t == nt - 2);
            const char* a1 = cA + (size_t)(t + 1) * kstep;
            const char* a2 = last ? nA : cA + (size_t)(t + 2) * kstep; const char* b2 = last ? nB : cB + (size_t)(t + 2) * kstep;
            const char* a3 = a2 + kstep; const char* b3 = b2 + kstep;
            if (last && has_next) S.a_ready(nxt);
            if constexpr (SP2) {
            PG8_LDB(B0, 0, 0); PG8_LDB(B1, 0, 1); PG8_SCHED; PG8_LDA(At, 0, 0); PG8_STAGE(PG8_SA(1, 1), a1 + hstep, voffA);
            PG8_WAIT_V(8); PG8_WAIT_L(0); PG8_BAR; PG8_MMA(0, 0, At, B0); PG8_MMA(0, 1, At, B1); PG8_BAR; PG8_SCHED;
            PG8_LDA(At, 0, 1); PG8_STAGE(PG8_SB(0, 0), b2, voffB); PG8_STAGE(PG8_SB(0, 1), b2 + hstep, voffB); PG8_STAGE(PG8_SA(0, 0), a2, voffA);
            PG8_WAIT_V(8); PG8_WAIT_L(0); PG8_BAR; PG8_MMA(1, 0, At, B0); PG8_MMA(1, 1, At, B1); PG8_BAR; PG8_SCHED;
            PG8_LDB(B0, 1, 0); PG8_LDB(B1, 1, 1); PG8_SCHED; PG8_LDA(At, 1, 0); PG8_STAGE(PG8_SA(0, 1), a2 + hstep, voffA);
            PG8_WAIT_V(8); PG8_WAIT_L(0); PG8_BAR; PG8_MMA(0, 0, At, B0); PG8_MMA(0, 1, At, B1); PG8_BAR; PG8_SCHED;
            PG8_LDA(At, 1, 1); PG8_STAGE(PG8_SB(1, 0), b3, voffB); PG8_STAGE(PG8_SB(1, 1), b3 + hstep, voffB); PG8_STAGE(PG8_SA(1, 0), a3, voffA);
            PG8_WAIT_V(8); PG8_WAIT_L(0); PG8_BAR; PG8_MMA(1, 0, At, B0); PG8_MMA(1, 1, At, B1); PG8_BAR; PG8_SCHED;
            } else {
            PG8_LDB(B0, 0, 0); PG8_SCHED; PG8_LDA(At, 0, 0); PG8_STAGE(PG8_SA(1, 1), a1 + hstep, voffA);
            PG8_WAIT_L(8); PG8_BAR; PG8_WAIT_L(0); PG8_MMA(0, 0, At, B0); PG8_BAR; PG8_SCHED;
            PG8_LDB(B1, 0, 1); PG8_STAGE(PG8_SB(0, 0), b2, voffB);
            PG8_BAR; PG8_WAIT_L(0); PG8_MMA(0, 1, At, B1); PG8_BAR;
            PG8_LDA(At, 0, 1); PG8_STAGE(PG8_SA(0, 0), a2, voffA);
            PG8_BAR; PG8_WAIT_L(0); PG8_MMA(1, 0, At, B0); PG8_BAR; PG8_SCHED;
            PG8_STAGE(PG8_SB(0, 1), b2 + hstep, voffB);
            PG8_WAIT_V(6); PG8_BAR; PG8_MMA(1, 1, At, B1); PG8_BAR;
            PG8_LDB(B0, 1, 0); PG8_SCHED; PG8_LDA(At, 1, 0); PG8_STAGE(PG8_SA(0, 1), a2 + hstep, voffA);
            PG8_WAIT_L(8); PG8_BAR; PG8_WAIT_L(0); PG8_MMA(0, 0, At, B0); PG8_BAR; PG8_SCHED;
            PG8_LDB(B1, 1, 1); PG8_STAGE(PG8_SB(1, 0), b3, voffB);
            PG8_BAR; PG8_WAIT_L(0); PG8_MMA(0, 1, At, B1); PG8_BAR;
            PG8_LDA(At, 1, 1); PG8_STAGE(PG8_SA(1, 0), a3, voffA);
            PG8_BAR; PG8_WAIT_L(0); PG8_MMA(1, 0, At, B0); PG8_BAR; PG8_SCHED;
            PG8_STAGE(PG8_SB(1, 1), b3 + hstep, voffB);
            PG8_WAIT_V(6); PG8_BAR; PG8_MMA(1, 1, At, B1); PG8_BAR;
            }
        }
        if constexpr (ALIGN_EPI) { if (wr == 0) PG8_BAR; }
        if constexpr (!Epi::AFTER_DRAIN) { E(acc, cur, wr, wc, fr, fq); S.done(cur); }
        if (!has_next) break;
#pragma unroll
        for (int a = 0; a < 2; ++a)
#pragma unroll
            for (int b = 0; b < 2; ++b)
#pragma unroll
                for (int m = 0; m < 4; ++m)
#pragma unroll
                    for (int n = 0; n < 2; ++n) acc[a][b][m][n] = (f32x4){0.f, 0.f, 0.f, 0.f};
        cur = nxt; cA = nA; cB = nB; ++ui;
        if constexpr (ALIGN_EPI) { if (wr == 1) PG8_BAR; }
    }
    PG8_WAIT_V(0);
    if constexpr (!ALIGN_EPI) { if (wr == 0) PG8_BAR; }
    PG8_BAR;
    if constexpr (Epi::AFTER_DRAIN) { E.fused(acc, cur, wr, wc, fr, fq, lds, wid, lane); S.done(cur); }
#undef PG8_SA
#undef PG8_SB
#undef PG8_STAGE
#undef PG8_LDA
#undef PG8_LDB
#undef PG8_MMA
#undef PG8_WAIT_V
#undef PG8_WAIT_L
#undef PG8_BAR
#undef PG8_SCHED
}
}

#define LAS __attribute__((address_space(3)))
typedef unsigned short bf16;
typedef short bf16x8 __attribute__((ext_vector_type(8)));
typedef float f32x4 __attribute__((ext_vector_type(4)));
typedef float f32x16 __attribute__((ext_vector_type(16)));
typedef unsigned u32x4 __attribute__((ext_vector_type(4)));
typedef unsigned u32x2 __attribute__((ext_vector_type(2)));
constexpr int NWAVES = 8, NTHR = 512;
constexpr int SEQ = 2048, NBATCH = 8, M = NBATCH * SEQ, DM = 1024, NIN = 7296, NINP = 7424, DFF = 4096, DEPTH = 4;
constexpr int C_AQ = 0, C_AK = 384, C_AV = 768, C_BQ = 1152, C_BK = 1664, C_BV = 2176, C_CQ = 2688, C_CK = 2944, C_CV = 3200, C_CG = 3712, C_GATE = 4224;
constexpr float NORM_EPS = 1e-6f, LOG2E = 1.4426950408889634f;
constexpr size_t MiB = 1u << 20;
constexpr size_t WS_WIN = 0, WS_WBRA = 16 * MiB, WS_WBRB = 17 * MiB, WS_WBRC = 18 * MiB, WS_WO = 19 * MiB, WS_W1 = 21 * MiB, WS_W2 = 29 * MiB;
constexpr size_t WS_ROPE = 37 * MiB, WS_LA = 38 * MiB, WS_ACT = 40 * MiB, WS_YA = 72 * MiB, WS_YB = 84 * MiB, WS_YC = 100 * MiB, WS_PROJ = 116 * MiB;
constexpr size_t WS_H = WS_PROJ, WS_VTB = 348 * MiB, WS_VTC = 364 * MiB  , WS_T1 = 348 * MiB, WS_T2 = 380 * MiB, WS_END = 412 * MiB;
static_assert(WS_PROJ + (size_t)M * NINP * 2 <= WS_T1, "ws map");
constexpr int LDS_BYTES = 147456, MISC_OFF = 147456 - 256;
constexpr size_t WS_CTL = WS_END, CTL_BYTES = 16384;

__device__ __forceinline__ unsigned pk2(float lo, float hi) { return pg8::cvt_pk_bf16(lo, hi); }
__device__ __forceinline__ float bflo(unsigned w) { return __uint_as_float(w << 16); }
__device__ __forceinline__ float bfhi(unsigned w) { return __uint_as_float(w & 0xffff0000u); }
__device__ __forceinline__ float shx(float v, int mask, int lane) { return __int_as_float(__builtin_amdgcn_ds_bpermute((lane ^ mask) << 2, __float_as_int(v))); }
__device__ __forceinline__ float wave_sum(float v, int lane) {
#pragma unroll
    for (int o = 1; o < 64; o <<= 1) v += shx(v, o, lane);
    return v;
}
__device__ __forceinline__ float wave_max(float v, int lane) {
#pragma unroll
    for (int o = 1; o < 64; o <<= 1) v = fmaxf(v, shx(v, o, lane));
    return v;
}
#define MFMA32(a, b, c) __builtin_amdgcn_mfma_f32_32x32x16_bf16((a), (b), (c), 0, 0, 0)
__device__ __forceinline__ bf16x8 pack8(float a0, float a1, float a2, float a3, float a4, float a5, float a6, float a7) {
    u32x4 p;
    asm volatile("v_cvt_pk_bf16_f32 %0, %4, %5\n\tv_cvt_pk_bf16_f32 %1, %6, %7\n\tv_cvt_pk_bf16_f32 %2, %8, %9\n\tv_cvt_pk_bf16_f32 %3, %10, %11\n\ts_nop 1"
                 : "=&v"(p[0]), "=&v"(p[1]), "=&v"(p[2]), "=&v"(p[3])
                 : "v"(a0), "v"(a1), "v"(a2), "v"(a3), "v"(a4), "v"(a5), "v"(a6), "v"(a7));
    return __builtin_bit_cast(bf16x8, p);
}
__device__ __forceinline__ int kpos(int key) { return (key & ~12) | ((key & 4) << 1) | ((key & 8) >> 1); }

__device__ __forceinline__ void transpose_item(const float* W, int K, int N, bf16* WT, LAS float* scr, int item, int lane) {
    const int nblk = N / 32, kb = item / nblk, nb = item % nblk, k0 = 64 * kb, n0 = 32 * nb;
#pragma unroll 8
    for (int i = 0; i < 32; ++i) { const int kk = 2 * i + (lane >> 5); scr[kk * 33 + (lane & 31)] = W[(size_t)(k0 + kk) * N + n0 + (lane & 31)]; }
    asm volatile("s_waitcnt lgkmcnt(0)" ::: "memory");
    const int c = lane & 7;
#pragma unroll
    for (int j = 0; j < 4; ++j) { const int n = (lane >> 3) + 8 * j; const LAS float* s = scr + (8 * c) * 33 + n;
        u32x4 o; o.x = pk2(s[0 * 33], s[1 * 33]); o.y = pk2(s[2 * 33], s[3 * 33]); o.z = pk2(s[4 * 33], s[5 * 33]); o.w = pk2(s[6 * 33], s[7 * 33]);
        *(u32x4*)(WT + (size_t)(n0 + n) * K + k0 + 8 * c) = o; }
    asm volatile("s_waitcnt lgkmcnt(0)" ::: "memory");
}
__device__ __forceinline__ void rms_rows_to_bf16(const float* x, const float* g, bf16* o, int gw, int NGW, int lane) {
    const f32x4* gr = (const f32x4*)g + lane;
    f32x4 gg[4];
#pragma unroll
    for (int j = 0; j < 4; ++j) gg[j] = gr[64 * j];
    for (int m0 = gw * 4; m0 < M; m0 += NGW * 4) {
        f32x4 v[4][4];
#pragma unroll
        for (int q = 0; q < 4; ++q)
#pragma unroll
            for (int j = 0; j < 4; ++j) v[q][j] = ((const f32x4*)(x + (size_t)(m0 + q) * DM) + lane)[64 * j];
#pragma unroll
        for (int q = 0; q < 4; ++q) { float s = 0.f;
#pragma unroll
            for (int j = 0; j < 4; ++j) s += (v[q][j].x * v[q][j].x + v[q][j].y * v[q][j].y) + (v[q][j].z * v[q][j].z + v[q][j].w * v[q][j].w);
            const float rstd = 1.0f / sqrtf(wave_sum(s, lane) * (1.f / DM) + NORM_EPS);
            unsigned long long* o8 = (unsigned long long*)(o + (size_t)(m0 + q) * DM) + lane;
#pragma unroll
            for (int j = 0; j < 4; ++j)
                o8[64 * j] = (unsigned long long)pk2(v[q][j].x * rstd * gg[j].x, v[q][j].y * rstd * gg[j].y) | ((unsigned long long)pk2(v[q][j].z * rstd * gg[j].z, v[q][j].w * rstd * gg[j].w) << 32); }
    }
}

struct Args { const float* in[22]; float* out; unsigned char* ws; };
__device__ __forceinline__ int otid() { int t = threadIdx.x; asm volatile("" : "+v"(t)); return t; }

__device__ __forceinline__ void phase_prep(const Args& a, int l, LAS unsigned char* lds, int gw, int NGW, int wave, int lane, const float* xsrc) {
    unsigned char* ws = a.ws;
    LAS float* scr = (LAS float*)(lds + wave * 16384);
    const float* w_in = a.in[2] + (size_t)l * DM * NIN;
    const float* w_bra = a.in[15] + (size_t)l * 384 * DM;
    const float* w_brb = a.in[16] + (size_t)l * 512 * DM;
    const float* w_brc = a.in[17] + (size_t)l * 512 * DM;
    const float* w_o = a.in[18] + (size_t)l * DM * DM;
    const float* w_1 = a.in[20] + (size_t)l * DM * DFF;
    const float* w_2 = a.in[21] + (size_t)l * DFF * DM;
    constexpr int I_IN = (DM / 64) * (NIN / 32), I_A = (384 / 64) * (DM / 32), I_B = (512 / 64) * (DM / 32), I_O = (DM / 64) * (DM / 32), I_1 = (DM / 64) * (DFF / 32), I_2 = (DFF / 64) * (DM / 32);
    constexpr int NITEMS = I_IN + I_A + 2 * I_B + I_O + I_1 + I_2;
    for (int it = gw; it < NITEMS; it += NGW) {
        int r = it;
        if (r < I_IN) { transpose_item(w_in, DM, NIN, (bf16*)(ws + WS_WIN), scr, r, lane); continue; } r -= I_IN;
        if (r < I_A) { transpose_item(w_bra, 384, DM, (bf16*)(ws + WS_WBRA), scr, r, lane); continue; } r -= I_A;
        if (r < I_B) { transpose_item(w_brb, 512, DM, (bf16*)(ws + WS_WBRB), scr, r, lane); continue; } r -= I_B;
        if (r < I_B) { transpose_item(w_brc, 512, DM, (bf16*)(ws + WS_WBRC), scr, r, lane); continue; } r -= I_B;
        if (r < I_O) { transpose_item(w_o, DM, DM, (bf16*)(ws + WS_WO), scr, r, lane); continue; } r -= I_O;
        if (r < I_1) { transpose_item(w_1, DM, DFF, (bf16*)(ws + WS_W1), scr, r, lane); continue; } r -= I_1;
        transpose_item(w_2, DFF, DM, (bf16*)(ws + WS_W2), scr, r, lane);
    }
    { u32x4* z = (u32x4*)((bf16*)(ws + WS_WIN) + (size_t)NIN * DM); unsigned z0 = 0u; asm volatile("" : "+v"(z0)); const u32x4 zz = {z0, z0, z0, z0};
      for (int i = gw * 64 + lane; i < (NINP - NIN) * DM / 8; i += NGW * 64) z[i] = zz; }
    const float* g1 = a.in[1] + (size_t)l * DM;
    bf16* act = (bf16*)(ws + WS_ACT);
    rms_rows_to_bf16(xsrc, g1, act, gw, NGW, lane);
    if (l == 0) {
        float* rp = (float*)(ws + WS_ROPE);
        for (int e = gw * 64 + lane; e < SEQ * 40; e += NGW * 64) {
            const int s = e / 40, i = e % 40;
            float inv; if (i < 8) inv = 1.0f / exp2f((float)(2 * i) * (1.0f / 16.0f) * 18.931568569324174f);
            else inv = 1.0f / exp2f((float)(2 * (i - 8)) * (1.0f / 64.0f) * 13.287712379549449f);
            const float ang = (float)s * inv;
            const double rev = (double)ang * 0.15915494309189535; const float fr = (float)(rev - floor(rev));
            const float cs = __builtin_amdgcn_cosf(fr), sn = __builtin_amdgcn_sinf(fr);
            if (i < 8) { rp[s * 8 + i] = cs; rp[SEQ * 8 + s * 8 + i] = sn; }
            else { rp[SEQ * 16 + s * 32 + (i - 8)] = cs; rp[SEQ * 16 + SEQ * 32 + s * 32 + (i - 8)] = sn; }
        }
    }
}

__device__ __forceinline__ void pp_decode(const Args& a, int l, int hv, int& col, const float*& g, int& full, float& sc) {
    const float qs = 0.125f * LOG2E;
    g = a.in[3]; full = 0; sc = 1.f;
    if (hv < 6) { col = C_AQ + 64 * hv; g = a.in[3] + l * 64; sc = qs; }
    else if (hv < 12) { col = C_AK + 64 * (hv - 6); g = a.in[4] + l * 64; }
    else if (hv < 20) { col = C_BQ + 64 * (hv - 12); g = a.in[5] + l * 64; sc = qs; }
    else if (hv < 28) { col = C_BK + 64 * (hv - 20); g = a.in[6] + l * 64; }
    else if (hv < 32) { col = C_CQ + 64 * (hv - 28); full = 1; }
    else { col = C_CK + 64 * (hv - 32); full = 1; sc = 0.125f; }
}
__device__ __forceinline__ void pp_compute(const u32x4 w0, const u32x4 w1, u32x4& o0, u32x4& o1, const float* g, int full, float sc, int s, int q4, int lane,
                                           const float* cosP, const float* sinP, const float* cosR, const float* sinR) {
    float v[16] = {bflo(w0.x), bfhi(w0.x), bflo(w0.y), bfhi(w0.y), bflo(w0.z), bfhi(w0.z), bflo(w0.w), bfhi(w0.w),
                   bflo(w1.x), bfhi(w1.x), bflo(w1.y), bfhi(w1.y), bflo(w1.z), bfhi(w1.z), bflo(w1.w), bfhi(w1.w)};
    if (!full) {
        float ss = 0.f;
#pragma unroll
        for (int i = 0; i < 16; ++i) ss += v[i] * v[i];
        ss += shx(ss, 1, lane); ss += shx(ss, 2, lane);
        const float r = 1.0f / sqrtf(ss * (1.f / 64.f) + NORM_EPS);
        const f32x4* gp = (const f32x4*)(g + q4 * 16);
#pragma unroll
        for (int c = 0; c < 4; ++c) { const f32x4 gg = gp[c]; v[4 * c] *= r * gg[0]; v[4 * c + 1] *= r * gg[1]; v[4 * c + 2] *= r * gg[2]; v[4 * c + 3] *= r * gg[3]; }
        if (q4 == 0) {
            const f32x4 c0 = *(const f32x4*)(cosP + s * 8), c1 = *(const f32x4*)(cosP + s * 8 + 4), s0 = *(const f32x4*)(sinP + s * 8), s1 = *(const f32x4*)(sinP + s * 8 + 4);
#pragma unroll
            for (int i = 0; i < 8; ++i) { const float c = i < 4 ? c0[i & 3] : c1[i & 3], sn = i < 4 ? s0[i & 3] : s1[i & 3], t1 = v[i], t2 = v[8 + i]; v[i] = t1 * c - t2 * sn; v[8 + i] = t2 * c + t1 * sn; }
        }
    } else {
        const int ib = (q4 & 1) * 16;
        const float sg = (q4 < 2) ? -1.0f : 1.0f;
#pragma unroll
        for (int c = 0; c < 4; ++c) { const f32x4 cc = *(const f32x4*)(cosR + s * 32 + ib + 4 * c), sn = *(const f32x4*)(sinR + s * 32 + ib + 4 * c);
#pragma unroll
            for (int j = 0; j < 4; ++j) { const float pv = shx(v[4 * c + j], 2, lane); v[4 * c + j] = v[4 * c + j] * cc[j] + sg * pv * sn[j]; } }
    }
    o0.x = pk2(v[0] * sc, v[1] * sc); o0.y = pk2(v[2] * sc, v[3] * sc); o0.z = pk2(v[4] * sc, v[5] * sc); o0.w = pk2(v[6] * sc, v[7] * sc);
    o1.x = pk2(v[8] * sc, v[9] * sc); o1.y = pk2(v[10] * sc, v[11] * sc); o1.z = pk2(v[12] * sc, v[13] * sc); o1.w = pk2(v[14] * sc, v[15] * sc);
}
__device__ __forceinline__ void phase_postproj(const Args& a, int l, int gtid, int NT, int lane) {
    bf16* proj = (bf16*)(a.ws + WS_PROJ);
    const float* rp = (const float*)(a.ws + WS_ROPE);
    const float* cosP = rp; const float* sinP = rp + SEQ * 8; const float* cosR = rp + SEQ * 16; const float* sinR = rp + SEQ * 16 + SEQ * 32;
    const int q4 = lane & 3, NQ = NT >> 2;
    for (int e0 = gtid >> 2; e0 < M * 36; e0 += 2 * NQ) {
        const int e1 = e0 + NQ; const bool has1 = e1 < M * 36;
        const int t0 = e0 / 36, hv0 = e0 % 36, t1 = has1 ? e1 / 36 : t0, hv1 = has1 ? e1 % 36 : hv0;
        int col0, full0, col1, full1; const float *g0, *g1; float sc0, sc1;
        pp_decode(a, l, hv0, col0, g0, full0, sc0); pp_decode(a, l, hv1, col1, g1, full1, sc1);
        u32x4* p0 = (u32x4*)(proj + (size_t)t0 * NINP + col0 + q4 * 16); u32x4* p1 = (u32x4*)(proj + (size_t)t1 * NINP + col1 + q4 * 16);
        const u32x4 a0 = p0[0], a1 = p0[1], b0 = p1[0], b1 = p1[1];
        u32x4 o0, o1;
        pp_compute(a0, a1, o0, o1, g0, full0, sc0, t0 & (SEQ - 1), q4, lane, cosP, sinP, cosR, sinR);
        p0[0] = o0; p0[1] = o1;
        if (has1) { pp_compute(b0, b1, o0, o1, g1, full1, sc1, t1 & (SEQ - 1), q4, lane, cosP, sinP, cosR, sinR); p1[0] = o0; p1[1] = o1; }
    }
}

__device__ __forceinline__ void vt_item(const bf16* proj, bf16* vt, int vcol0, int item, LAS unsigned char* scr, int lane) {
    const int kt = item & 31, h = (item >> 5) & 3, b = item >> 7;
    const bf16* src = proj + ((size_t)b * SEQ + kt * 64) * NINP + vcol0 + h * 128;
#pragma unroll 4
    for (int i = 0; i < 16; ++i) { const int row = 4 * i + (lane >> 4), ch = lane & 15;
        const u32x4 w = *(const u32x4*)(src + (size_t)row * NINP + ch * 8);
        *(LAS u32x4*)(scr + row * 272 + ch * 16) = w; }
    asm volatile("s_waitcnt lgkmcnt(0)" ::: "memory");
    const int c = lane & 7;
    bf16* dst = vt + ((size_t)(b * 4 + h) * 128) * SEQ + kt * 64 + c * 8;
#pragma unroll 4
    for (int i = 0; i < 16; ++i) { const int dv = 8 * i + (lane >> 3);
        unsigned short e[8];
#pragma unroll
        for (int j = 0; j < 8; ++j) e[j] = *(const LAS unsigned short*)(scr + kpos(8 * c + j) * 272 + dv * 2);
        u32x4 o; o.x = e[0] | ((unsigned)e[1] << 16); o.y = e[2] | ((unsigned)e[3] << 16); o.z = e[4] | ((unsigned)e[5] << 16); o.w = e[6] | ((unsigned)e[7] << 16);
        *(u32x4*)(dst + (size_t)dv * SEQ) = o; }
    asm volatile("s_waitcnt lgkmcnt(0)" ::: "memory");
}

__device__ __forceinline__ void attn_a_item(const Args& a, int item, LAS unsigned char* wlds, int lane, float M2) {
    const bf16* proj = (const bf16*)(a.ws + WS_PROJ);
    bf16* ya = (bf16*)(a.ws + WS_YA); float* lA = (float*)(a.ws + WS_LA);
    const int r = lane & 31, hh = lane >> 5;
    const int g = item >> 10; int rem = item & 1023;
    const int qhalf = rem & 1; rem >>= 1;
    const int dsh = 2 * g, dil = 1 << dsh, nbs = 5 - dsh, L = SEQ >> dsh;
    const int n = rem & ((1 << nbs) - 1); rem >>= nbs;
    const int rsd = rem & (dil - 1); rem >>= dsh;
    const int hg = rem & 1; const int b = rem >> 1;
    const int head = 2 * g + hg;
    const int iq = 64 * n + 32 * qhalf + r;
    const size_t tq = (size_t)b * SEQ + (size_t)dil * iq + rsd;
    bf16x8 qf[4];
#pragma unroll
    for (int kk = 0; kk < 4; ++kk) qf[kk] = *(const bf16x8*)(proj + tq * NINP + C_AQ + head * 64 + 16 * kk + 8 * hh);
    f32x16 O0, O1;
#pragma unroll
    for (int i = 0; i < 16; ++i) { O0[i] = 0.f; O1[i] = 0.f; }
    float lsum = 0.f;
    const int j0 = 64 * n + 32 * qhalf - 64;
    const int lkey = lane >> 3, lch = lane & 7;
    u32x4 kb_[2][4], vb_[2][4];
    {
#pragma unroll
      for (int i = 0; i < 4; ++i) { int jr = j0 + lkey + 8 * i; jr = jr < 0 ? 0 : (jr >= L ? L - 1 : jr); const size_t tk = (size_t)b * SEQ + (size_t)dil * jr + rsd;
        kb_[0][i] = *(const u32x4*)(proj + tk * NINP + C_AK + head * 64 + lch * 8); vb_[0][i] = *(const u32x4*)(proj + tk * NINP + C_AV + head * 64 + lch * 8); } }
    LAS unsigned char* kl = wlds + 5120;
#pragma unroll
    for (int sb = 0; sb < 5; ++sb) {
        const int jb = j0 + 32 * sb;
        if (sb + 1 < 5) {
#pragma unroll
            for (int i = 0; i < 4; ++i) { int jr = jb + 32 + lkey + 8 * i; jr = jr < 0 ? 0 : (jr >= L ? L - 1 : jr); const size_t tk = (size_t)b * SEQ + (size_t)dil * jr + rsd;
                kb_[(sb + 1) & 1][i] = *(const u32x4*)(proj + tk * NINP + C_AK + head * 64 + lch * 8); vb_[(sb + 1) & 1][i] = *(const u32x4*)(proj + tk * NINP + C_AV + head * 64 + lch * 8); } }
        if (jb < 0 || jb >= L) continue;
#pragma unroll
        for (int i = 0; i < 4; ++i) { const int key = lkey + 8 * i;
            *(LAS u32x4*)(kl + key * 144 + lch * 16) = kb_[sb & 1][i];
            const u32x4 vv = vb_[sb & 1][i]; const unsigned ww[4] = {vv.x, vv.y, vv.z, vv.w};
            LAS bf16* w = (LAS bf16*)(wlds + (lch * 8) * 80 + kpos(key) * 2);
#pragma unroll
            for (int j = 0; j < 4; ++j) { w[(2 * j) * 40] = (bf16)(ww[j] & 0xffffu); w[(2 * j + 1) * 40] = (bf16)(ww[j] >> 16); } }
        asm volatile("s_waitcnt lgkmcnt(0)" ::: "memory");
        f32x16 acc;
#pragma unroll
        for (int i = 0; i < 16; ++i) acc[i] = -M2;
#pragma unroll
        for (int kk = 0; kk < 4; ++kk) { const bf16x8 kf = *(const LAS bf16x8*)(kl + r * 144 + (16 * kk + 8 * hh) * 2); acc = MFMA32(kf, qf[kk], acc); }
        float p[16];
#pragma unroll
        for (int i = 0; i < 16; ++i) { const int j = jb + (i & 3) + 8 * (i >> 2) + 4 * hh; const int d = iq - j;
            const float e = __builtin_amdgcn_exp2f(acc[i]); p[i] = (d <= 64 && d >= -64) ? e : 0.f; lsum += p[i]; }
        const bf16x8 pf0 = pack8(p[0], p[1], p[2], p[3], p[4], p[5], p[6], p[7]);
        const bf16x8 pf1 = pack8(p[8], p[9], p[10], p[11], p[12], p[13], p[14], p[15]);
        const bf16x8 v00 = *(const LAS bf16x8*)(wlds + r * 80 + (8 * hh) * 2);
        const bf16x8 v01 = *(const LAS bf16x8*)(wlds + r * 80 + (16 + 8 * hh) * 2);
        const bf16x8 v10 = *(const LAS bf16x8*)(wlds + (32 + r) * 80 + (8 * hh) * 2);
        const bf16x8 v11 = *(const LAS bf16x8*)(wlds + (32 + r) * 80 + (16 + 8 * hh) * 2);
        O0 = MFMA32(v00, pf0, O0); O0 = MFMA32(v01, pf1, O0);
        O1 = MFMA32(v10, pf0, O1); O1 = MFMA32(v11, pf1, O1);
        asm volatile("s_waitcnt lgkmcnt(0)" ::: "memory");
    }
    const float l = lsum + shx(lsum, 32, lane);
    bf16* op = ya + tq * 384 + head * 64 + 4 * hh;
#pragma unroll
    for (int q = 0; q < 4; ++q) {
        u32x2 w0; w0.x = pk2(O0[4 * q], O0[4 * q + 1]); w0.y = pk2(O0[4 * q + 2], O0[4 * q + 3]); *(u32x2*)(op + 8 * q) = w0;
        u32x2 w1; w1.x = pk2(O1[4 * q], O1[4 * q + 1]); w1.y = pk2(O1[4 * q + 2], O1[4 * q + 3]); *(u32x2*)(op + 32 + 8 * q) = w1;
    }
    if (hh == 0) lA[tq * 6 + head] = l;
}

constexpr int AT_KOFF = 9216, AT_VT = 18432, AT_STAGE = 36864;
constexpr size_t WS_RST = 380 * MiB;
__device__ __forceinline__ void ret_state_item(const Args& a, int l, int item, LAS unsigned char* lds) {
    const bf16* proj = (const bf16*)(a.ws + WS_PROJ);
    const int tid = otid(), wid = __builtin_amdgcn_readfirstlane(tid >> 6), lane = tid & 63, r = lane & 31, hh = lane >> 5;
    const int j = item & 7, h = (item >> 3) & 3, b = item >> 5;
    const float lgf2 = -__expf(a.in[12][l * 4 + h]) * LOG2E, lgb2 = -__expf(a.in[13][l * 4 + h]) * LOG2E;
    const int dir = wid >> 2, db = (wid >> 1) & 1, dvp = wid & 1;
    const bf16* kg = proj + ((size_t)b * SEQ + j * 256 + (tid >> 3)) * NINP + C_CK + h * 64 + (tid & 7) * 8;
    const bf16* vg = (const bf16*)(a.ws + WS_VTC) + ((size_t)(b * 4 + h) * 128 + (tid >> 3)) * SEQ + j * 256 + (tid & 7) * 8;
    f32x16 acc0, acc1;
#pragma unroll
    for (int i = 0; i < 16; ++i) { acc0[i] = 0.f; acc1[i] = 0.f; }
    for (int t = 0; t < 4; ++t) {
        const u32x4 kw = *(const u32x4*)(kg + (size_t)t * 64 * NINP);
        const u32x4 v0 = *(const u32x4*)(vg + t * 64), v1 = *(const u32x4*)(vg + t * 64 + 64 * SEQ);
        const int key = tid >> 3, ch = tid & 7, pos = t * 64 + key;
        const float wf = __builtin_amdgcn_exp2f(lgf2 * (float)(256 - pos)), wb = __builtin_amdgcn_exp2f(lgb2 * (float)pos);
        const float kv[8] = {bflo(kw.x), bfhi(kw.x), bflo(kw.y), bfhi(kw.y), bflo(kw.z), bfhi(kw.z), bflo(kw.w), bfhi(kw.w)};
        LAS bf16* ktf = (LAS bf16*)(lds + (ch * 8) * 144 + kpos(key) * 2);
        LAS bf16* ktb = (LAS bf16*)(lds + 9216 + (ch * 8) * 144 + kpos(key) * 2);
#pragma unroll
        for (int e = 0; e < 8; e += 2) { const unsigned pf = pk2(kv[e] * wf, kv[e + 1] * wf), pb = pk2(kv[e] * wb, kv[e + 1] * wb);
            ktf[e * 72] = (bf16)(pf & 0xffffu); ktf[(e + 1) * 72] = (bf16)(pf >> 16); ktb[e * 72] = (bf16)(pb & 0xffffu); ktb[(e + 1) * 72] = (bf16)(pb >> 16); }
        *(LAS u32x4*)(lds + AT_VT + (tid >> 3) * 144 + (tid & 7) * 16) = v0;
        *(LAS u32x4*)(lds + AT_VT + ((tid >> 3) + 64) * 144 + (tid & 7) * 16) = v1;
        __syncthreads();
        LAS unsigned char* abase = lds + dir * 9216 + (32 * db + r) * 144 + (8 * hh) * 2;
        LAS unsigned char* bbase = lds + AT_VT + (64 * dvp + r) * 144 + (8 * hh) * 2;
#pragma unroll
        for (int ks = 0; ks < 4; ++ks) { const bf16x8 af = *(const LAS bf16x8*)(abase + 32 * ks);
            const bf16x8 b0 = *(const LAS bf16x8*)(bbase + 32 * ks), b1 = *(const LAS bf16x8*)(bbase + 32 * 144 + 32 * ks);
            acc0 = MFMA32(af, b0, acc0); acc1 = MFMA32(af, b1, acc1); }
        __syncthreads();
    }
    float* F = (float*)(a.ws + WS_RST) + ((size_t)(dir * 256 + item) * 64 + 32 * db + 4 * hh) * 128 + 64 * dvp + r;
#pragma unroll
    for (int i = 0; i < 16; ++i) { const int drow = (i & 3) + 8 * (i >> 2); F[drow * 128] = acc0[i]; F[drow * 128 + 32] = acc1[i]; }
}

template <int MODE>
__device__ __forceinline__ void attn_dense_unit(const Args& a, int l, int unit, LAS unsigned char* lds, float M2, float lam, float oscale) {
    const bf16* proj = (const bf16*)(a.ws + WS_PROJ);
    const int tid = otid(), wid = __builtin_amdgcn_readfirstlane(tid >> 6), lane = tid & 63, r = lane & 31, hh = lane >> 5;
    constexpr int QROWS = MODE == 0 ? 128 : 256;
    const int g = MODE == 0 ? (wid >> 1) : wid, m = MODE == 0 ? (wid & 1) : 0;
    const int qb = MODE == 0 ? (unit & 15) : (unit & 7), h = MODE == 0 ? ((unit >> 4) & 3) : ((unit >> 3) & 3), b = MODE == 0 ? (unit >> 6) : (unit >> 5);
    const int qcol = MODE == 0 ? C_BQ + (h * 2 + m) * 64 : C_CQ + h * 64;
    const int kcol = MODE == 0 ? C_BK + h * 128 : C_CK + h * 64;
    const size_t rowbase = (size_t)b * SEQ;
    const int nq = qb * QROWS + g * 32 + r;
    bf16x8 qf[4];
#pragma unroll
    for (int kk = 0; kk < 4; ++kk) qf[kk] = *(const bf16x8*)(proj + (rowbase + nq) * NINP + qcol + 16 * kk + 8 * hh);
    float lgf2 = 0.f, lgb2n = 0.f;
    float c1f[4] = {0.f, 0.f, 0.f, 0.f}, c2f[4] = {0.f, 0.f, 0.f, 0.f}, c1b[4] = {0.f, 0.f, 0.f, 0.f}, c2b[4] = {0.f, 0.f, 0.f, 0.f};
    if (MODE == 1) { lgf2 = -__expf(a.in[12][l * 4 + h]) * LOG2E; lgb2n = __expf(a.in[13][l * 4 + h]) * LOG2E;
#pragma unroll
        for (int q = 0; q < 4; ++q) { c1f[q] = __builtin_amdgcn_exp2f(lgf2 * (float)(3 - q)); c2f[q] = __builtin_amdgcn_exp2f(lgf2 * (float)(28 - 4 * hh - 8 * q));
                                      c1b[q] = __builtin_amdgcn_exp2f(-lgb2n * (float)q); c2b[q] = __builtin_amdgcn_exp2f(-lgb2n * (float)(4 * hh + 8 * q)); } }
    f32x16 O[4];
#pragma unroll
    for (int d = 0; d < 4; ++d)
#pragma unroll
        for (int i = 0; i < 16; ++i) O[d][i] = 0.f;
    float lsum = 0.f;
    if constexpr (MODE == 1) {
        const float* Fb_ = (const float*)(a.ws + WS_RST) + (size_t)((b * 4 + h) * 8) * 8192;
        const float cf = __builtin_amdgcn_exp2f(lgf2 * 256.0f), cb = __builtin_amdgcn_exp2f(-lgb2n * 256.0f);
#pragma unroll
        for (int e = 0; e < 4; ++e) { const int idx = tid + 512 * e, d = idx >> 5, dv4 = (idx & 31) * 4;
            f32x4 sf = {0.f, 0.f, 0.f, 0.f}, sb = {0.f, 0.f, 0.f, 0.f}; float w = 1.0f;
            for (int j = qb - 1; j >= 0; --j) { const f32x4 v = *(const f32x4*)(Fb_ + (size_t)j * 8192 + d * 128 + dv4); sf += v * w; w *= cf; }
            w = 1.0f;
            for (int j = qb + 1; j < 8; ++j) { const f32x4 v = *(const f32x4*)(Fb_ + (size_t)(256 + j) * 8192 + d * 128 + dv4); sb += v * w; w *= cb; }
#pragma unroll
            for (int q = 0; q < 4; ++q) { *(LAS bf16*)(lds + 73728 + (dv4 + q) * 144 + d * 2) = (bf16)(pk2(sf[q], 0.f) & 0xffffu); *(LAS bf16*)(lds + 92160 + (dv4 + q) * 144 + d * 2) = (bf16)(pk2(sb[q], 0.f) & 0xffffu); } }
        __syncthreads();
        const float wqf = __builtin_amdgcn_exp2f(lgf2 * (float)(g * 32 + r)), wqb = __builtin_amdgcn_exp2f(-lgb2n * (float)(256 - (g * 32 + r)));
#pragma unroll
        for (int d = 0; d < 4; ++d) { f32x16 of = O[d], ob = O[d];
#pragma unroll
            for (int kk = 0; kk < 4; ++kk) { const bf16x8 af = *(const LAS bf16x8*)(lds + 73728 + (32 * d + r) * 144 + (16 * kk + 8 * hh) * 2);
                const bf16x8 ab = *(const LAS bf16x8*)(lds + 92160 + (32 * d + r) * 144 + (16 * kk + 8 * hh) * 2);
                of = MFMA32(af, qf[kk], of); ob = MFMA32(ab, qf[kk], ob); }
#pragma unroll
            for (int i = 0; i < 16; ++i) O[d][i] = of[i] * wqf + ob[i] * wqb; }
    }
    const int lk_key = tid >> 3, lk_ch = tid & 7;
    const bf16* kg = proj + (rowbase + lk_key) * NINP + kcol + lk_ch * 8;
    const bf16* vg = (const bf16*)(a.ws + (MODE == 0 ? WS_VTB : WS_VTC)) + ((size_t)(b * 4 + h) * 128 + (tid >> 3)) * SEQ + (tid & 7) * 8;
    u32x4 kr0, kr1, vr0, vr1;
    constexpr int NTALL = SEQ / 64, NT = MODE == 0 ? NTALL : 4;
    const int kt0 = ((QROWS / 64) * qb) & (NTALL - 1);
    { const size_t o = (size_t)kt0 * 64 * NINP;
      kr0 = *(const u32x4*)(kg + o); if (MODE == 0) kr1 = *(const u32x4*)(kg + o + 64);
      vr0 = *(const u32x4*)(vg + kt0 * 64); vr1 = *(const u32x4*)(vg + kt0 * 64 + 64 * SEQ); }
    for (int it = 0; it < NT; ++it) {
        const int kt = (it + kt0) & (NTALL - 1);
        LAS unsigned char* st = lds + (it & 1) * AT_STAGE;
        *(LAS u32x4*)(st + lk_key * 144 + lk_ch * 16) = kr0;
        if (MODE == 0) *(LAS u32x4*)(st + AT_KOFF + lk_key * 144 + lk_ch * 16) = kr1;
        *(LAS u32x4*)(st + AT_VT + lk_key * 144 + lk_ch * 16) = vr0;
        *(LAS u32x4*)(st + AT_VT + (lk_key + 64) * 144 + lk_ch * 16) = vr1;
        __syncthreads();
        if (it + 1 < NT) {
            const int kn = (kt + 1) & (NTALL - 1);
            const size_t o = (size_t)kn * 64 * NINP;
            kr0 = *(const u32x4*)(kg + o); if (MODE == 0) kr1 = *(const u32x4*)(kg + o + 64);
            vr0 = *(const u32x4*)(vg + kn * 64); vr1 = *(const u32x4*)(vg + kn * 64 + 64 * SEQ);
        }
#define SCORE_TO_P(acc, kb, p) do { \
            if (MODE == 0) { _Pragma("unroll") for (int i = 0; i < 16; ++i) { p[i] = __builtin_amdgcn_exp2f(acc[i]); lsum += p[i]; } } \
            else { const int mk0 = kt * 64 + 32 * (kb), q0w = qb * QROWS + g * 32; \
                if (mk0 + 31 < q0w) { const float A_ = __builtin_amdgcn_exp2f(lgf2 * (float)(nq - mk0 - 31)); float c2_[4]; \
                    _Pragma("unroll") for (int bq = 0; bq < 4; ++bq) c2_[bq] = A_ * c2f[bq]; \
                    _Pragma("unroll") for (int i = 0; i < 16; ++i) p[i] = acc[i] * (c2_[i >> 2] * c1f[i & 3]); } \
                else if (mk0 > q0w + 31) { const float A_ = __builtin_amdgcn_exp2f(-lgb2n * (float)(mk0 - nq)); float c2_[4]; \
                    _Pragma("unroll") for (int bq = 0; bq < 4; ++bq) c2_[bq] = A_ * c2b[bq]; \
                    _Pragma("unroll") for (int i = 0; i < 16; ++i) p[i] = acc[i] * (c2_[i >> 2] * c1b[i & 3]); } \
                else { const int dbase_ = nq - (mk0 + 4 * hh); \
                    _Pragma("unroll") for (int i = 0; i < 16; ++i) { const int d_ = dbase_ - ((i & 3) + 8 * (i >> 2)); const float df_ = (float)d_; \
                        const float e_ = df_ * (d_ > 0 ? lgf2 : lgb2n); float D_ = __builtin_amdgcn_exp2f(e_); D_ = (d_ == 0) ? 2.0f : D_; p[i] = acc[i] * D_; } } } } while (0)
        {
            LAS unsigned char* kbase = st + (MODE == 0 ? m * AT_KOFF : 0) + r * 144 + (8 * hh) * 2;
            LAS unsigned char* vbase = st + AT_VT + r * 144 + (8 * hh) * 2;
            bf16x8 kf0[4], kf1[4], vf[8];
#pragma unroll
            for (int kk = 0; kk < 4; ++kk) kf0[kk] = *(const LAS bf16x8*)(kbase + 32 * kk);
#pragma unroll
            for (int kk = 0; kk < 4; ++kk) kf1[kk] = *(const LAS bf16x8*)(kbase + 32 * 144 + 32 * kk);
#pragma unroll
            for (int dvb = 0; dvb < 4; ++dvb) { vf[2 * dvb] = *(const LAS bf16x8*)(vbase + dvb * 32 * 144); vf[2 * dvb + 1] = *(const LAS bf16x8*)(vbase + dvb * 32 * 144 + 32); }
            __builtin_amdgcn_sched_barrier(0);
            f32x16 acc0, acc1;
#pragma unroll
            for (int i = 0; i < 16; ++i) { acc0[i] = MODE == 0 ? -M2 : 0.f; acc1[i] = MODE == 0 ? -M2 : 0.f; }
#pragma unroll
            for (int kk = 0; kk < 4; ++kk) acc0 = MFMA32(kf0[kk], qf[kk], acc0);
#pragma unroll
            for (int kk = 0; kk < 4; ++kk) acc1 = MFMA32(kf1[kk], qf[kk], acc1);
            __builtin_amdgcn_sched_barrier(0);
            float p[16];
            SCORE_TO_P(acc0, 0, p);
            const bf16x8 pf00 = pack8(p[0], p[1], p[2], p[3], p[4], p[5], p[6], p[7]);
            const bf16x8 pf01 = pack8(p[8], p[9], p[10], p[11], p[12], p[13], p[14], p[15]);
            __builtin_amdgcn_sched_barrier(0);
#pragma unroll
            for (int dvb = 0; dvb < 4; ++dvb) O[dvb] = MFMA32(vf[2 * dvb], pf00, O[dvb]);
#pragma unroll
            for (int dvb = 0; dvb < 4; ++dvb) O[dvb] = MFMA32(vf[2 * dvb + 1], pf01, O[dvb]);
#pragma unroll
            for (int dvb = 0; dvb < 4; ++dvb) { vf[2 * dvb] = *(const LAS bf16x8*)(vbase + 64 + dvb * 32 * 144); vf[2 * dvb + 1] = *(const LAS bf16x8*)(vbase + 64 + dvb * 32 * 144 + 32); }
            SCORE_TO_P(acc1, 1, p);
            const bf16x8 pf10 = pack8(p[0], p[1], p[2], p[3], p[4], p[5], p[6], p[7]);
            const bf16x8 pf11 = pack8(p[8], p[9], p[10], p[11], p[12], p[13], p[14], p[15]);
            __builtin_amdgcn_sched_barrier(0);
#pragma unroll
            for (int dvb = 0; dvb < 4; ++dvb) O[dvb] = MFMA32(vf[2 * dvb], pf10, O[dvb]);
#pragma unroll
            for (int dvb = 0; dvb < 4; ++dvb) O[dvb] = MFMA32(vf[2 * dvb + 1], pf11, O[dvb]);
        }
#undef SCORE_TO_P
    }
    __syncthreads();
    if (MODE == 0) { const float linv = 1.0f / (lsum + shx(lsum, 32, lane));
#pragma unroll
        for (int d = 0; d < 4; ++d)
#pragma unroll
            for (int i = 0; i < 16; ++i) O[d][i] *= linv; }
    LAS float* ex = (LAS float*)(lds + g * 16384) + lane;
    if (MODE == 0 && m == 1) {
#pragma unroll
        for (int d = 0; d < 4; ++d)
#pragma unroll
            for (int i = 0; i < 16; ++i) ex[(d * 16 + i) * 64] = O[d][i];
    }
    __syncthreads();
    if (m == 0) {
        float ss = 0.f;
#pragma unroll
        for (int d = 0; d < 4; ++d)
#pragma unroll
            for (int i = 0; i < 16; ++i) { float o = O[d][i]; if (MODE == 0) { o -= lam * ex[(d * 16 + i) * 64]; O[d][i] = o; } ss += o * o; }
        ss += shx(ss, 32, lane);
        const float rr = (1.0f / sqrtf(ss * (1.f / 128.f) + NORM_EPS)) * oscale;
        const float* gout = MODE == 0 ? a.in[11] + l * 128 : a.in[14] + l * 128;
        const size_t trow = rowbase + nq;
        bf16* yo = (bf16*)(a.ws + (MODE == 0 ? WS_YB : WS_YC)) + trow * 512 + h * 128 + 4 * hh;
        const bf16* cg = proj + trow * NINP + C_CG + h * 128 + 4 * hh;
#pragma unroll
        for (int d = 0; d < 4; ++d)
#pragma unroll
            for (int q = 0; q < 4; ++q) {
                const int dv = 32 * d + 8 * q;
                const f32x4 gg = *(const f32x4*)(gout + dv + 4 * hh);
                float y0 = O[d][4 * q] * rr * gg.x, y1 = O[d][4 * q + 1] * rr * gg.y, y2 = O[d][4 * q + 2] * rr * gg.z, y3 = O[d][4 * q + 3] * rr * gg.w;
                if (MODE == 1) { const u32x2 cw = *(const u32x2*)(cg + dv);
                    const float c0 = bflo(cw.x), c1 = bfhi(cw.x), c2 = bflo(cw.y), c3 = bfhi(cw.y);
                    y0 *= c0 / (1.0f + __expf(-c0)); y1 *= c1 / (1.0f + __expf(-c1)); y2 *= c2 / (1.0f + __expf(-c2)); y3 *= c3 / (1.0f + __expf(-c3)); }
                u32x2 w; w.x = pk2(y0, y1); w.y = pk2(y2, y3); *(u32x2*)(yo + dv) = w;
            }
    }
    __syncthreads();
}

#ifndef PHM
#define PHM 0xFFFF
#endif
#ifndef DBL
#define DBL 0
#endif
#define REP(k) for (int rep_ = 0; rep_ < (((DBL >> (k)) & 1) ? 2 : 1); ++rep_)
#define PH(k) if constexpr ((PHM >> (k)) & 1)
#define XB_TMO      128
#define XB_XCNT(j)  (256  + 64 * (j))
#define XB_XSUB(j)  (1280 + 64 * (j))
#define XB_XGEN(j)  (2304 + 64 * (j))
#define XB_TOP      3328
#define XB_TOPGEN   3392
#define XCD_BAR_WORDS 3456
#define XB_SPIN_CAP (1u << 18)

__device__ __forceinline__ unsigned xb_ld(unsigned* p)              { return __hip_atomic_load(p, __ATOMIC_RELAXED, __HIP_MEMORY_SCOPE_AGENT); }
__device__ __forceinline__ unsigned xb_add(unsigned* p, unsigned v) { return __hip_atomic_fetch_add(p, v, __ATOMIC_RELAXED, __HIP_MEMORY_SCOPE_AGENT); }
__device__ __forceinline__ unsigned xb_xcc_id() { return (unsigned)__builtin_amdgcn_s_getreg((3 << 11) | 20) & 0xFu; }
#define XB_SPIN(cond, bar) do { unsigned _sp = 0; while (cond) { __builtin_amdgcn_s_sleep(1); \
    if ((++_sp & 255u) == 0u) { if (xb_ld(&(bar)[XB_TMO])) break; if (_sp > XB_SPIN_CAP) { atomicAdd(&(bar)[XB_TMO], 1u); break; } } } } while (0)

struct XcdBarrier {
    unsigned* bar; unsigned x;
    volatile LAS unsigned* st;
};

__device__ __forceinline__ XcdBarrier xcd_barrier_post(unsigned* bar, volatile LAS unsigned* st) {
    XcdBarrier b; b.bar = bar; b.x = xb_xcc_id(); b.st = st;
    if (threadIdx.x == 0) (void)xb_add(&bar[XB_XCNT(b.x)], 1u);
    return b;
}
__device__ __forceinline__ void xcd_barrier_complete(unsigned* bar, unsigned x, unsigned& nloc, unsigned& nx) {
    const unsigned G = gridDim.x * gridDim.y * gridDim.z;
    unsigned sum, cnt, mine, sp = 0u;
    for (;;) {
        sum = 0u; cnt = 0u; mine = 0u;
#pragma unroll
        for (unsigned j = 0; j < 16; ++j) { const unsigned c = xb_ld(&bar[XB_XCNT(j)]); sum += c; cnt += (c > 0u) ? 1u : 0u; mine = (j == x) ? c : mine; }
        if (sum == G) break;
        __builtin_amdgcn_s_sleep(1);
        if ((++sp & 255u) == 0u) { if (xb_ld(&bar[XB_TMO])) break; if (sp > XB_SPIN_CAP) { atomicAdd(&bar[XB_TMO], 1u); break; } }
    }
    nloc = mine > 0u ? mine : 1u; nx = cnt > 0u ? cnt : 1u;
}

__device__ __forceinline__ void xcd_barrier(const XcdBarrier& b) {
    asm volatile("s_waitcnt vmcnt(0)" ::: "memory");
    __syncthreads();
    if (threadIdx.x == 0) {
        unsigned* bar = b.bar;
        __builtin_amdgcn_s_waitcnt(0);
        unsigned nloc = b.st[0], nx = b.st[1];
        if (nloc == 0u) { xcd_barrier_complete(bar, b.x, nloc, nx); b.st[0] = nloc; b.st[1] = nx; }
        const unsigned old = xb_add(&bar[XB_XSUB(b.x)], 1u);
        const unsigned gen = old / nloc;
        if (old + 1u == (gen + 1u) * nloc) {
            __builtin_amdgcn_fence(__ATOMIC_RELEASE, "agent");
            asm volatile("s_waitcnt vmcnt(0)" ::: "memory");
            const unsigned og = xb_add(&bar[XB_TOP], 1u);
            const unsigned tg = og / nx;
            if (og + 1u == (tg + 1u) * nx) xb_add(&bar[XB_TOPGEN], 1u);
            else XB_SPIN(xb_ld(&bar[XB_TOPGEN]) == tg, bar);
            __builtin_amdgcn_fence(__ATOMIC_ACQUIRE, "agent");
            xb_add(&bar[XB_XGEN(b.x)], 1u);
            asm volatile("s_waitcnt vmcnt(0)" ::: "memory");
        } else {
            XB_SPIN(xb_ld(&bar[XB_XGEN(b.x)]) == gen, bar);
            __builtin_amdgcn_fence(__ATOMIC_ACQUIRE, "agent");
            asm volatile("s_waitcnt vmcnt(0)" ::: "memory");
        }
    }
    __syncthreads();
}

typedef __attribute__((address_space(4))) const Args* CArgsP;
__device__ __forceinline__ Args load_args() {
    Args r{};
#if defined(__HIP_DEVICE_COMPILE__)
    CArgsP p = (CArgsP)__builtin_amdgcn_kernarg_segment_ptr(); asm volatile("" : "+s"(p));
#pragma unroll
    for (int i = 0; i < 22; ++i) r.in[i] = p->in[i];
    r.out = p->out; r.ws = p->ws;
#endif
    return r;
}
#define TIDS() const int tid = otid(), lane = tid & 63, wave = __builtin_amdgcn_readfirstlane(tid >> 6), gw = bx * NWAVES + wave, gtid = bx * NTHR + tid; (void)lane; (void)gw; (void)gtid
__global__ void __launch_bounds__(NTHR, 2) fwd_megakernel(Args a_unused) {
    extern __shared__ __attribute__((aligned(16))) unsigned char lds_raw[];
    LAS unsigned char* lds = (LAS unsigned char*)lds_raw;
    cg::grid_group grid = cg::this_grid();
    const int G = gridDim.x, bx = blockIdx.x;
    const int NGW = G * NWAVES, NT = G * NTHR;
    if (threadIdx.x < 2) ((volatile LAS unsigned*)(lds + MISC_OFF))[threadIdx.x] = 0u;
    __syncthreads();
    { const Args a = load_args(); (void)xcd_barrier_post((unsigned*)(a.ws + WS_CTL), (volatile LAS unsigned*)(lds + MISC_OFF)); }
#define GSYNC() do { const Args a_ = load_args(); XcdBarrier b_; b_.bar = (unsigned*)(a_.ws + WS_CTL); b_.x = xb_xcc_id(); b_.st = (volatile LAS unsigned*)(lds + MISC_OFF); xcd_barrier(b_); } while (0)

    for (int l = 0; l < DEPTH; ++l) {
        PH(0) REP(0) { const Args a = load_args(); TIDS(); phase_prep(a, l, lds, gw, NGW, wave, lane, (l == 0) ? a.in[0] : a.out); }
        { const Args a_ = load_args(); if (a_.ws == nullptr) grid.sync(); }
        GSYNC();
        if constexpr ((DBL >> 8) & 1) { for (int i_ = 0; i_ < 10; ++i_) GSYNC(); }
        PH(1) REP(1) { const Args a = load_args(); unsigned char* ws = a.ws;
          pg8::Gemm g{(const bf16*)(ws + WS_ACT), (const bf16*)(ws + WS_WIN), M, NINP, DM}; pg8::StaticOrder S; S.init(M, NINP, G, bx, 6);
          pg8::EpiStore<0> E{(bf16*)(ws + WS_PROJ), NINP};
          pg8::gemm_phase<pg8::EpiStore<0>, pg8::StaticOrder, true, true>(lds, g, S, E); }
        GSYNC();
        PH(2) { const Args a = load_args(); TIDS(); phase_postproj(a, l, gtid, NT, lane);
                for (int it = gw; it < 2048; it += NGW) { const int c = it >> 10;
                    vt_item((const bf16*)(a.ws + WS_PROJ), (bf16*)(a.ws + (c ? WS_VTC : WS_VTB)), c ? C_CV : C_BV, it & 1023, lds + wave * 17408, lane); } }
        GSYNC();
        {
            const Args a = load_args(); TIDS();
            PH(5) { if (G == 256) { if (bx >= 128) for (int it = bx - 128; it < 256; it += 128) ret_state_item(a, l, it, lds); }
                    else for (int it = bx; it < 256; it += G) ret_state_item(a, l, it, lds); }
            PH(3) {
            const float gqa = wave_max(fabsf(a.in[3][l * 64 + lane]), lane), gka = wave_max(fabsf(a.in[4][l * 64 + lane]), lane);
            const float M2a = 8.0f * LOG2E * gqa * gka;
            REP(2) for (int it = gw; it < 3072; it += NGW) attn_a_item(a, it, lds + wave * 16384, lane, M2a);
            }
            __syncthreads();
            PH(4) {
            const float gqb = wave_max(fabsf(a.in[5][l * 64 + lane]), lane), gkb = wave_max(fabsf(a.in[6][l * 64 + lane]), lane);
            const float M2b = 8.0f * LOG2E * gqb * gkb;
            const float lam_init = 0.8f - 0.6f * expf(-0.3f * (float)l);
            const float s1 = wave_sum(a.in[7][l * 64 + lane] * a.in[8][l * 64 + lane], lane), s2 = wave_sum(a.in[9][l * 64 + lane] * a.in[10][l * 64 + lane], lane);
            const float lam = expf(s1) - expf(s2) + lam_init;
            REP(3) for (int u0 = bx; u0 < 512; u0 += G) { const int v = u0 & 255, u = (((v & 7) * 2 + (v >> 7)) + 16 * (u0 >> 8)) * 16 + ((v >> 3) & 15); attn_dense_unit<0>(a, l, u, lds, M2b, lam, 1.0f - lam_init); }
            }
        }
        GSYNC();
        {
            const Args a = load_args(); TIDS();
            PH(5) REP(4) for (int u0 = bx; u0 < 256; u0 += G) { const int u = ((u0 & 7) * 4 + (u0 >> 6)) * 8 + ((u0 >> 3) & 7); attn_dense_unit<1>(a, l, u, lds, 0.f, 0.f, 1.0f); }
            const float* lA = (const float*)(a.ws + WS_LA); bf16* ya = (bf16*)(a.ws + WS_YA);
            for (int e0 = gtid; e0 < M * 48; e0 += 3 * NT) {
                u32x4 w[3]; float lt[3]; u32x4* pp[3];
#pragma unroll
                for (int q = 0; q < 3; ++q) { int e = e0 + q * NT; e = e < M * 48 ? e : e0; const int t = e / 48, ch = e % 48, hg = (ch >> 3) & 1;
                    lt[q] = lA[t * 6 + hg] + lA[t * 6 + 2 + hg] + lA[t * 6 + 4 + hg]; pp[q] = (u32x4*)(ya + (size_t)t * 384 + ch * 8); w[q] = *pp[q]; }
#pragma unroll
                for (int q = 0; q < 3; ++q) { const float li = 1.0f / lt[q]; u32x4 v = w[q];
                    v.x = pk2(bflo(v.x) * li, bfhi(v.x) * li); v.y = pk2(bflo(v.y) * li, bfhi(v.y) * li);
                    v.z = pk2(bflo(v.z) * li, bfhi(v.z) * li); v.w = pk2(bflo(v.w) * li, bfhi(v.w) * li); *pp[q] = v; }
            }
        }
        GSYNC();
        PH(6) {
          { const Args a = load_args(); unsigned char* ws = a.ws; pg8::StaticOrder S; S.init(M, DM, G, bx);
            pg8::Gemm g{(const bf16*)(ws + WS_YA), (const bf16*)(ws + WS_WBRA), M, DM, 384}; pg8::EpiGate<0> E{(const bf16*)(ws + WS_PROJ) + C_GATE, NINP, nullptr, (bf16*)(ws + WS_T1)};
            pg8::gemm_phase<pg8::EpiGate<0>, pg8::StaticOrder, true, true>(lds, g, S, E); }
          { const Args a = load_args(); unsigned char* ws = a.ws; pg8::StaticOrder S; S.init(M, DM, G, bx);
            pg8::Gemm g{(const bf16*)(ws + WS_YB), (const bf16*)(ws + WS_WBRB), M, DM, 512}; pg8::EpiGate<1> E{(const bf16*)(ws + WS_PROJ) + C_GATE + 1024, NINP, (const bf16*)(ws + WS_T1), (bf16*)(ws + WS_T2)};
            pg8::gemm_phase<pg8::EpiGate<1>, pg8::StaticOrder, true, true>(lds, g, S, E); }
          { const Args a = load_args(); unsigned char* ws = a.ws; pg8::StaticOrder S; S.init(M, DM, G, bx);
            pg8::Gemm g{(const bf16*)(ws + WS_YC), (const bf16*)(ws + WS_WBRC), M, DM, 512}; pg8::EpiGate<1> E{(const bf16*)(ws + WS_PROJ) + C_GATE + 2048, NINP, (const bf16*)(ws + WS_T2), (bf16*)(ws + WS_ACT)};
            pg8::gemm_phase<pg8::EpiGate<1>, pg8::StaticOrder, true, true>(lds, g, S, E); } }
        GSYNC();
        PH(7) { const Args a = load_args(); unsigned char* ws = a.ws;
          pg8::Gemm g{(const bf16*)(ws + WS_ACT), (const bf16*)(ws + WS_WO), M, DM, DM}; pg8::StaticOrder S; S.init(M, DM, G, bx);
          pg8::EpiResid E{(l == 0) ? a.in[0] : a.out, a.out};
          pg8::gemm_phase<pg8::EpiResid, pg8::StaticOrder, true, true>(lds, g, S, E); }
        GSYNC();
        { const Args a = load_args(); TIDS(); const float* g2 = a.in[19] + (size_t)l * DM; bf16* act = (bf16*)(a.ws + WS_ACT);
          rms_rows_to_bf16(a.out, g2, act, gw, NGW, lane); }
        GSYNC();
        PH(8) { const Args a = load_args(); unsigned char* ws = a.ws;
          pg8::Gemm g{(const bf16*)(ws + WS_ACT), (const bf16*)(ws + WS_W1), M, DFF, DM}; pg8::StaticOrder S; S.init(M, DFF, G, bx, 6);
          pg8::EpiStore<1> E{(bf16*)(ws + WS_H), DFF};
          pg8::gemm_phase<pg8::EpiStore<1>, pg8::StaticOrder, true, true>(lds, g, S, E); }
        GSYNC();
        PH(9) { const Args a = load_args(); unsigned char* ws = a.ws;
          pg8::Gemm g{(const bf16*)(ws + WS_H), (const bf16*)(ws + WS_W2), M, DM, DFF}; pg8::StaticOrder S; S.init(M, DM, G, bx);
          pg8::EpiResid E{a.out, a.out};
          pg8::gemm_phase<pg8::EpiResid, pg8::StaticOrder, true, true>(lds, g, S, E); }
        GSYNC();
    }
}

extern "C" void kernel_launch(void* const* d_in, const int* in_sizes, int n_in, void* d_out, int out_size, void* d_ws, size_t ws_size, hipStream_t stream) {
    static int grid = 0;
    if (grid == 0) {
        if (n_in != 22 || out_size != M * DM || ws_size < WS_CTL + CTL_BYTES) { fprintf(stderr, "kernel_launch: unexpected shapes (n_in %d out %d ws %zu)\n", n_in, out_size, ws_size); grid = -1; return; }
        int dev = 0, cus = 0, per_cu = 0;
        hipGetDevice(&dev); hipDeviceGetAttribute(&cus, hipDeviceAttributeMultiprocessorCount, dev);
        hipFuncSetAttribute((const void*)fwd_megakernel, hipFuncAttributeMaxDynamicSharedMemorySize, LDS_BYTES);
        hipOccupancyMaxActiveBlocksPerMultiprocessor(&per_cu, (const void*)fwd_megakernel, NTHR, LDS_BYTES);
        if (per_cu < 1) { fprintf(stderr, "kernel_launch: occupancy query says %d blocks/CU\n", per_cu); per_cu = 1; }
        (void)hipGetLastError();
        grid = cus;
    }
    if (grid < 0) return;
    if (hipMemsetAsync((char*)d_ws + WS_CTL, 0, CTL_BYTES, stream) != hipSuccess) { fprintf(stderr, "kernel_launch: memset failed\n"); return; }
    Args a{};
    for (int i = 0; i < 22; ++i) a.in[i] = (const float*)d_in[i];
    a.out = (float*)d_out; a.ws = (unsigned char*)d_ws;
    void* args[] = {&a};
    hipError_t e = hipLaunchCooperativeKernel((const void*)fwd_megakernel, dim3(grid), dim3(NTHR), args, LDS_BYTES, stream);
    if (e != hipSuccess) fprintf(stderr, "cooperative launch failed: %s (grid %d)\n", hipGetErrorString(e), grid);
}
```

```cpp
#include <hip/hip_runtime.h>
#include <hip/hip_cooperative_groups.h>
#include <cstdio>
#include <cstdint>
namespace cg = cooperative_groups;
namespace pg8 {
#define PG8_LAS __attribute__((address_space(3)))
typedef unsigned short bf16_t;
typedef short bf16x8 __attribute__((ext_vector_type(8)));
typedef float f32x4 __attribute__((ext_vector_type(4)));
typedef unsigned u32x4 __attribute__((ext_vector_type(4)));
constexpr int BM = 256, BK = 64, HALF = 128, HTB = HALF * BK * 2  , STAGE_BYTES = 8 * HTB, NXCD = 8, WGM = 8;

__host__ __device__ __forceinline__ int lds_byte(int r, int c) { const int st = (r >> 4) * 2 + (c >> 5), rr = r & 15, cc = c & 31, ob = rr * 64 + cc * 2; return st * 1024 + (ob ^ (((ob >> 9) & 1) << 5)); }
__host__ __device__ __forceinline__ void stage_rc(int b, int& R, int& C) { const int st = b / 1024, sb = b % 1024, swz = sb ^ (((sb >> 9) & 1) << 5); R = (st >> 1) * 16 + swz / 64; C = (st & 1) * 32 + (swz % 64) / 2; }
__host__ __device__ __forceinline__ int perm32(int rho) { const int n = rho >> 4, i = rho & 15; return 8 * (i >> 2) + 4 * n + (i & 3); }

struct Unit { int pm, pn; };
struct Gemm { const bf16_t* A; const bf16_t* Bt; int M, N, K; };

struct StaticOrder {
    int nM, nN, nwg, G, c, wgm;
    __host__ __device__ void init(int M, int N, int G_, int c_, int wgm_ = 8) { nM = M / BM; nN = N / BM; nwg = nM * nN; G = G_; c = c_; wgm = wgm_; }
    __host__ __device__ bool next(int i, Unit& u) const {
        const long L = (long)i * G + c; if (L >= nwg) return false;
        int wgid = (int)L; { const int q = nwg / NXCD, r = nwg % NXCD, xcd = wgid % NXCD, off = wgid / NXCD; wgid = (xcd < r ? xcd * (q + 1) : r * (q + 1) + (xcd - r) * q) + off; }
        const int nig = wgm * nN, gid = wgid / nig, fm = gid * wgm, gsz = (nM - fm) < wgm ? (nM - fm) : wgm;
        u.pm = fm + ((wgid % nig) % gsz); u.pn = (wgid % nig) / gsz; return true;
    }
    __device__ __forceinline__ void a_ready(const Unit&) const {}
    __device__ __forceinline__ void done(const Unit&) const {}
};

__device__ __forceinline__ unsigned cvt_pk_bf16(float lo, float hi) { unsigned r; asm volatile("v_cvt_pk_bf16_f32 %0, %1, %2" : "=v"(r) : "v"(lo), "v"(hi)); return r; }
typedef float f32x2 __attribute__((ext_vector_type(2)));
typedef unsigned u32x2 __attribute__((ext_vector_type(2)));
__device__ __forceinline__ float bflo(unsigned w) { return __uint_as_float(w << 16); }
__device__ __forceinline__ float bfhi(unsigned w) { return __uint_as_float(w & 0xffff0000u); }
template <int ACT> struct EpiStore {
    static constexpr bool PERM = true, AFTER_DRAIN = false;
    bf16_t* O; int ldc;
    __device__ __forceinline__ void operator()(const f32x4 (&acc)[2][2][4][2], const Unit& u, int wr, int wc, int fr, int fq) const {
        const int row0 = u.pm * BM + wr * 64 + fr, col0 = u.pn * BM + wc * 32 + 8 * fq;
#pragma unroll
        for (int ai = 0; ai < 2; ++ai)
#pragma unroll
            for (int m = 0; m < 4; ++m) { const unsigned off = ((unsigned)(row0 + ai * HALF + m * 16) * (unsigned)ldc + (unsigned)col0) * 2u;
#pragma unroll
                for (int bj = 0; bj < 2; ++bj) { f32x4 v0 = acc[ai][bj][m][0], v1 = acc[ai][bj][m][1];
                    if (ACT == 1) {
#pragma unroll
                        for (int e = 0; e < 4; ++e) { float a = fmaxf(v0[e], 0.f), b = fmaxf(v1[e], 0.f); v0[e] = a * a; v1[e] = b * b; } }
                    u32x4 w; w.x = cvt_pk_bf16(v0[0], v0[1]); w.y = cvt_pk_bf16(v0[2], v0[3]); w.z = cvt_pk_bf16(v1[0], v1[1]); w.w = cvt_pk_bf16(v1[2], v1[3]);
                    *(u32x4*)((char*)O + off + (unsigned)(bj * HALF) * 2u) = w; } }
    }
};
template <int HAS_IN> struct EpiGate {
    static constexpr bool PERM = true, AFTER_DRAIN = false;
    const bf16_t* gate; int ldg; const bf16_t* Tin; bf16_t* Tout;
    __device__ __forceinline__ void operator()(const f32x4 (&acc)[2][2][4][2], const Unit& u, int wr, int wc, int fr, int fq) const {
        const int row0 = u.pm * BM + wr * 64 + fr, col0 = u.pn * BM + wc * 32 + 8 * fq;
#pragma unroll
        for (int ai = 0; ai < 2; ++ai)
#pragma unroll
            for (int mp = 0; mp < 2; ++mp) {
                u32x4 gw[2][2], tw[2][2];
#pragma unroll
                for (int mm = 0; mm < 2; ++mm)
#pragma unroll
                    for (int bj = 0; bj < 2; ++bj) { const unsigned row = (unsigned)(row0 + ai * HALF + (2 * mp + mm) * 16);
                        gw[mm][bj] = *(const u32x4*)((const char*)gate + (row * (unsigned)ldg + (unsigned)(col0 + bj * HALF)) * 2u);
                        if (HAS_IN) tw[mm][bj] = *(const u32x4*)((const char*)Tin + (row * 1024u + (unsigned)(col0 + bj * HALF)) * 2u); else tw[mm][bj] = (u32x4){0u, 0u, 0u, 0u}; }
                asm volatile("" ::: "memory");
#pragma unroll
                for (int mm = 0; mm < 2; ++mm)
#pragma unroll
                    for (int bj = 0; bj < 2; ++bj) { const int m = 2 * mp + mm; const unsigned row = (unsigned)(row0 + ai * HALF + m * 16);
                        const f32x4 v0 = acc[ai][bj][m][0], v1 = acc[ai][bj][m][1]; const u32x4 g4 = gw[mm][bj], t4 = tw[mm][bj];
                        const float gg[8] = {bflo(g4.x), bfhi(g4.x), bflo(g4.y), bfhi(g4.y), bflo(g4.z), bfhi(g4.z), bflo(g4.w), bfhi(g4.w)};
                        const float ti[8] = {bflo(t4.x), bfhi(t4.x), bflo(t4.y), bfhi(t4.y), bflo(t4.z), bfhi(t4.z), bflo(t4.w), bfhi(t4.w)};
                        float o[8];
#pragma unroll
                        for (int e = 0; e < 8; ++e) { const float s = __builtin_amdgcn_rcpf(1.0f + __builtin_amdgcn_exp2f(-1.4426950408889634f * gg[e])); o[e] = ti[e] + s * (e < 4 ? v0[e & 3] : v1[e & 3]); }
                        u32x4 w; w.x = cvt_pk_bf16(o[0], o[1]); w.y = cvt_pk_bf16(o[2], o[3]); w.z = cvt_pk_bf16(o[4], o[5]); w.w = cvt_pk_bf16(o[6], o[7]);
                        *(u32x4*)((char*)Tout + (row * 1024u + (unsigned)(col0 + bj * HALF)) * 2u) = w; }
                asm volatile("" ::: "memory"); }
    }
};
struct EpiResid {
    static constexpr bool PERM = false, AFTER_DRAIN = false;
    const float* base; float* out;
    __device__ __forceinline__ void operator()(const f32x4 (&acc)[2][2][4][2], const Unit& u, int wr, int wc, int fr, int fq) const {
        const int row0 = u.pm * BM + wr * 64 + fr, col0 = u.pn * BM + wc * 32 + 4 * fq;
        f32x4 bs[2][2][2][2];
#define ER_LOAD(c) do { _Pragma("unroll") for (int mm = 0; mm < 2; ++mm) _Pragma("unroll") for (int bj = 0; bj < 2; ++bj) _Pragma("unroll") for (int n = 0; n < 2; ++n) \
            bs[(c) & 1][mm][bj][n] = *(const f32x4*)((const char*)base + ((unsigned)(row0 + ((c) >> 1) * HALF + (2 * ((c) & 1) + mm) * 16) * 1024u + (unsigned)(col0 + bj * HALF + n * 16)) * 4u); } while (0)
        ER_LOAD(0);
#pragma unroll
        for (int c = 0; c < 4; ++c) {
            if (c + 1 < 4) ER_LOAD(c + 1);
            const int ai = c >> 1, mp = c & 1;
#pragma unroll
            for (int mm = 0; mm < 2; ++mm)
#pragma unroll
                for (int bj = 0; bj < 2; ++bj)
#pragma unroll
                    for (int n = 0; n < 2; ++n) *(f32x4*)((char*)out + ((unsigned)(row0 + ai * HALF + (2 * mp + mm) * 16) * 1024u + (unsigned)(col0 + bj * HALF + n * 16)) * 4u) = bs[c & 1][mm][bj][n] + acc[ai][bj][2 * mp + mm][n];
        }
#undef ER_LOAD
    }
};

template <class Epi, class Sched, bool ALIGN_EPI = false, bool SP2 = false>
__device__ __forceinline__ void gemm_phase(PG8_LAS unsigned char* lds, const Gemm g, const Sched& S, const Epi& E) {
    int tid_ = threadIdx.x; asm volatile("" : "+v"(tid_));
    const int tid = tid_, wid = __builtin_amdgcn_readfirstlane(tid >> 6), lane = tid & 63, wr = wid >> 2, wc = wid & 3, fr = lane & 15, fq = lane >> 4;
    const int K = g.K, nt = K / BK;
    unsigned voffA[2], voffB[2];
#pragma unroll
    for (int i = 0; i < 2; ++i) { int R, C; stage_rc(tid * 16 + i * 8192, R, C); const int Rb = Epi::PERM ? ((R & ~31) + perm32(R & 31)) : R;
        voffA[i] = (unsigned)(R * K + C) * 2u; voffB[i] = (unsigned)(Rb * K + C) * 2u; }
    const size_t kstep = (size_t)(BK * 2);
    const size_t hstep = (size_t)HALF * K * 2;
    const size_t tstep = 2 * hstep;
    const unsigned ldsw = (unsigned)wid * 1024u;
    const int aoff = lds_byte(wr * 64 + fr, fq * 8), boff = lds_byte(wc * 32 + fr, fq * 8);
#define PG8_SA(b, h) (((b) * 2 + (h)) * HTB)
#define PG8_SB(b, h) ((4 + (b) * 2 + (h)) * HTB)
#define PG8_STAGE(bufoff, gbase, voff) do { _Pragma("unroll") for (int _i = 0; _i < 2; ++_i) \
        __builtin_amdgcn_global_load_lds((const unsigned*)((const char*)(gbase) + (voff)[_i]), (PG8_LAS unsigned*)(lds + (bufoff) + ldsw + _i * 8192), 16, 0, 0); } while (0)
#define PG8_LDA(dst, b, h) do { _Pragma("unroll") for (int m = 0; m < 4; ++m) _Pragma("unroll") for (int k = 0; k < 2; ++k) dst[m][k] = *(const PG8_LAS bf16x8*)(lds + PG8_SA(b, h) + aoff + m * 2048 + k * 1024); } while (0)
#define PG8_LDB(dst, b, h) do { _Pragma("unroll") for (int n = 0; n < 2; ++n) _Pragma("unroll") for (int k = 0; k < 2; ++k) dst[n][k] = *(const PG8_LAS bf16x8*)(lds + PG8_SB(b, h) + boff + n * 2048 + k * 1024); } while (0)
#define PG8_MMA(ai, bj, At, Bt) do { __builtin_amdgcn_s_setprio(1); _Pragma("unroll") for (int m = 0; m < 4; ++m) _Pragma("unroll") for (int n = 0; n < 2; ++n) _Pragma("unroll") for (int k = 0; k < 2; ++k) \
        acc[ai][bj][m][n] = __builtin_amdgcn_mfma_f32_16x16x32_bf16(Bt[n][k], At[m][k], acc[ai][bj][m][n], 0, 0, 0); __builtin_amdgcn_s_setprio(0); } while (0)
#define PG8_WAIT_V(n) asm volatile("s_waitcnt vmcnt(" #n ")" ::: "memory")
#define PG8_WAIT_L(n) asm volatile("s_waitcnt lgkmcnt(" #n ")" ::: "memory")
#define PG8_BAR __builtin_amdgcn_s_barrier()
#define PG8_SCHED __builtin_amdgcn_sched_barrier(0)
    Unit cur, nxt; int ui = 0;
    if (!S.next(0, cur)) return;
    f32x4 acc[2][2][4][2];
#pragma unroll
    for (int a = 0; a < 2; ++a)
#pragma unroll
        for (int b = 0; b < 2; ++b)
#pragma unroll
            for (int m = 0; m < 4; ++m)
#pragma unroll
                for (int n = 0; n < 2; ++n) acc[a][b][m][n] = (f32x4){0.f, 0.f, 0.f, 0.f};
    bf16x8 At[4][2], B0[2][2], B1[2][2];
    const char* cA = (const char*)g.A + (size_t)cur.pm * tstep; const char* cB = (const char*)g.Bt + (size_t)cur.pn * tstep;
    S.a_ready(cur);
    if constexpr (SP2) {
        PG8_STAGE(PG8_SB(0, 0), cB, voffB); PG8_STAGE(PG8_SB(0, 1), cB + hstep, voffB); PG8_STAGE(PG8_SA(0, 0), cA, voffA); PG8_STAGE(PG8_SA(0, 1), cA + hstep, voffA);
        if (wr == 1) PG8_BAR;
        PG8_WAIT_V(2); PG8_BAR;
        PG8_STAGE(PG8_SB(1, 0), cB + kstep, voffB); PG8_STAGE(PG8_SA(1, 0), cA + kstep, voffA); PG8_STAGE(PG8_SB(1, 1), cB + hstep + kstep, voffB);
        PG8_WAIT_V(6); PG8_BAR;
    } else {
        PG8_STAGE(PG8_SB(0, 0), cB, voffB); PG8_STAGE(PG8_SA(0, 0), cA, voffA); PG8_STAGE(PG8_SB(0, 1), cB + hstep, voffB); PG8_STAGE(PG8_SA(0, 1), cA + hstep, voffA);
        if (wr == 1) PG8_BAR;
        PG8_WAIT_V(4); PG8_BAR;
        PG8_STAGE(PG8_SB(1, 0), cB + kstep, voffB); PG8_STAGE(PG8_SA(1, 0), cA + kstep, voffA); PG8_STAGE(PG8_SB(1, 1), cB + hstep + kstep, voffB);
        PG8_WAIT_V(6); PG8_BAR;
    }
    for (;;) {
        const bool has_next = S.next(ui + 1, nxt);
        const char* nA = has_next ? (const char*)g.A + (size_t)nxt.pm * tstep : cA; const char* nB = has_next ? (const char*)g.Bt + (size_t)nxt.pn * tstep : cB;
        for (int t = 0; t < nt; t += 2) {
            const bool last = (t == nt - 2);
            const char* a1 = cA + (size_t)(t + 1) * kstep;
            const char* a2 = last ? nA : cA + (size_t)(t + 2) * kstep; const char* b2 = last ? nB : cB + (size_t)(t + 2) * kstep;
            const char* a3 = a2 + kstep; const char* b3 = b2 + kstep;
            if (last && has_next) S.a_ready(nxt);
            if constexpr (SP2) {
            PG8_LDB(B0, 0, 0); PG8_LDB(B1, 0, 1); PG8_SCHED; PG8_LDA(At, 0, 0); PG8_STAGE(PG8_SA(1, 1), a1 + hstep, voffA);
            PG8_WAIT_V(8); PG8_WAIT_L(0); PG8_BAR; PG8_MMA(0, 0, At, B0); PG8_MMA(0, 1, At, B1); PG8_BAR; PG8_SCHED;
            PG8_LDA(At, 0, 1); PG8_STAGE(PG8_SB(0, 0), b2, voffB); PG8_STAGE(PG8_SB(0, 1), b2 + hstep, voffB); PG8_STAGE(PG8_SA(0, 0), a2, voffA);
            PG8_WAIT_V(8); PG8_WAIT_L(0); PG8_BAR; PG8_MMA(1, 0, At, B0); PG8_MMA(1, 1, At, B1); PG8_BAR; PG8_SCHED;
            PG8_LDB(B0, 1, 0); PG8_LDB(B1, 1, 1); PG8_SCHED; PG8_LDA(At, 1, 0); PG8_STAGE(PG8_SA(0, 1), a2 + hstep, voffA);
            PG8_WAIT_V(8); PG8_WAIT_L(0); PG8_BAR; PG8_MMA(0, 0, At, B0); PG8_MMA(0, 1, At, B1); PG8_BAR; PG8_SCHED;
            PG8_LDA(At, 1, 1); PG8_STAGE(PG8_SB(1, 0), b3, voffB); PG8_STAGE(PG8_SB(1, 1), b3 + hstep, voffB); PG8_STAGE(PG8_SA(1, 0), a3, voffA);
            PG8_WAIT_V(8); PG8_WAIT_L(0); PG8_BAR; PG8_MMA(1, 0, At, B0); PG8_MMA(1, 1, At, B1); PG8_BAR; PG8_SCHED;
            } else {
            PG8_LDB(B0, 0, 0); PG8_SCHED; PG8_LDA(At, 0, 0); PG8_STAGE(PG8_SA(1, 1), a1 + hstep, voffA);
            PG8_WAIT_L(8); PG8_BAR; PG8_WAIT_L(0); PG8_MMA(0, 0, At, B0); PG8_BAR; PG8_SCHED;
            PG8_LDB(B1, 0, 1); PG8_STAGE(PG8_SB(0, 0), b2, voffB);
            PG8_BAR; PG8_WAIT_L(0); PG8_MMA(0, 1, At, B1); PG8_BAR;
            PG8_LDA(At, 0, 1); PG8_STAGE(PG8_SA(0, 0), a2, voffA);
            PG8_BAR; PG8_WAIT_L(0); PG8_MMA(1, 0, At, B0); PG8_BAR; PG8_SCHED;
            PG8_STAGE(PG8_SB(0, 1), b2 + hstep, voffB);
            PG8_WAIT_V(6); PG8_BAR; PG8_MMA(1, 1, At, B1); PG8_BAR;
            PG8_LDB(B0, 1, 0); PG8_SCHED; PG8_LDA(At, 1, 0); PG8_STAGE(PG8_SA(0, 1), a2 + hstep, voffA);
            PG8_WAIT_L(8); PG8_BAR; PG8_WAIT_L(0); PG8_MMA(0, 0, At, B0); PG8_BAR; PG8_SCHED;
            PG8_LDB(B1, 1, 1); PG8_STAGE(PG8_SB(1, 0), b3, voffB);
            PG8_BAR; PG8_WAIT_L(0); PG8_MMA(0, 1, At, B1); PG8_BAR;
            PG8_LDA(At, 1, 1); PG8_STAGE(PG8_SA(1, 0), a3, voffA);
            PG8_BAR; PG8_WAIT_L(0); PG8_MMA(1, 0, At, B0); PG8_BAR; PG8_SCHED;
            PG8_STAGE(PG8_SB(1, 1), b3 + hstep, voffB);
            PG8_WAIT_V(6); PG8_BAR; PG8_MMA(1, 1, At, B1); PG8_BAR;
            }
        }
        if constexpr (ALIGN_EPI) { if (wr == 0) PG8_BAR; }
        if constexpr (!Epi::AFTER_DRAIN) { E(acc, cur, wr, wc, fr, fq); S.done(cur); }
        if (!has_next) break;
#pragma unroll
        for (int a = 0; a < 2; ++a)
#pragma unroll
            for (int b = 0; b < 2; ++b)
#pragma unroll
                for (int m = 0; m < 4; ++m)
#pragma unroll
                    for (int n = 0; n < 2; ++n) acc[a][b][m][n] = (f32x4){0.f, 0.f, 0.f, 0.f};
        cur = nxt; cA = nA; cB = nB; ++ui;
        if constexpr (ALIGN_EPI) { if (wr == 1) PG8_BAR; }
    }
    PG8_WAIT_V(0);
    if constexpr (!ALIGN_EPI) { if (wr == 0) PG8_BAR; }
    PG8_BAR;
    if constexpr (Epi::AFTER_DRAIN) { E.fused(acc, cur, wr, wc, fr, fq, lds, wid, lane); S.done(cur); }
#undef PG8_SA
#undef PG8_SB
#undef PG8_STAGE
#undef PG8_LDA
#undef PG8_LDB
#undef PG8_MMA
#undef PG8_WAIT_V
#undef PG8_WAIT_L
#undef PG8_BAR
#undef PG8_SCHED
}
}

#define LAS __attribute__((address_space(3)))
typedef unsigned short bf16;
typedef short bf16x8 __attribute__((ext_vector_type(8)));
typedef float f32x4 __attribute__((ext_vector_type(4)));
typedef float f32x16 __attribute__((ext_vector_type(16)));
typedef unsigned u32x4 __attribute__((ext_vector_type(4)));
typedef unsigned u32x2 __attribute__((ext_vector_type(2)));
constexpr int NWAVES = 8, NTHR = 512;
constexpr int SEQ = 2048, NBATCH = 8, M = NBATCH * SEQ, DM = 1024, NIN = 7296, NINP = 7424, DFF = 4096, DEPTH = 4;
constexpr int C_AQ = 0, C_AK = 384, C_AV = 768, C_BQ = 1152, C_BK = 1664, C_BV = 2176, C_CQ = 2688, C_CK = 2944, C_CV = 3200, C_CG = 3712, C_GATE = 4224;
constexpr float NORM_EPS = 1e-6f, LOG2E = 1.4426950408889634f;
constexpr size_t MiB = 1u << 20;
constexpr size_t WS_WIN = 0, WS_WBRA = 16 * MiB, WS_WBRB = 17 * MiB, WS_WBRC = 18 * MiB, WS_WO = 19 * MiB, WS_W1 = 21 * MiB, WS_W2 = 29 * MiB;
constexpr size_t WS_ROPE = 37 * MiB, WS_LA = 38 * MiB, WS_ACT = 40 * MiB, WS_YA = 72 * MiB, WS_YB = 84 * MiB, WS_YC = 100 * MiB, WS_PROJ = 116 * MiB;
constexpr size_t WS_H = WS_PROJ, WS_VTB = 348 * MiB, WS_VTC = 364 * MiB  , WS_T1 = 348 * MiB, WS_T2 = 380 * MiB, WS_END = 412 * MiB;
static_assert(WS_PROJ + (size_t)M * NINP * 2 <= WS_T1, "ws map");
constexpr int LDS_BYTES = 147456, MISC_OFF = 147456 - 256;
constexpr size_t WS_CTL = WS_END, CTL_BYTES = 16384;

__device__ __forceinline__ unsigned pk2(float lo, float hi) { return pg8::cvt_pk_bf16(lo, hi); }
__device__ __forceinline__ float bflo(unsigned w) { return __uint_as_float(w << 16); }
__device__ __forceinline__ float bfhi(unsigned w) { return __uint_as_float(w & 0xffff0000u); }
__device__ __forceinline__ float shx(float v, int mask, int lane) { return __int_as_float(__builtin_amdgcn_ds_bpermute((lane ^ mask) << 2, __float_as_int(v))); }
__device__ __forceinline__ float wave_sum(float v, int lane) {
#pragma unroll
    for (int o = 1; o < 64; o <<= 1) v += shx(v, o, lane);
    return v;
}
__device__ __forceinline__ float wave_max(float v, int lane) {
#pragma unroll
    for (int o = 1; o < 64; o <<= 1) v = fmaxf(v, shx(v, o, lane));
    return v;
}
#define MFMA32(a, b, c) __builtin_amdgcn_mfma_f32_32x32x16_bf16((a), (b), (c), 0, 0, 0)
__device__ __forceinline__ bf16x8 pack8(float a0, float a1, float a2, float a3, float a4, float a5, float a6, float a7) {
    u32x4 p;
    asm volatile("v_cvt_pk_bf16_f32 %0, %4, %5\n\tv_cvt_pk_bf16_f32 %1, %6, %7\n\tv_cvt_pk_bf16_f32 %2, %8, %9\n\tv_cvt_pk_bf16_f32 %3, %10, %11\n\ts_nop 1"
                 : "=&v"(p[0]), "=&v"(p[1]), "=&v"(p[2]), "=&v"(p[3])
                 : "v"(a0), "v"(a1), "v"(a2), "v"(a3), "v"(a4), "v"(a5), "v"(a6), "v"(a7));
    return __builtin_bit_cast(bf16x8, p);
}
__device__ __forceinline__ int kpos(int key) { return (key & ~12) | ((key & 4) << 1) | ((key & 8) >> 1); }

__device__ __forceinline__ void transpose_item(const float* W, int K, int N, bf16* WT, LAS float* scr, int item, int lane) {
    const int nblk = N / 32, kb = item / nblk, nb = item % nblk, k0 = 64 * kb, n0 = 32 * nb;
#pragma unroll 8
    for (int i = 0; i < 32; ++i) { const int kk = 2 * i + (lane >> 5); scr[kk * 33 + (lane & 31)] = W[(size_t)(k0 + kk) * N + n0 + (lane & 31)]; }
    asm volatile("s_waitcnt lgkmcnt(0)" ::: "memory");
    const int c = lane & 7;
#pragma unroll
    for (int j = 0; j < 4; ++j) { const int n = (lane >> 3) + 8 * j; const LAS float* s = scr + (8 * c) * 33 + n;
        u32x4 o; o.x = pk2(s[0 * 33], s[1 * 33]); o.y = pk2(s[2 * 33], s[3 * 33]); o.z = pk2(s[4 * 33], s[5 * 33]); o.w = pk2(s[6 * 33], s[7 * 33]);
        *(u32x4*)(WT + (size_t)(n0 + n) * K + k0 + 8 * c) = o; }
    asm volatile("s_waitcnt lgkmcnt(0)" ::: "memory");
}
__device__ __forceinline__ void rms_rows_to_bf16(const float* x, const float* g, bf16* o, int gw, int NGW, int lane) {
    const f32x4* gr = (const f32x4*)g + lane;
    f32x4 gg[4];
#pragma unroll
    for (int j = 0; j < 4; ++j) gg[j] = gr[64 * j];
    for (int m0 = gw * 4; m0 < M; m0 += NGW * 4) {
        f32x4 v[4][4];
#pragma unroll
        for (int q = 0; q < 4; ++q)
#pragma unroll
            for (int j = 0; j < 4; ++j) v[q][j] = ((const f32x4*)(x + (size_t)(m0 + q) * DM) + lane)[64 * j];
#pragma unroll
        for (int q = 0; q < 4; ++q) { float s = 0.f;
#pragma unroll
            for (int j = 0; j < 4; ++j) s += (v[q][j].x * v[q][j].x + v[q][j].y * v[q][j].y) + (v[q][j].z * v[q][j].z + v[q][j].w * v[q][j].w);
            const float rstd = 1.0f / sqrtf(wave_sum(s, lane) * (1.f / DM) + NORM_EPS);
            unsigned long long* o8 = (unsigned long long*)(o + (size_t)(m0 + q) * DM) + lane;
#pragma unroll
            for (int j = 0; j < 4; ++j)
                o8[64 * j] = (unsigned long long)pk2(v[q][j].x * rstd * gg[j].x, v[q][j].y * rstd * gg[j].y) | ((unsigned long long)pk2(v[q][j].z * rstd * gg[j].z, v[q][j].w * rstd * gg[j].w) << 32); }
    }
}

struct Args { const float* in[22]; float* out; unsigned char* ws; };
__device__ __forceinline__ int otid() { int t = threadIdx.x; asm volatile("" : "+v"(t)); return t; }

__device__ __forceinline__ void phase_prep(const Args& a, int l, LAS unsigned char* lds, int gw, int NGW, int wave, int lane, const float* xsrc) {
    unsigned char* ws = a.ws;
    LAS float* scr = (LAS float*)(lds + wave * 16384);
    const float* w_in = a.in[2] + (size_t)l * DM * NIN;
    const float* w_bra = a.in[15] + (size_t)l * 384 * DM;
    const float* w_brb = a.in[16] + (size_t)l * 512 * DM;
    const float* w_brc = a.in[17] + (size_t)l * 512 * DM;
    const float* w_o = a.in[18] + (size_t)l * DM * DM;
    const float* w_1 = a.in[20] + (size_t)l * DM * DFF;
    const float* w_2 = a.in[21] + (size_t)l * DFF * DM;
    constexpr int I_IN = (DM / 64) * (NIN / 32), I_A = (384 / 64) * (DM / 32), I_B = (512 / 64) * (DM / 32), I_O = (DM / 64) * (DM / 32), I_1 = (DM / 64) * (DFF / 32), I_2 = (DFF / 64) * (DM / 32);
    constexpr int NITEMS = I_IN + I_A + 2 * I_B + I_O + I_1 + I_2;
    for (int it = gw; it < NITEMS; it += NGW) {
        int r = it;
        if (r < I_IN) { transpose_item(w_in, DM, NIN, (bf16*)(ws + WS_WIN), scr, r, lane); continue; } r -= I_IN;
        if (r < I_A) { transpose_item(w_bra, 384, DM, (bf16*)(ws + WS_WBRA), scr, r, lane); continue; } r -= I_A;
        if (r < I_B) { transpose_item(w_brb, 512, DM, (bf16*)(ws + WS_WBRB), scr, r, lane); continue; } r -= I_B;
        if (r < I_B) { transpose_item(w_brc, 512, DM, (bf16*)(ws + WS_WBRC), scr, r, lane); continue; } r -= I_B;
        if (r < I_O) { transpose_item(w_o, DM, DM, (bf16*)(ws + WS_WO), scr, r, lane); continue; } r -= I_O;
        if (r < I_1) { transpose_item(w_1, DM, DFF, (bf16*)(ws + WS_W1), scr, r, lane); continue; } r -= I_1;
        transpose_item(w_2, DFF, DM, (bf16*)(ws + WS_W2), scr, r, lane);
    }
    { u32x4* z = (u32x4*)((bf16*)(ws + WS_WIN) + (size_t)NIN * DM); unsigned z0 = 0u; asm volatile("" : "+v"(z0)); const u32x4 zz = {z0, z0, z0, z0};
      for (int i = gw * 64 + lane; i < (NINP - NIN) * DM / 8; i += NGW * 64) z[i] = zz; }
    const float* g1 = a.in[1] + (size_t)l * DM;
    bf16* act = (bf16*)(ws + WS_ACT);
    rms_rows_to_bf16(xsrc, g1, act, gw, NGW, lane);
    if (l == 0) {
        float* rp = (float*)(ws + WS_ROPE);
        for (int e = gw * 64 + lane; e < SEQ * 40; e += NGW * 64) {
            const int s = e / 40, i = e % 40;
            float inv; if (i < 8) inv = 1.0f / exp2f((float)(2 * i) * (1.0f / 16.0f) * 18.931568569324174f);
            else inv = 1.0f / exp2f((float)(2 * (i - 8)) * (1.0f / 64.0f) * 13.287712379549449f);
            const float ang = (float)s * inv;
            const double rev = (double)ang * 0.15915494309189535; const float fr = (float)(rev - floor(rev));
            const float cs = __builtin_amdgcn_cosf(fr), sn = __builtin_amdgcn_sinf(fr);
            if (i < 8) { rp[s * 8 + i] = cs; rp[SEQ * 8 + s * 8 + i] = sn; }
            else { rp[SEQ * 16 + s * 32 + (i - 8)] = cs; rp[SEQ * 16 + SEQ * 32 + s * 32 + (i - 8)] = sn; }
        }
    }
}

__device__ __forceinline__ void pp_decode(const Args& a, int l, int hv, int& col, const float*& g, int& full, float& sc) {
    const float qs = 0.125f * LOG2E;
    g = a.in[3]; full = 0; sc = 1.f;
    if (hv < 6) { col = C_AQ + 64 * hv; g = a.in[3] + l * 64; sc = qs; }
    else if (hv < 12) { col = C_AK + 64 * (hv - 6); g = a.in[4] + l * 64; }
    else if (hv < 20) { col = C_BQ + 64 * (hv - 12); g = a.in[5] + l * 64; sc = qs; }
    else if (hv < 28) { col = C_BK + 64 * (hv - 20); g = a.in[6] + l * 64; }
    else if (hv < 32) { col = C_CQ + 64 * (hv - 28); full = 1; }
    else { col = C_CK + 64 * (hv - 32); full = 1; sc = 0.125f; }
}
__device__ __forceinline__ void pp_compute(const u32x4 w0, const u32x4 w1, u32x4& o0, u32x4& o1, const float* g, int full, float sc, int s, int q4, int lane,
                                           const float* cosP, const float* sinP, const float* cosR, const float* sinR) {
    float v[16] = {bflo(w0.x), bfhi(w0.x), bflo(w0.y), bfhi(w0.y), bflo(w0.z), bfhi(w0.z), bflo(w0.w), bfhi(w0.w),
                   bflo(w1.x), bfhi(w1.x), bflo(w1.y), bfhi(w1.y), bflo(w1.z), bfhi(w1.z), bflo(w1.w), bfhi(w1.w)};
    if (!full) {
        float ss = 0.f;
#pragma unroll
        for (int i = 0; i < 16; ++i) ss += v[i] * v[i];
        ss += shx(ss, 1, lane); ss += shx(ss, 2, lane);
        const float r = 1.0f / sqrtf(ss * (1.f / 64.f) + NORM_EPS);
        const f32x4* gp = (const f32x4*)(g + q4 * 16);
#pragma unroll
        for (int c = 0; c < 4; ++c) { const f32x4 gg = gp[c]; v[4 * c] *= r * gg[0]; v[4 * c + 1] *= r * gg[1]; v[4 * c + 2] *= r * gg[2]; v[4 * c + 3] *= r * gg[3]; }
        if (q4 == 0) {
            const f32x4 c0 = *(const f32x4*)(cosP + s * 8), c1 = *(const f32x4*)(cosP + s * 8 + 4), s0 = *(const f32x4*)(sinP + s * 8), s1 = *(const f32x4*)(sinP + s * 8 + 4);
#pragma unroll
            for (int i = 0; i < 8; ++i) { const float c = i < 4 ? c0[i & 3] : c1[i & 3], sn = i < 4 ? s0[i & 3] : s1[i & 3], t1 = v[i], t2 = v[8 + i]; v[i] = t1 * c - t2 * sn; v[8 + i] = t2 * c + t1 * sn; }
        }
    } else {
        const int ib = (q4 & 1) * 16;
        const float sg = (q4 < 2) ? -1.0f : 1.0f;
#pragma unroll
        for (int c = 0; c < 4; ++c) { const f32x4 cc = *(const f32x4*)(cosR + s * 32 + ib + 4 * c), sn = *(const f32x4*)(sinR + s * 32 + ib + 4 * c);
#pragma unroll
            for (int j = 0; j < 4; ++j) { const float pv = shx(v[4 * c + j], 2, lane); v[4 * c + j] = v[4 * c + j] * cc[j] + sg * pv * sn[j]; } }
    }
    o0.x = pk2(v[0] * sc, v[1] * sc); o0.y = pk2(v[2] * sc, v[3] * sc); o0.z = pk2(v[4] * sc, v[5] * sc); o0.w = pk2(v[6] * sc, v[7] * sc);
    o1.x = pk2(v[8] * sc, v[9] * sc); o1.y = pk2(v[10] * sc, v[11] * sc); o1.z = pk2(v[12] * sc, v[13] * sc); o1.w = pk2(v[14] * sc, v[15] * sc);
}
__device__ __forceinline__ void phase_postproj(const Args& a, int l, int gtid, int NT, int lane) {
    bf16* proj = (bf16*)(a.ws + WS_PROJ);
    const float* rp = (const float*)(a.ws + WS_ROPE);
    const float* cosP = rp; const float* sinP = rp + SEQ * 8; const float* cosR = rp + SEQ * 16; const float* sinR = rp + SEQ * 16 + SEQ * 32;
    const int q4 = lane & 3, NQ = NT >> 2;
    for (int e0 = gtid >> 2; e0 < M * 36; e0 += 2 * NQ) {
        const int e1 = e0 + NQ; const bool has1 = e1 < M * 36;
        const int t0 = e0 / 36, hv0 = e0 % 36, t1 = has1 ? e1 / 36 : t0, hv1 = has1 ? e1 % 36 : hv0;
        int col0, full0, col1, full1; const float *g0, *g1; float sc0, sc1;
        pp_decode(a, l, hv0, col0, g0, full0, sc0); pp_decode(a, l, hv1, col1, g1, full1, sc1);
        u32x4* p0 = (u32x4*)(proj + (size_t)t0 * NINP + col0 + q4 * 16); u32x4* p1 = (u32x4*)(proj + (size_t)t1 * NINP + col1 + q4 * 16);
        const u32x4 a0 = p0[0], a1 = p0[1], b0 = p1[0], b1 = p1[1];
        u32x4 o0, o1;
        pp_compute(a0, a1, o0, o1, g0, full0, sc0, t0 & (SEQ - 1), q4, lane, cosP, sinP, cosR, sinR);
        p0[0] = o0; p0[1] = o1;
        if (has1) { pp_compute(b0, b1, o0, o1, g1, full1, sc1, t1 & (SEQ - 1), q4, lane, cosP, sinP, cosR, sinR); p1[0] = o0; p1[1] = o1; }
    }
}

__device__ __forceinline__ void vt_item(const bf16* proj, bf16* vt, int vcol0, int item, LAS unsigned char* scr, int lane) {
    const int kt = item & 31, h = (item >> 5) & 3, b = item >> 7;
    const bf16* src = proj + ((size_t)b * SEQ + kt * 64) * NINP + vcol0 + h * 128;
#pragma unroll 4
    for (int i = 0; i < 16; ++i) { const int row = 4 * i + (lane >> 4), ch = lane & 15;
        const u32x4 w = *(const u32x4*)(src + (size_t)row * NINP + ch * 8);
        *(LAS u32x4*)(scr + row * 272 + ch * 16) = w; }
    asm volatile("s_waitcnt lgkmcnt(0)" ::: "memory");
    const int c = lane & 7;
    bf16* dst = vt + ((size_t)(b * 4 + h) * 128) * SEQ + kt * 64 + c * 8;
#pragma unroll 4
    for (int i = 0; i < 16; ++i) { const int dv = 8 * i + (lane >> 3);
        unsigned short e[8];
#pragma unroll
        for (int j = 0; j < 8; ++j) e[j] = *(const LAS unsigned short*)(scr + kpos(8 * c + j) * 272 + dv * 2);
        u32x4 o; o.x = e[0] | ((unsigned)e[1] << 16); o.y = e[2] | ((unsigned)e[3] << 16); o.z = e[4] | ((unsigned)e[5] << 16); o.w = e[6] | ((unsigned)e[7] << 16);
        *(u32x4*)(dst + (size_t)dv * SEQ) = o; }
    asm volatile("s_waitcnt lgkmcnt(0)" ::: "memory");
}

__device__ __forceinline__ void attn_a_item(const Args& a, int item, LAS unsigned char* wlds, int lane, float M2) {
    const bf16* proj = (const bf16*)(a.ws + WS_PROJ);
    bf16* ya = (bf16*)(a.ws + WS_YA); float* lA = (float*)(a.ws + WS_LA);
    const int r = lane & 31, hh = lane >> 5;
    const int g = item >> 10; int rem = item & 1023;
    const int qhalf = rem & 1; rem >>= 1;
    const int dsh = 2 * g, dil = 1 << dsh, nbs = 5 - dsh, L = SEQ >> dsh;
    const int n = rem & ((1 << nbs) - 1); rem >>= nbs;
    const int rsd = rem & (dil - 1); rem >>= dsh;
    const int hg = rem & 1; const int b = rem >> 1;
    const int head = 2 * g + hg;
    const int iq = 64 * n + 32 * qhalf + r;
    const size_t tq = (size_t)b * SEQ + (size_t)dil * iq + rsd;
    bf16x8 qf[4];
#pragma unroll
    for (int kk = 0; kk < 4; ++kk) qf[kk] = *(const bf16x8*)(proj + tq * NINP + C_AQ + head * 64 + 16 * kk + 8 * hh);
    f32x16 O0, O1;
#pragma unroll
    for (int i = 0; i < 16; ++i) { O0[i] = 0.f; O1[i] = 0.f; }
    float lsum = 0.f;
    const int j0 = 64 * n + 32 * qhalf - 64;
    const int lkey = lane >> 3, lch = lane & 7;
    u32x4 kb_[2][4], vb_[2][4];
    {
#pragma unroll
      for (int i = 0; i < 4; ++i) { int jr = j0 + lkey + 8 * i; jr = jr < 0 ? 0 : (jr >= L ? L - 1 : jr); const size_t tk = (size_t)b * SEQ + (size_t)dil * jr + rsd;
        kb_[0][i] = *(const u32x4*)(proj + tk * NINP + C_AK + head * 64 + lch * 8); vb_[0][i] = *(const u32x4*)(proj + tk * NINP + C_AV + head * 64 + lch * 8); } }
    LAS unsigned char* kl = wlds + 5120;
#pragma unroll
    for (int sb = 0; sb < 5; ++sb) {
        const int jb = j0 + 32 * sb;
        if (sb + 1 < 5) {
#pragma unroll
            for (int i = 0; i < 4; ++i) { int jr = jb + 32 + lkey + 8 * i; jr = jr < 0 ? 0 : (jr >= L ? L - 1 : jr); const size_t tk = (size_t)b * SEQ + (size_t)dil * jr + rsd;
                kb_[(sb + 1) & 1][i] = *(const u32x4*)(proj + tk * NINP + C_AK + head * 64 + lch * 8); vb_[(sb + 1) & 1][i] = *(const u32x4*)(proj + tk * NINP + C_AV + head * 64 + lch * 8); } }
        if (jb < 0 || jb >= L) continue;
#pragma unroll
        for (int i = 0; i < 4; ++i) { const int key = lkey + 8 * i;
            *(LAS u32x4*)(kl + key * 144 + lch * 16) = kb_[sb & 1][i];
            const u32x4 vv = vb_[sb & 1][i]; const unsigned ww[4] = {vv.x, vv.y, vv.z, vv.w};
            LAS bf16* w = (LAS bf16*)(wlds + (lch * 8) * 80 + kpos(key) * 2);
#pragma unroll
            for (int j = 0; j < 4; ++j) { w[(2 * j) * 40] = (bf16)(ww[j] & 0xffffu); w[(2 * j + 1) * 40] = (bf16)(ww[j] >> 16); } }
        asm volatile("s_waitcnt lgkmcnt(0)" ::: "memory");
        f32x16 acc;
#pragma unroll
        for (int i = 0; i < 16; ++i) acc[i] = -M2;
#pragma unroll
        for (int kk = 0; kk < 4; ++kk) { const bf16x8 kf = *(const LAS bf16x8*)(kl + r * 144 + (16 * kk + 8 * hh) * 2); acc = MFMA32(kf, qf[kk], acc); }
        float p[16];
#pragma unroll
        for (int i = 0; i < 16; ++i) { const int j = jb + (i & 3) + 8 * (i >> 2) + 4 * hh; const int d = iq - j;
            const float e = __builtin_amdgcn_exp2f(acc[i]); p[i] = (d <= 64 && d >= -64) ? e : 0.f; lsum += p[i]; }
        const bf16x8 pf0 = pack8(p[0], p[1], p[2], p[3], p[4], p[5], p[6], p[7]);
        const bf16x8 pf1 = pack8(p[8], p[9], p[10], p[11], p[12], p[13], p[14], p[15]);
        const bf16x8 v00 = *(const LAS bf16x8*)(wlds + r * 80 + (8 * hh) * 2);
        const bf16x8 v01 = *(const LAS bf16x8*)(wlds + r * 80 + (16 + 8 * hh) * 2);
        const bf16x8 v10 = *(const LAS bf16x8*)(wlds + (32 + r) * 80 + (8 * hh) * 2);
        const bf16x8 v11 = *(const LAS bf16x8*)(wlds + (32 + r) * 80 + (16 + 8 * hh) * 2);
        O0 = MFMA32(v00, pf0, O0); O0 = MFMA32(v01, pf1, O0);
        O1 = MFMA32(v10, pf0, O1); O1 = MFMA32(v11, pf1, O1);
        asm volatile("s_waitcnt lgkmcnt(0)" ::: "memory");
    }
    const float l = lsum + shx(lsum, 32, lane);
    bf16* op = ya + tq * 384 + head * 64 + 4 * hh;
#pragma unroll
    for (int q = 0; q < 4; ++q) {
        u32x2 w0; w0.x = pk2(O0[4 * q], O0[4 * q + 1]); w0.y = pk2(O0[4 * q + 2], O0[4 * q + 3]); *(u32x2*)(op + 8 * q) = w0;
        u32x2 w1; w1.x = pk2(O1[4 * q], O1[4 * q + 1]); w1.y = pk2(O1[4 * q + 2], O1[4 * q + 3]); *(u32x2*)(op + 32 + 8 * q) = w1;
    }
    if (hh == 0) lA[tq * 6 + head] = l;
}

__device__ __forceinline__ void vfrag8_tr(unsigned base, bf16x8 (&vf)[8]) {
    u32x2 r[16];
    asm volatile(
        "ds_read_b64_tr_b16 %0, %16 offset:0\n\t"
        "ds_read_b64_tr_b16 %1, %16 offset:2304\n\t"
        "ds_read_b64_tr_b16 %2, %16 offset:4608\n\t"
        "ds_read_b64_tr_b16 %3, %16 offset:6912\n\t"
        "ds_read_b64_tr_b16 %4, %16 offset:64\n\t"
        "ds_read_b64_tr_b16 %5, %16 offset:2368\n\t"
        "ds_read_b64_tr_b16 %6, %16 offset:4672\n\t"
        "ds_read_b64_tr_b16 %7, %16 offset:6976\n\t"
        "ds_read_b64_tr_b16 %8, %16 offset:128\n\t"
        "ds_read_b64_tr_b16 %9, %16 offset:2432\n\t"
        "ds_read_b64_tr_b16 %10, %16 offset:4736\n\t"
        "ds_read_b64_tr_b16 %11, %16 offset:7040\n\t"
        "ds_read_b64_tr_b16 %12, %16 offset:192\n\t"
        "ds_read_b64_tr_b16 %13, %16 offset:2496\n\t"
        "ds_read_b64_tr_b16 %14, %16 offset:4800\n\t"
        "ds_read_b64_tr_b16 %15, %16 offset:7104\n\t"
        "s_waitcnt lgkmcnt(0)"
        : "=&v"(r[0]), "=&v"(r[1]), "=&v"(r[2]), "=&v"(r[3]), "=&v"(r[4]), "=&v"(r[5]), "=&v"(r[6]), "=&v"(r[7]), "=&v"(r[8]), "=&v"(r[9]), "=&v"(r[10]), "=&v"(r[11]), "=&v"(r[12]), "=&v"(r[13]), "=&v"(r[14]), "=&v"(r[15]) : "v"(base) : "memory");
#pragma unroll
    for (int f = 0; f < 8; ++f) { u32x4 w; w.x = r[2 * f].x; w.y = r[2 * f].y; w.z = r[2 * f + 1].x; w.w = r[2 * f + 1].y; vf[f] = __builtin_bit_cast(bf16x8, w); }
}

__device__ __forceinline__ void vfrag4_tr(unsigned base, bf16x8 (&vf)[4]) {
    u32x2 r[8];
    asm volatile(
        "ds_read_b64_tr_b16 %0, %8 offset:0\n\t"
        "ds_read_b64_tr_b16 %1, %8 offset:2304\n\t"
        "ds_read_b64_tr_b16 %2, %8 offset:4608\n\t"
        "ds_read_b64_tr_b16 %3, %8 offset:6912\n\t"
        "ds_read_b64_tr_b16 %4, %8 offset:64\n\t"
        "ds_read_b64_tr_b16 %5, %8 offset:2368\n\t"
        "ds_read_b64_tr_b16 %6, %8 offset:4672\n\t"
        "ds_read_b64_tr_b16 %7, %8 offset:6976\n\t"
        "s_waitcnt lgkmcnt(0)"
        : "=&v"(r[0]), "=&v"(r[1]), "=&v"(r[2]), "=&v"(r[3]), "=&v"(r[4]), "=&v"(r[5]), "=&v"(r[6]), "=&v"(r[7]) : "v"(base) : "memory");
#pragma unroll
    for (int f = 0; f < 4; ++f) { u32x4 w; w.x = r[2 * f].x; w.y = r[2 * f].y; w.z = r[2 * f + 1].x; w.w = r[2 * f + 1].y; vf[f] = __builtin_bit_cast(bf16x8, w); }
}

constexpr int AT_KOFF = 9216, AT_VT = 18432, AT_STAGE = 36864;
constexpr size_t WS_RST = 380 * MiB;
__device__ __forceinline__ void ret_state_item(const Args& a, int l, int item, LAS unsigned char* lds) {
    const bf16* proj = (const bf16*)(a.ws + WS_PROJ);
    const int tid = otid(), wid = __builtin_amdgcn_readfirstlane(tid >> 6), lane = tid & 63, r = lane & 31, hh = lane >> 5;
    const int j = item & 7, h = (item >> 3) & 3, b = item >> 5;
    const float lgf2 = -__expf(a.in[12][l * 4 + h]) * LOG2E, lgb2 = -__expf(a.in[13][l * 4 + h]) * LOG2E;
    const int dir = wid >> 2, db = (wid >> 1) & 1, dvp = wid & 1;
    const bf16* kg = proj + ((size_t)b * SEQ + j * 256 + (tid >> 3)) * NINP + C_CK + h * 64 + (tid & 7) * 8;
    const bf16* vg = proj + ((size_t)b * SEQ + j * 256 + (tid >> 4)) * NINP + C_CV + h * 128 + (tid & 15) * 8;
    f32x16 acc0, acc1;
#pragma unroll
    for (int i = 0; i < 16; ++i) { acc0[i] = 0.f; acc1[i] = 0.f; }
    for (int t = 0; t < 4; ++t) {
        const u32x4 kw = *(const u32x4*)(kg + (size_t)t * 64 * NINP);
        const u32x4 v0 = *(const u32x4*)(vg + (size_t)t * 64 * NINP), v1 = *(const u32x4*)(vg + (size_t)(t * 64 + 32) * NINP);
        const int key = tid >> 3, ch = tid & 7, pos = t * 64 + key;
        const float wf = __builtin_amdgcn_exp2f(lgf2 * (float)(256 - pos)), wb = __builtin_amdgcn_exp2f(lgb2 * (float)pos);
        const float kv[8] = {bflo(kw.x), bfhi(kw.x), bflo(kw.y), bfhi(kw.y), bflo(kw.z), bfhi(kw.z), bflo(kw.w), bfhi(kw.w)};
        LAS bf16* ktf = (LAS bf16*)(lds + (ch * 8) * 144 + kpos(key) * 2);
        LAS bf16* ktb = (LAS bf16*)(lds + 9216 + (ch * 8) * 144 + kpos(key) * 2);
#pragma unroll
        for (int e = 0; e < 8; e += 2) { const unsigned pf = pk2(kv[e] * wf, kv[e + 1] * wf), pb = pk2(kv[e] * wb, kv[e + 1] * wb);
            ktf[e * 72] = (bf16)(pf & 0xffffu); ktf[(e + 1) * 72] = (bf16)(pf >> 16); ktb[e * 72] = (bf16)(pb & 0xffffu); ktb[(e + 1) * 72] = (bf16)(pb >> 16); }
        *(LAS u32x4*)(lds + AT_VT + (tid >> 4) * 288 + (tid & 15) * 16) = v0;
        *(LAS u32x4*)(lds + AT_VT + ((tid >> 4) + 32) * 288 + (tid & 15) * 16) = v1;
        __syncthreads();
        LAS unsigned char* abase = lds + dir * 9216 + (32 * db + r) * 144 + (8 * hh) * 2;
        const unsigned vb_ = (unsigned)(size_t)(lds + AT_VT) + (unsigned)((4 * hh + ((lane & 15) >> 2)) * 288 + (64 * dvp + 16 * ((lane >> 4) & 1)) * 2 + 8 * (lane & 3));
        bf16x8 vfa[4], vfb[4];
        vfrag4_tr(vb_, vfa); vfrag4_tr(vb_ + 32u * 288u, vfb);
#pragma unroll
        for (int ks = 0; ks < 4; ++ks) { const bf16x8 af = *(const LAS bf16x8*)(abase + 32 * ks);
            const bf16x8 b0 = ks < 2 ? vfa[ks] : vfb[ks - 2], b1 = ks < 2 ? vfa[2 + ks] : vfb[ks];
            acc0 = MFMA32(af, b0, acc0); acc1 = MFMA32(af, b1, acc1); }
        __syncthreads();
    }
    float* F = (float*)(a.ws + WS_RST) + ((size_t)(dir * 256 + item) * 64 + 32 * db + 4 * hh) * 128 + 64 * dvp + r;
#pragma unroll
    for (int i = 0; i < 16; ++i) { const int drow = (i & 3) + 8 * (i >> 2); F[drow * 128] = acc0[i]; F[drow * 128 + 32] = acc1[i]; }
}

template <int MODE>
__device__ __forceinline__ void attn_dense_unit(const Args& a, int l, int unit, LAS unsigned char* lds, float M2, float lam, float oscale) {
    const bf16* proj = (const bf16*)(a.ws + WS_PROJ);
    const int tid = otid(), wid = __builtin_amdgcn_readfirstlane(tid >> 6), lane = tid & 63, r = lane & 31, hh = lane >> 5;
    constexpr int QROWS = MODE == 0 ? 128 : 256;
    const int g = MODE == 0 ? (wid >> 1) : wid, m = MODE == 0 ? (wid & 1) : 0;
    const int qb = MODE == 0 ? (unit & 15) : (unit & 7), h = MODE == 0 ? ((unit >> 4) & 3) : ((unit >> 3) & 3), b = MODE == 0 ? (unit >> 6) : (unit >> 5);
    const int qcol = MODE == 0 ? C_BQ + (h * 2 + m) * 64 : C_CQ + h * 64;
    const int kcol = MODE == 0 ? C_BK + h * 128 : C_CK + h * 64;
    const size_t rowbase = (size_t)b * SEQ;
    const int nq = qb * QROWS + g * 32 + r;
    bf16x8 qf[4];
#pragma unroll
    for (int kk = 0; kk < 4; ++kk) qf[kk] = *(const bf16x8*)(proj + (rowbase + nq) * NINP + qcol + 16 * kk + 8 * hh);
    float lgf2 = 0.f, lgb2n = 0.f;
    float c1f[4] = {0.f, 0.f, 0.f, 0.f}, c2f[4] = {0.f, 0.f, 0.f, 0.f}, c1b[4] = {0.f, 0.f, 0.f, 0.f}, c2b[4] = {0.f, 0.f, 0.f, 0.f};
    if (MODE == 1) { lgf2 = -__expf(a.in[12][l * 4 + h]) * LOG2E; lgb2n = __expf(a.in[13][l * 4 + h]) * LOG2E;
#pragma unroll
        for (int q = 0; q < 4; ++q) { c1f[q] = __builtin_amdgcn_exp2f(lgf2 * (float)(3 - q)); c2f[q] = __builtin_amdgcn_exp2f(lgf2 * (float)(28 - 4 * hh - 8 * q));
                                      c1b[q] = __builtin_amdgcn_exp2f(-lgb2n * (float)q); c2b[q] = __builtin_amdgcn_exp2f(-lgb2n * (float)(4 * hh + 8 * q)); } }
    f32x16 O[4];
#pragma unroll
    for (int d = 0; d < 4; ++d)
#pragma unroll
        for (int i = 0; i < 16; ++i) O[d][i] = 0.f;
    float lsum = 0.f;
    if constexpr (MODE == 1) {
        const float* Fb_ = (const float*)(a.ws + WS_RST) + (size_t)((b * 4 + h) * 8) * 8192;
        const float cf = __builtin_amdgcn_exp2f(lgf2 * 256.0f), cb = __builtin_amdgcn_exp2f(-lgb2n * 256.0f);
#pragma unroll
        for (int e = 0; e < 4; ++e) { const int idx = tid + 512 * e, d = idx >> 5, dv4 = (idx & 31) * 4;
            f32x4 sf = {0.f, 0.f, 0.f, 0.f}, sb = {0.f, 0.f, 0.f, 0.f}; float w = 1.0f;
            for (int j = qb - 1; j >= 0; --j) { const f32x4 v = *(const f32x4*)(Fb_ + (size_t)j * 8192 + d * 128 + dv4); sf += v * w; w *= cf; }
            w = 1.0f;
            for (int j = qb + 1; j < 8; ++j) { const f32x4 v = *(const f32x4*)(Fb_ + (size_t)(256 + j) * 8192 + d * 128 + dv4); sb += v * w; w *= cb; }
#pragma unroll
            for (int q = 0; q < 4; ++q) { *(LAS bf16*)(lds + 73728 + (dv4 + q) * 144 + d * 2) = (bf16)(pk2(sf[q], 0.f) & 0xffffu); *(LAS bf16*)(lds + 92160 + (dv4 + q) * 144 + d * 2) = (bf16)(pk2(sb[q], 0.f) & 0xffffu); } }
        __syncthreads();
        const float wqf = __builtin_amdgcn_exp2f(lgf2 * (float)(g * 32 + r)), wqb = __builtin_amdgcn_exp2f(-lgb2n * (float)(256 - (g * 32 + r)));
#pragma unroll
        for (int d = 0; d < 4; ++d) { f32x16 of = O[d], ob = O[d];
#pragma unroll
            for (int kk = 0; kk < 4; ++kk) { const bf16x8 af = *(const LAS bf16x8*)(lds + 73728 + (32 * d + r) * 144 + (16 * kk + 8 * hh) * 2);
                const bf16x8 ab = *(const LAS bf16x8*)(lds + 92160 + (32 * d + r) * 144 + (16 * kk + 8 * hh) * 2);
                of = MFMA32(af, qf[kk], of); ob = MFMA32(ab, qf[kk], ob); }
#pragma unroll
            for (int i = 0; i < 16; ++i) O[d][i] = of[i] * wqf + ob[i] * wqb; }
    }
    const int lk_key = tid >> 3, lk_ch = tid & 7;
    const bf16* kg = proj + (rowbase + lk_key) * NINP + kcol + lk_ch * 8;
    const bf16* vg = proj + (rowbase + (tid >> 4)) * NINP + (MODE == 0 ? C_BV : C_CV) + h * 128 + (tid & 15) * 8;
    u32x4 kr0, kr1, vr0, vr1;
    constexpr int NTALL = SEQ / 64, NT = MODE == 0 ? NTALL : 4;
    const int kt0 = ((QROWS / 64) * qb) & (NTALL - 1);
    { const size_t o = (size_t)kt0 * 64 * NINP;
      kr0 = *(const u32x4*)(kg + o); if (MODE == 0) kr1 = *(const u32x4*)(kg + o + 64);
      vr0 = *(const u32x4*)(vg + o); vr1 = *(const u32x4*)(vg + o + (size_t)32 * NINP); }
    for (int it = 0; it < NT; ++it) {
        const int kt = (it + kt0) & (NTALL - 1);
        LAS unsigned char* st = lds + (it & 1) * AT_STAGE;
        *(LAS u32x4*)(st + lk_key * 144 + lk_ch * 16) = kr0;
        if (MODE == 0) *(LAS u32x4*)(st + AT_KOFF + lk_key * 144 + lk_ch * 16) = kr1;
        *(LAS u32x4*)(st + AT_VT + (tid >> 4) * 288 + (tid & 15) * 16) = vr0;
        *(LAS u32x4*)(st + AT_VT + ((tid >> 4) + 32) * 288 + (tid & 15) * 16) = vr1;
        __syncthreads();
        if (it + 1 < NT) {
            const int kn = (kt + 1) & (NTALL - 1);
            const size_t o = (size_t)kn * 64 * NINP;
            kr0 = *(const u32x4*)(kg + o); if (MODE == 0) kr1 = *(const u32x4*)(kg + o + 64);
            vr0 = *(const u32x4*)(vg + o); vr1 = *(const u32x4*)(vg + o + (size_t)32 * NINP);
        }
#define SCORE_TO_P(acc, kb, p) do { \
            if (MODE == 0) { _Pragma("unroll") for (int i = 0; i < 16; ++i) { p[i] = __builtin_amdgcn_exp2f(acc[i]); lsum += p[i]; } } \
            else { const int mk0 = kt * 64 + 32 * (kb), q0w = qb * QROWS + g * 32; \
                if (mk0 + 31 < q0w) { const float A_ = __builtin_amdgcn_exp2f(lgf2 * (float)(nq - mk0 - 31)); float c2_[4]; \
                    _Pragma("unroll") for (int bq = 0; bq < 4; ++bq) c2_[bq] = A_ * c2f[bq]; \
                    _Pragma("unroll") for (int i = 0; i < 16; ++i) p[i] = acc[i] * (c2_[i >> 2] * c1f[i & 3]); } \
                else if (mk0 > q0w + 31) { const float A_ = __builtin_amdgcn_exp2f(-lgb2n * (float)(mk0 - nq)); float c2_[4]; \
                    _Pragma("unroll") for (int bq = 0; bq < 4; ++bq) c2_[bq] = A_ * c2b[bq]; \
                    _Pragma("unroll") for (int i = 0; i < 16; ++i) p[i] = acc[i] * (c2_[i >> 2] * c1b[i & 3]); } \
                else { const int dbase_ = nq - (mk0 + 4 * hh); \
                    _Pragma("unroll") for (int i = 0; i < 16; ++i) { const int d_ = dbase_ - ((i & 3) + 8 * (i >> 2)); const float df_ = (float)d_; \
                        const float e_ = df_ * (d_ > 0 ? lgf2 : lgb2n); float D_ = __builtin_amdgcn_exp2f(e_); D_ = (d_ == 0) ? 2.0f : D_; p[i] = acc[i] * D_; } } } } while (0)
        {
            LAS unsigned char* kbase = st + (MODE == 0 ? m * AT_KOFF : 0) + r * 144 + (8 * hh) * 2;
            const unsigned vbase = (unsigned)(size_t)(st + AT_VT) + (unsigned)((4 * hh + ((lane & 15) >> 2)) * 288 + (16 * ((lane >> 4) & 1)) * 2 + 8 * (lane & 3));
            bf16x8 kf0[4], kf1[4], vf[8];
#pragma unroll
            for (int kk = 0; kk < 4; ++kk) kf0[kk] = *(const LAS bf16x8*)(kbase + 32 * kk);
#pragma unroll
            for (int kk = 0; kk < 4; ++kk) kf1[kk] = *(const LAS bf16x8*)(kbase + 32 * 144 + 32 * kk);
            __builtin_amdgcn_sched_barrier(0);
            f32x16 acc0, acc1;
#pragma unroll
            for (int i = 0; i < 16; ++i) { acc0[i] = MODE == 0 ? -M2 : 0.f; acc1[i] = MODE == 0 ? -M2 : 0.f; }
#pragma unroll
            for (int kk = 0; kk < 4; ++kk) acc0 = MFMA32(kf0[kk], qf[kk], acc0);
#pragma unroll
            for (int kk = 0; kk < 4; ++kk) acc1 = MFMA32(kf1[kk], qf[kk], acc1);
            __builtin_amdgcn_sched_barrier(0);
            if constexpr (MODE == 0) vfrag8_tr(vbase, vf);
            float p[16];
            SCORE_TO_P(acc0, 0, p);
            const bf16x8 pf00 = pack8(p[0], p[1], p[2], p[3], p[4], p[5], p[6], p[7]);
            const bf16x8 pf01 = pack8(p[8], p[9], p[10], p[11], p[12], p[13], p[14], p[15]);
            if constexpr (MODE == 1) vfrag8_tr(vbase, vf);
            __builtin_amdgcn_sched_barrier(0);
#pragma unroll
            for (int dvb = 0; dvb < 4; ++dvb) O[dvb] = MFMA32(vf[2 * dvb], pf00, O[dvb]);
#pragma unroll
            for (int dvb = 0; dvb < 4; ++dvb) O[dvb] = MFMA32(vf[2 * dvb + 1], pf01, O[dvb]);
            if constexpr (MODE == 0) vfrag8_tr(vbase + 32u * 288u, vf);
            SCORE_TO_P(acc1, 1, p);
            const bf16x8 pf10 = pack8(p[0], p[1], p[2], p[3], p[4], p[5], p[6], p[7]);
            const bf16x8 pf11 = pack8(p[8], p[9], p[10], p[11], p[12], p[13], p[14], p[15]);
            if constexpr (MODE == 1) vfrag8_tr(vbase + 32u * 288u, vf);
            __builtin_amdgcn_sched_barrier(0);
#pragma unroll
            for (int dvb = 0; dvb < 4; ++dvb) O[dvb] = MFMA32(vf[2 * dvb], pf10, O[dvb]);
#pragma unroll
            for (int dvb = 0; dvb < 4; ++dvb) O[dvb] = MFMA32(vf[2 * dvb + 1], pf11, O[dvb]);
        }
#undef SCORE_TO_P
    }
    __syncthreads();
    if (MODE == 0) { const float linv = 1.0f / (lsum + shx(lsum, 32, lane));
#pragma unroll
        for (int d = 0; d < 4; ++d)
#pragma unroll
            for (int i = 0; i < 16; ++i) O[d][i] *= linv; }
    LAS float* ex = (LAS float*)(lds + g * 16384) + lane;
    if (MODE == 0 && m == 1) {
#pragma unroll
        for (int d = 0; d < 4; ++d)
#pragma unroll
            for (int i = 0; i < 16; ++i) ex[(d * 16 + i) * 64] = O[d][i];
    }
    __syncthreads();
    if (m == 0) {
        float ss = 0.f;
#pragma unroll
        for (int d = 0; d < 4; ++d)
#pragma unroll
            for (int i = 0; i < 16; ++i) { float o = O[d][i]; if (MODE == 0) { o -= lam * ex[(d * 16 + i) * 64]; O[d][i] = o; } ss += o * o; }
        ss += shx(ss, 32, lane);
        const float rr = (1.0f / sqrtf(ss * (1.f / 128.f) + NORM_EPS)) * oscale;
        const float* gout = MODE == 0 ? a.in[11] + l * 128 : a.in[14] + l * 128;
        const size_t trow = rowbase + nq;
        bf16* yo = (bf16*)(a.ws + (MODE == 0 ? WS_YB : WS_YC)) + trow * 512 + h * 128 + 4 * hh;
        const bf16* cg = proj + trow * NINP + C_CG + h * 128 + 4 * hh;
#pragma unroll
        for (int d = 0; d < 4; ++d)
#pragma unroll
            for (int q = 0; q < 4; ++q) {
                const int dv = 32 * d + 8 * q;
                const f32x4 gg = *(const f32x4*)(gout + dv + 4 * hh);
                float y0 = O[d][4 * q] * rr * gg.x, y1 = O[d][4 * q + 1] * rr * gg.y, y2 = O[d][4 * q + 2] * rr * gg.z, y3 = O[d][4 * q + 3] * rr * gg.w;
                if (MODE == 1) { const u32x2 cw = *(const u32x2*)(cg + dv);
                    const float c0 = bflo(cw.x), c1 = bfhi(cw.x), c2 = bflo(cw.y), c3 = bfhi(cw.y);
                    y0 *= c0 / (1.0f + __expf(-c0)); y1 *= c1 / (1.0f + __expf(-c1)); y2 *= c2 / (1.0f + __expf(-c2)); y3 *= c3 / (1.0f + __expf(-c3)); }
                u32x2 w; w.x = pk2(y0, y1); w.y = pk2(y2, y3); *(u32x2*)(yo + dv) = w;
            }
    }
    __syncthreads();
}

#ifndef PHM
#define PHM 0xFFFF
#endif
#ifndef DBL
#define DBL 0
#endif
#define REP(k) for (int rep_ = 0; rep_ < (((DBL >> (k)) & 1) ? 2 : 1); ++rep_)
#define PH(k) if constexpr ((PHM >> (k)) & 1)
#define XB_TMO      128
#define XB_XCNT(j)  (256  + 64 * (j))
#define XB_XSUB(j)  (1280 + 64 * (j))
#define XB_XGEN(j)  (2304 + 64 * (j))
#define XB_TOP      3328
#define XB_TOPGEN   3392
#define XCD_BAR_WORDS 3456
#define XB_SPIN_CAP (1u << 18)

__device__ __forceinline__ unsigned xb_ld(unsigned* p)              { return __hip_atomic_load(p, __ATOMIC_RELAXED, __HIP_MEMORY_SCOPE_AGENT); }
__device__ __forceinline__ unsigned xb_add(unsigned* p, unsigned v) { return __hip_atomic_fetch_add(p, v, __ATOMIC_RELAXED, __HIP_MEMORY_SCOPE_AGENT); }
__device__ __forceinline__ unsigned xb_xcc_id() { return (unsigned)__builtin_amdgcn_s_getreg((3 << 11) | 20) & 0xFu; }
#define XB_SPIN(cond, bar) do { unsigned _sp = 0; while (cond) { __builtin_amdgcn_s_sleep(1); \
    if ((++_sp & 255u) == 0u) { if (xb_ld(&(bar)[XB_TMO])) break; if (_sp > XB_SPIN_CAP) { atomicAdd(&(bar)[XB_TMO], 1u); break; } } } } while (0)

struct XcdBarrier {
    unsigned* bar; unsigned x;
    volatile LAS unsigned* st;
};

__device__ __forceinline__ XcdBarrier xcd_barrier_post(unsigned* bar, volatile LAS unsigned* st) {
    XcdBarrier b; b.bar = bar; b.x = xb_xcc_id(); b.st = st;
    if (threadIdx.x == 0) (void)xb_add(&bar[XB_XCNT(b.x)], 1u);
    return b;
}
__device__ __forceinline__ void xcd_barrier_complete(unsigned* bar, unsigned x, unsigned& nloc, unsigned& nx) {
    const unsigned G = gridDim.x * gridDim.y * gridDim.z;
    unsigned sum, cnt, mine, sp = 0u;
    for (;;) {
        sum = 0u; cnt = 0u; mine = 0u;
#pragma unroll
        for (unsigned j = 0; j < 16; ++j) { const unsigned c = xb_ld(&bar[XB_XCNT(j)]); sum += c; cnt += (c > 0u) ? 1u : 0u; mine = (j == x) ? c : mine; }
        if (sum == G) break;
        __builtin_amdgcn_s_sleep(1);
        if ((++sp & 255u) == 0u) { if (xb_ld(&bar[XB_TMO])) break; if (sp > XB_SPIN_CAP) { atomicAdd(&bar[XB_TMO], 1u); break; } }
    }
    nloc = mine > 0u ? mine : 1u; nx = cnt > 0u ? cnt : 1u;
}

__device__ __forceinline__ void xcd_barrier(const XcdBarrier& b) {
    asm volatile("s_waitcnt vmcnt(0)" ::: "memory");
    __syncthreads();
    if (threadIdx.x == 0) {
        unsigned* bar = b.bar;
        __builtin_amdgcn_s_waitcnt(0);
        unsigned nloc = b.st[0], nx = b.st[1];
        if (nloc == 0u) { xcd_barrier_complete(bar, b.x, nloc, nx); b.st[0] = nloc; b.st[1] = nx; }
        const unsigned old = xb_add(&bar[XB_XSUB(b.x)], 1u);
        const unsigned gen = old / nloc;
        if (old + 1u == (gen + 1u) * nloc) {
            __builtin_amdgcn_fence(__ATOMIC_RELEASE, "agent");
            asm volatile("s_waitcnt vmcnt(0)" ::: "memory");
            const unsigned og = xb_add(&bar[XB_TOP], 1u);
            const unsigned tg = og / nx;
            if (og + 1u == (tg + 1u) * nx) xb_add(&bar[XB_TOPGEN], 1u);
            else XB_SPIN(xb_ld(&bar[XB_TOPGEN]) == tg, bar);
            __builtin_amdgcn_fence(__ATOMIC_ACQUIRE, "agent");
            xb_add(&bar[XB_XGEN(b.x)], 1u);
            asm volatile("s_waitcnt vmcnt(0)" ::: "memory");
        } else {
            XB_SPIN(xb_ld(&bar[XB_XGEN(b.x)]) == gen, bar);
            __builtin_amdgcn_fence(__ATOMIC_ACQUIRE, "agent");
            asm volatile("s_waitcnt vmcnt(0)" ::: "memory");
        }
    }
    __syncthreads();
}

typedef __attribute__((address_space(4))) const Args* CArgsP;
__device__ __forceinline__ Args load_args() {
    Args r{};
#if defined(__HIP_DEVICE_COMPILE__)
    CArgsP p = (CArgsP)__builtin_amdgcn_kernarg_segment_ptr(); asm volatile("" : "+s"(p));
#pragma unroll
    for (int i = 0; i < 22; ++i) r.in[i] = p->in[i];
    r.out = p->out; r.ws = p->ws;
#endif
    return r;
}
#define TIDS() const int tid = otid(), lane = tid & 63, wave = __builtin_amdgcn_readfirstlane(tid >> 6), gw = bx * NWAVES + wave, gtid = bx * NTHR + tid; (void)lane; (void)gw; (void)gtid
__global__ void __launch_bounds__(NTHR, 2) fwd_megakernel(Args a_unused) {
    extern __shared__ __attribute__((aligned(16))) unsigned char lds_raw[];
    LAS unsigned char* lds = (LAS unsigned char*)lds_raw;
    cg::grid_group grid = cg::this_grid();
    const int G = gridDim.x, bx = blockIdx.x;
    const int NGW = G * NWAVES, NT = G * NTHR;
    if (threadIdx.x < 2) ((volatile LAS unsigned*)(lds + MISC_OFF))[threadIdx.x] = 0u;
    __syncthreads();
    { const Args a = load_args(); (void)xcd_barrier_post((unsigned*)(a.ws + WS_CTL), (volatile LAS unsigned*)(lds + MISC_OFF)); }
#define GSYNC() do { const Args a_ = load_args(); XcdBarrier b_; b_.bar = (unsigned*)(a_.ws + WS_CTL); b_.x = xb_xcc_id(); b_.st = (volatile LAS unsigned*)(lds + MISC_OFF); xcd_barrier(b_); } while (0)

    for (int l = 0; l < DEPTH; ++l) {
        PH(0) REP(0) { const Args a = load_args(); TIDS(); phase_prep(a, l, lds, gw, NGW, wave, lane, (l == 0) ? a.in[0] : a.out); }
        { const Args a_ = load_args(); if (a_.ws == nullptr) grid.sync(); }
        GSYNC();
        if constexpr ((DBL >> 8) & 1) { for (int i_ = 0; i_ < 10; ++i_) GSYNC(); }
        PH(1) REP(1) { const Args a = load_args(); unsigned char* ws = a.ws;
          pg8::Gemm g{(const bf16*)(ws + WS_ACT), (const bf16*)(ws + WS_WIN), M, NINP, DM}; pg8::StaticOrder S; S.init(M, NINP, G, bx, 6);
          pg8::EpiStore<0> E{(bf16*)(ws + WS_PROJ), NINP};
          pg8::gemm_phase<pg8::EpiStore<0>, pg8::StaticOrder, true, true>(lds, g, S, E); }
        GSYNC();
        PH(2) { const Args a = load_args(); TIDS(); phase_postproj(a, l, gtid, NT, lane);
 }
        GSYNC();
        {
            const Args a = load_args(); TIDS();
            PH(5) { if (G == 256) { if (bx >= 128) for (int it = bx - 128; it < 256; it += 128) ret_state_item(a, l, it, lds); }
                    else for (int it = bx; it < 256; it += G) ret_state_item(a, l, it, lds); }
            PH(3) {
            const float gqa = wave_max(fabsf(a.in[3][l * 64 + lane]), lane), gka = wave_max(fabsf(a.in[4][l * 64 + lane]), lane);
            const float M2a = 8.0f * LOG2E * gqa * gka;
            REP(2) for (int it = gw; it < 3072; it += NGW) attn_a_item(a, it, lds + wave * 16384, lane, M2a);
            }
            __syncthreads();
            PH(4) {
            const float gqb = wave_max(fabsf(a.in[5][l * 64 + lane]), lane), gkb = wave_max(fabsf(a.in[6][l * 64 + lane]), lane);
            const float M2b = 8.0f * LOG2E * gqb * gkb;
            const float lam_init = 0.8f - 0.6f * expf(-0.3f * (float)l);
            const float s1 = wave_sum(a.in[7][l * 64 + lane] * a.in[8][l * 64 + lane], lane), s2 = wave_sum(a.in[9][l * 64 + lane] * a.in[10][l * 64 + lane], lane);
            const float lam = expf(s1) - expf(s2) + lam_init;
            REP(3) for (int u0 = bx; u0 < 512; u0 += G) { const int v = u0 & 255, u = (((v & 7) * 2 + (v >> 7)) + 16 * (u0 >> 8)) * 16 + ((v >> 3) & 15); attn_dense_unit<0>(a, l, u, lds, M2b, lam, 1.0f - lam_init); }
            }
        }
        GSYNC();
        {
            const Args a = load_args(); TIDS();
            PH(5) REP(4) for (int u0 = bx; u0 < 256; u0 += G) { const int u = ((u0 & 7) * 4 + (u0 >> 6)) * 8 + ((u0 >> 3) & 7); attn_dense_unit<1>(a, l, u, lds, 0.f, 0.f, 1.0f); }
            const float* lA = (const float*)(a.ws + WS_LA); bf16* ya = (bf16*)(a.ws + WS_YA);
            for (int e0 = gtid; e0 < M * 48; e0 += 3 * NT) {
                u32x4 w[3]; float lt[3]; u32x4* pp[3];
#pragma unroll
                for (int q = 0; q < 3; ++q) { int e = e0 + q * NT; e = e < M * 48 ? e : e0; const int t = e / 48, ch = e % 48, hg = (ch >> 3) & 1;
                    lt[q] = lA[t * 6 + hg] + lA[t * 6 + 2 + hg] + lA[t * 6 + 4 + hg]; pp[q] = (u32x4*)(ya + (size_t)t * 384 + ch * 8); w[q] = *pp[q]; }
#pragma unroll
                for (int q = 0; q < 3; ++q) { const float li = 1.0f / lt[q]; u32x4 v = w[q];
                    v.x = pk2(bflo(v.x) * li, bfhi(v.x) * li); v.y = pk2(bflo(v.y) * li, bfhi(v.y) * li);
                    v.z = pk2(bflo(v.z) * li, bfhi(v.z) * li); v.w = pk2(bflo(v.w) * li, bfhi(v.w) * li); *pp[q] = v; }
            }
        }
        GSYNC();
        PH(6) {
          { const Args a = load_args(); unsigned char* ws = a.ws; pg8::StaticOrder S; S.init(M, DM, G, bx);
            pg8::Gemm g{(const bf16*)(ws + WS_YA), (const bf16*)(ws + WS_WBRA), M, DM, 384}; pg8::EpiGate<0> E{(const bf16*)(ws + WS_PROJ) + C_GATE, NINP, nullptr, (bf16*)(ws + WS_T1)};
            pg8::gemm_phase<pg8::EpiGate<0>, pg8::StaticOrder, true, true>(lds, g, S, E); }
          { const Args a = load_args(); unsigned char* ws = a.ws; pg8::StaticOrder S; S.init(M, DM, G, bx);
            pg8::Gemm g{(const bf16*)(ws + WS_YB), (const bf16*)(ws + WS_WBRB), M, DM, 512}; pg8::EpiGate<1> E{(const bf16*)(ws + WS_PROJ) + C_GATE + 1024, NINP, (const bf16*)(ws + WS_T1), (bf16*)(ws + WS_T2)};
            pg8::gemm_phase<pg8::EpiGate<1>, pg8::StaticOrder, true, true>(lds, g, S, E); }
          { const Args a = load_args(); unsigned char* ws = a.ws; pg8::StaticOrder S; S.init(M, DM, G, bx);
            pg8::Gemm g{(const bf16*)(ws + WS_YC), (const bf16*)(ws + WS_WBRC), M, DM, 512}; pg8::EpiGate<1> E{(const bf16*)(ws + WS_PROJ) + C_GATE + 2048, NINP, (const bf16*)(ws + WS_T2), (bf16*)(ws + WS_ACT)};
            pg8::gemm_phase<pg8::EpiGate<1>, pg8::StaticOrder, true, true>(lds, g, S, E); } }
        GSYNC();
        PH(7) { const Args a = load_args(); unsigned char* ws = a.ws;
          pg8::Gemm g{(const bf16*)(ws + WS_ACT), (const bf16*)(ws + WS_WO), M, DM, DM}; pg8::StaticOrder S; S.init(M, DM, G, bx);
          pg8::EpiResid E{(l == 0) ? a.in[0] : a.out, a.out};
          pg8::gemm_phase<pg8::EpiResid, pg8::StaticOrder, true, true>(lds, g, S, E); }
        GSYNC();
        { const Args a = load_args(); TIDS(); const float* g2 = a.in[19] + (size_t)l * DM; bf16* act = (bf16*)(a.ws + WS_ACT);
          rms_rows_to_bf16(a.out, g2, act, gw, NGW, lane); }
        GSYNC();
        PH(8) { const Args a = load_args(); unsigned char* ws = a.ws;
          pg8::Gemm g{(const bf16*)(ws + WS_ACT), (const bf16*)(ws + WS_W1), M, DFF, DM}; pg8::StaticOrder S; S.init(M, DFF, G, bx, 6);
          pg8::EpiStore<1> E{(bf16*)(ws + WS_H), DFF};
          pg8::gemm_phase<pg8::EpiStore<1>, pg8::StaticOrder, true, true>(lds, g, S, E); }
        GSYNC();
        PH(9) { const Args a = load_args(); unsigned char* ws = a.ws;
          pg8::Gemm g{(const bf16*)(ws + WS_H), (const bf16*)(ws + WS_W2), M, DM, DFF}; pg8::StaticOrder S; S.init(M, DM, G, bx);
          pg8::EpiResid E{a.out, a.out};
          pg8::gemm_phase<pg8::EpiResid, pg8::StaticOrder, true, true>(lds, g, S, E); }
        GSYNC();
    }
}

extern "C" void kernel_launch(void* const* d_in, const int* in_sizes, int n_in, void* d_out, int out_size, void* d_ws, size_t ws_size, hipStream_t stream) {
    static int grid = 0;
    if (grid == 0) {
        if (n_in != 22 || out_size != M * DM || ws_size < WS_CTL + CTL_BYTES) { fprintf(stderr, "kernel_launch: unexpected shapes (n_in %d out %d ws %zu)\n", n_in, out_size, ws_size); grid = -1; return; }
        int dev = 0, cus = 0, per_cu = 0;
        hipGetDevice(&dev); hipDeviceGetAttribute(&cus, hipDeviceAttributeMultiprocessorCount, dev);
        hipFuncSetAttribute((const void*)fwd_megakernel, hipFuncAttributeMaxDynamicSharedMemorySize, LDS_BYTES);
        hipOccupancyMaxActiveBlocksPerMultiprocessor(&per_cu, (const void*)fwd_megakernel, NTHR, LDS_BYTES);
        if (per_cu < 1) { fprintf(stderr, "kernel_launch: occupancy query says %d blocks/CU\n", per_cu); per_cu = 1; }
        (void)hipGetLastError();
        grid = cus;
    }
    if (grid < 0) return;
    if (hipMemsetAsync((char*)d_ws + WS_CTL, 0, CTL_BYTES, stream) != hipSuccess) { fprintf(stderr, "kernel_launch: memset failed\n"); return; }
    Args a{};
    for (int i = 0; i < 22; ++i) a.in[i] = (const float*)d_in[i];
    a.out = (float*)d_out; a.ws = (unsigned char*)d_ws;
    void* args[] = {&a};
    hipError_t e = hipLaunchCooperativeKernel((const void*)fwd_megakernel, dim3(grid), dim3(NTHR), args, LDS_BYTES, stream);
    if (e != hipSuccess) fprintf(stderr, "cooperative launch failed: %s (grid %d)\n", hipGetErrorString(e), grid);
}
```
